# Optimizing an MI355X kernel written in HIP

```python
import jax, jax.numpy as jnp
from jax import lax
import numpy as np

D_MODEL = 2048
BATCH = 1
SEQ = 8192
DEPTH = 1

HEAD_DIM = 64
MIX_WIDTH = D_MODEL
RWKV_WIDTH = MIX_WIDTH // 2
RWKV_HEADS = RWKV_WIDTH // HEAD_DIM
ATTN_WIDTH = MIX_WIDTH - RWKV_WIDTH
ATTN_HEADS = ATTN_WIDTH // HEAD_DIM
KV_HEADS = max(1, ATTN_HEADS // 8)
KV_GROUP = ATTN_HEADS // KV_HEADS
KV_WIDTH = KV_HEADS * HEAD_DIM
W_LORA = 64
A_LORA = 64
G_LORA = 160
WINDOW = 128
BLOCK = WINDOW
ROPE_THETA = 500000.0
ROT_DIM = HEAD_DIM // 4
D_FF = 5632
CONV_WIDTH = 3
NORM_EPS = 1e-5
LNX_EPS = 64e-5
SPLIT_SIZES = (RWKV_WIDTH, RWKV_WIDTH, RWKV_WIDTH, W_LORA, A_LORA, G_LORA, ATTN_WIDTH, KV_WIDTH, KV_WIDTH)
RWKV_IN = 3 * RWKV_WIDTH + W_LORA + A_LORA + G_LORA
ATTN_IN = ATTN_WIDTH + 2 * KV_WIDTH
IN_WIDTH = RWKV_IN + ATTN_IN

kernel_name = "hymba_rwkv7_swa_sink_convffn"


def rms_norm(x, g, eps=NORM_EPS):
    xf = x.astype(jnp.float32)
    y = xf * lax.rsqrt(jnp.mean(xf * xf, axis=-1, keepdims=True) + eps)
    return (y * g.astype(jnp.float32)).astype(x.dtype)


def token_shift(z):
    return jnp.pad(z, ((0, 0), (1, 0), (0, 0)))[:, :-1]


def rope_tables(T):
    inv_freq = ROPE_THETA ** (-jnp.arange(0, ROT_DIM, 2, dtype=jnp.float32) / ROT_DIM)
    ang = jnp.arange(T, dtype=jnp.float32)[:, None] * inv_freq[None, :]
    return jnp.cos(ang), jnp.sin(ang)


def partial_rope(x, cos, sin):
    half = ROT_DIM // 2
    c = cos[None, :, None, :].astype(x.dtype)
    s = sin[None, :, None, :].astype(x.dtype)
    x1, x2, xp = x[..., :half], x[..., half:ROT_DIM], x[..., ROT_DIM:]
    return jnp.concatenate([x1 * c - x2 * s, x2 * c + x1 * s, xp], axis=-1)


def rwkv7_mix(r, k, v, xw, xa, xg, w0, w2, a0, a2, g2, k_k, k_a, r_k, lnx_g, lnx_b):
    B, T, _ = r.shape
    heads = lambda t: t.reshape(B, T, RWKV_HEADS, HEAD_DIM)
    f32 = jnp.float32
    w_log = -jax.nn.softplus(-(w0 + jnp.tanh(xw) @ w2).astype(f32)) - 0.5
    decay = jnp.exp(-jnp.exp(w_log))
    a = jax.nn.sigmoid(a0 + xa @ a2)
    g = jax.nn.sigmoid(xg) @ g2
    kk = heads(k * k_k).astype(f32)
    kk = kk / jnp.maximum(jnp.sqrt(jnp.sum(kk * kk, axis=-1, keepdims=True)), 1e-12)
    k = k * (1.0 + (a - 1.0) * k_a)
    rh, kh, vh, ah, dh = heads(r), heads(k), heads(v), heads(a), heads(decay)

    def step(S, inp):
        r_t, w_t, k_t, v_t, kk_t, b_t = inp
        sa = jnp.einsum('bhij,bhj->bhi', S, -kk_t)
        S = S * w_t[:, :, None, :] + sa[..., None] * b_t[:, :, None, :] + v_t[..., None] * k_t[:, :, None, :]
        return S, jnp.einsum('bhij,bhj->bhi', S, r_t)

    xs = tuple(jnp.moveaxis(t.astype(f32), 1, 0) for t in (rh, dh, kh, vh, kk, kk * ah.astype(f32)))
    S0 = jnp.zeros((B, RWKV_HEADS, HEAD_DIM, HEAD_DIM), f32)
    _, ys = lax.scan(step, S0, xs)
    y = jnp.moveaxis(ys, 0, 1)
    mu = jnp.mean(y, axis=-1, keepdims=True)
    var = jnp.mean(jnp.square(y - mu), axis=-1, keepdims=True)
    y = ((y - mu) * lax.rsqrt(var + LNX_EPS)).reshape(B, T, RWKV_WIDTH)
    y = y * lnx_g.astype(f32) + lnx_b.astype(f32)
    bonus = jnp.sum((rh * kh * r_k).astype(f32), axis=-1, keepdims=True) * vh.astype(f32)
    y = y + bonus.reshape(B, T, RWKV_WIDTH)
    return y.astype(r.dtype) * g


def swa_sink_attention(q, k, v, sinks, cos, sin):
    B, T, _ = q.shape
    NB = T // BLOCK
    q = partial_rope(q.reshape(B, T, ATTN_HEADS, HEAD_DIM), cos, sin)
    k = partial_rope(k.reshape(B, T, KV_HEADS, HEAD_DIM), cos, sin)
    v = v.reshape(B, T, KV_HEADS, HEAD_DIM)
    qb = q.reshape(B, NB, BLOCK, KV_HEADS, KV_GROUP, HEAD_DIM)

    def with_prev(t):
        t = t.reshape(B, NB, BLOCK, KV_HEADS, HEAD_DIM)
        prev = jnp.pad(t, ((0, 0), (1, 0), (0, 0), (0, 0), (0, 0)))[:, :-1]
        return jnp.concatenate([prev, t], axis=2)

    kw, vw = with_prev(k), with_prev(v)
    s = jnp.einsum('bnqkgd,bnskd->bnkgqs', qb, kw).astype(jnp.float32) * (HEAD_DIM ** -0.5)
    qi = jnp.arange(BLOCK)[:, None] + BLOCK
    si = jnp.arange(2 * BLOCK)[None, :]
    diff = qi - si
    key_pos = (jnp.arange(NB) * BLOCK)[:, None, None] - BLOCK + si[None]
    allowed = (diff >= 0)[None] & (diff < WINDOW)[None] & (key_pos >= 0)
    s = jnp.where(allowed[None, :, None, None], s, -jnp.inf)
    sink = jnp.broadcast_to(sinks.astype(jnp.float32).reshape(KV_HEADS, KV_GROUP)[None, None, :, :, None, None],
                            s.shape[:-1] + (1,))
    p = jax.nn.softmax(jnp.concatenate([s, sink], axis=-1), axis=-1)[..., :-1]
    o = jnp.einsum('bnkgqs,bnskd->bnqkgd', p.astype(v.dtype), vw)
    return o.reshape(B, T, ATTN_WIDTH)


def causal_dwconv(u, w, b):
    T = u.shape[1]
    up = jnp.pad(u, ((0, 0), (CONV_WIDTH - 1, 0), (0, 0)))
    out = b
    for j in range(CONV_WIDTH):
        out = out + w[j] * up[:, j:j + T]
    return out


def setup_inputs(seed: int = 0) -> dict:
    key = jax.random.key(seed)
    ks = jax.random.split(key, 26)
    n = lambda i, shape, scale: scale * jax.random.normal(ks[i], shape, jnp.float32)
    L = DEPTH
    return {
        "x": jax.random.normal(ks[0], (BATCH, SEQ, D_MODEL), jnp.float32),
        "ln_mix_g": 1.0 + n(1, (L, D_MODEL), 0.02),
        "w_in": n(2, (L, D_MODEL, IN_WIDTH), D_MODEL ** -0.5),
        "b_attn_qkv": n(3, (L, ATTN_IN), 0.02),
        "rwkv_shift_mu": jax.random.uniform(ks[4], (L, RWKV_IN), jnp.float32),
        "rwkv_w0": jax.random.uniform(ks[5], (L, RWKV_WIDTH), jnp.float32, -4.0, 0.0),
        "rwkv_w2": n(6, (L, W_LORA, RWKV_WIDTH), 0.5 * W_LORA ** -0.5),
        "rwkv_a0": n(7, (L, RWKV_WIDTH), 0.3),
        "rwkv_a2": n(8, (L, A_LORA, RWKV_WIDTH), 0.5 * A_LORA ** -0.5),
        "rwkv_g2": n(9, (L, G_LORA, RWKV_WIDTH), G_LORA ** -0.5),
        "rwkv_k_k": 0.85 + n(10, (L, RWKV_WIDTH), 0.05),
        "rwkv_k_a": 1.0 + n(11, (L, RWKV_WIDTH), 0.05),
        "rwkv_r_k": n(12, (L, RWKV_HEADS, HEAD_DIM), 0.1),
        "rwkv_lnx_g": 1.0 + n(13, (L, RWKV_WIDTH), 0.02),
        "rwkv_lnx_b": n(14, (L, RWKV_WIDTH), 0.02),
        "attn_sinks": n(15, (L, ATTN_HEADS), 0.5),
        "attn_out_g": 1.0 + n(16, (L, ATTN_WIDTH), 0.02),
        "w_out": n(17, (L, MIX_WIDTH, D_MODEL), MIX_WIDTH ** -0.5),
        "ln_ffn_g": 1.0 + n(18, (L, D_MODEL), 0.02),
        "ffn_w_up": n(19, (L, D_MODEL, D_FF), D_MODEL ** -0.5),
        "ffn_w_gate": n(20, (L, D_MODEL, D_FF), D_MODEL ** -0.5),
        "ffn_conv_w": n(21, (L, CONV_WIDTH, D_FF), CONV_WIDTH ** -0.5),
        "ffn_conv_b": n(22, (L, D_FF), 0.02),
        "ffn_w_down": n(23, (L, D_FF, D_MODEL), D_FF ** -0.5),
        "ln_final_g": 1.0 + n(24, (D_MODEL,), 0.02),
    }


def reference(x, ln_mix_g, w_in, b_attn_qkv, rwkv_shift_mu, rwkv_w0, rwkv_w2, rwkv_a0, rwkv_a2,
              rwkv_g2, rwkv_k_k, rwkv_k_a, rwkv_r_k, rwkv_lnx_g, rwkv_lnx_b, attn_sinks, attn_out_g,
              w_out, ln_ffn_g, ffn_w_up, ffn_w_gate, ffn_conv_w, ffn_conv_b, ffn_w_down, ln_final_g):
    T = x.shape[1]
    cos, sin = rope_tables(T)
    split_idx = [int(i) for i in np.cumsum(SPLIT_SIZES)[:-1]]
    for l in range(DEPTH):
        h = rms_norm(x, ln_mix_g[l])
        z = h @ w_in[l]
        z_rwkv, z_attn = z[..., :RWKV_IN], z[..., RWKV_IN:] + b_attn_qkv[l]
        mu = rwkv_shift_mu[l]
        z_rwkv = z_rwkv + mu * (token_shift(z_rwkv) - z_rwkv)
        z = jnp.concatenate([z_rwkv, z_attn], axis=-1)
        r, k, v, xw, xa, xg, q, ka, va = jnp.split(z, split_idx, axis=-1)
        y_rwkv = rwkv7_mix(r, k, v, xw, xa, xg, rwkv_w0[l], rwkv_w2[l], rwkv_a0[l], rwkv_a2[l],
                           rwkv_g2[l], rwkv_k_k[l], rwkv_k_a[l], rwkv_r_k[l], rwkv_lnx_g[l], rwkv_lnx_b[l])
        y_attn = rms_norm(swa_sink_attention(q, ka, va, attn_sinks[l], cos, sin), attn_out_g[l])
        x = x + jnp.concatenate([y_rwkv, y_attn], axis=-1) @ w_out[l]
        h = rms_norm(x, ln_ffn_g[l])
        u = causal_dwconv(h @ ffn_w_up[l], ffn_conv_w[l], ffn_conv_b[l])
        x = x + (jax.nn.silu(u) * (h @ ffn_w_gate[l])) @ ffn_w_down[l]
    return rms_norm(x, ln_final_g)
```

```cpp
#include <hip/hip_runtime.h>
#include <cstdio>
#include <cstdint>
#define MK_N_LAUNCHES 11
namespace pg8 {
#define PG8_LAS __attribute__((address_space(3)))
typedef unsigned short bf16_t;
typedef short bf16x8 __attribute__((ext_vector_type(8)));
typedef float f32x4 __attribute__((ext_vector_type(4)));
typedef unsigned u32x4 __attribute__((ext_vector_type(4)));
constexpr int BM = 256, BK = 64, HALF = 128, HTB = HALF * BK * 2  , STAGE_BYTES = 8 * HTB, NXCD = 8, WGM = 8;

__host__ __device__ __forceinline__ int lds_byte(int r, int c) { const int st = (r >> 4) * 2 + (c >> 5), rr = r & 15, cc = c & 31, ob = rr * 64 + cc * 2; return st * 1024 + (ob ^ (((ob >> 9) & 1) << 5)); }
__host__ __device__ __forceinline__ void stage_rc(int b, int& R, int& C) { const int st = b / 1024, sb = b % 1024, swz = sb ^ (((sb >> 9) & 1) << 5); R = (st >> 1) * 16 + swz / 64; C = (st & 1) * 32 + (swz % 64) / 2; }
__host__ __device__ __forceinline__ int perm32(int rho) { const int n = rho >> 4, i = rho & 15; return 8 * (i >> 2) + 4 * n + (i & 3); }

struct Unit { int pm, pn; };
struct Gemm { const bf16_t* A; const bf16_t* Bt; int M, N, K; long a_off, a_tstep; };

struct StaticOrder {
    int nM, nN, nwg, G, c;
    __host__ __device__ void init(int M, int N, int G_, int c_) { nM = M / BM; nN = N / BM; nwg = nM * nN; G = G_; c = c_; }
    __host__ __device__ void initT(int nM_, int nN_, int G_, int c_) { nM = nM_; nN = nN_; nwg = nM * nN; G = G_; c = c_; }
    __host__ __device__ bool next(int i, Unit& u) const {
        const long L = (long)i * G + c; if (L >= nwg) return false;
        int wgid = (int)L; { const int q = nwg / NXCD, r = nwg % NXCD, xcd = wgid % NXCD, off = wgid / NXCD; wgid = (xcd < r ? xcd * (q + 1) : r * (q + 1) + (xcd - r) * q) + off; }
        const int nig = WGM * nN, gid = wgid / nig, fm = gid * WGM, gsz = (nM - fm) < WGM ? (nM - fm) : WGM;
        u.pm = fm + ((wgid % nig) % gsz); u.pn = (wgid % nig) / gsz; return true;
    }
    __device__ __forceinline__ void a_ready(const Unit&) const {}
    __device__ __forceinline__ void done(const Unit&) const {}
};

__device__ __forceinline__ unsigned cvt_pk_bf16(float lo, float hi) { unsigned r; asm volatile("v_cvt_pk_bf16_f32 %0, %1, %2" : "=v"(r) : "v"(lo), "v"(hi)); return r; }
typedef unsigned u32x2 __attribute__((ext_vector_type(2)));

struct EpiZ {
    static constexpr bool PERM = true, AFTER_DRAIN = false;
    bf16_t* O; int ldc; const float* bias;
    __device__ __forceinline__ void operator()(const f32x4 (&acc)[2][2][4][2], const Unit& u, int wr, int wc, int fr, int fq) const {
        const int row0 = u.pm * BM + wr * 64 + fr; const int col0 = u.pn * BM + wc * 32 + 8 * fq;
        f32x4 bv[2][2];
#pragma unroll
        for (int bj = 0; bj < 2; ++bj)
#pragma unroll
            for (int n = 0; n < 2; ++n) bv[bj][n] = *(const f32x4*)(bias + col0 + bj * HALF + 4 * n);
#pragma unroll
        for (int ai = 0; ai < 2; ++ai)
#pragma unroll
            for (int m = 0; m < 4; ++m) { bf16_t* rowp = O + (size_t)(row0 + ai * HALF + m * 16) * ldc + col0;
#pragma unroll
                for (int bj = 0; bj < 2; ++bj) { const f32x4 v0 = acc[ai][bj][m][0] + bv[bj][0], v1 = acc[ai][bj][m][1] + bv[bj][1];
                    u32x4 w; w.x = cvt_pk_bf16(v0[0], v0[1]); w.y = cvt_pk_bf16(v0[2], v0[3]); w.z = cvt_pk_bf16(v1[0], v1[1]); w.w = cvt_pk_bf16(v1[2], v1[3]);
                    *(u32x4*)(rowp + bj * HALF) = w; } }
    }
};
struct EpiRes {
    static constexpr bool PERM = false, AFTER_DRAIN = false;
    const float* base; float* out; int ldc; bf16_t* hb; const float* gain; float* ssq;
    __device__ __forceinline__ void operator()(const f32x4 (&acc)[2][2][4][2], const Unit& u, int wr, int wc, int fr, int fq) const {
        const int row0 = u.pm * BM + wr * 64 + fr, col0 = u.pn * BM + wc * 32 + 4 * fq;
        f32x4 gv[2][2];
#pragma unroll
        for (int bj = 0; bj < 2; ++bj)
#pragma unroll
            for (int n = 0; n < 2; ++n) gv[bj][n] = hb ? *(const f32x4*)(gain + col0 + bj * HALF + n * 16) : (f32x4){0.f, 0.f, 0.f, 0.f};
#pragma unroll
        for (int ai = 0; ai < 2; ++ai)
#pragma unroll
            for (int m = 0; m < 4; ++m) { const int row = row0 + ai * HALF + m * 16; const size_t off = (size_t)row * ldc + col0; float q = 0.f;
#pragma unroll
                for (int bj = 0; bj < 2; ++bj)
#pragma unroll
                    for (int n = 0; n < 2; ++n) { const f32x4 x1 = *(const f32x4*)(base + off + bj * HALF + n * 16) + acc[ai][bj][m][n];
                        *(f32x4*)(out + off + bj * HALF + n * 16) = x1; q += (x1[0] * x1[0] + x1[1] * x1[1]) + (x1[2] * x1[2] + x1[3] * x1[3]);
                        if (hb) { const f32x4 h = x1 * gv[bj][n]; u32x2 w; w.x = cvt_pk_bf16(h[0], h[1]); w.y = cvt_pk_bf16(h[2], h[3]); *(u32x2*)(hb + off + bj * HALF + n * 16) = w; } }
                q += __shfl_xor(q, 16); q += __shfl_xor(q, 32);
                if (fq == 0) atomicAdd(ssq + row, q); }
    }
};
struct EpiUpGate {
    static constexpr bool PERM = true, AFTER_DRAIN = false;
    bf16_t* act; const float* ssq; const float* cw; const float* cb; PG8_LAS float* xch; int T, F; float invD, eps;
    __device__ __forceinline__ void operator()(const f32x4 (&acc)[2][2][4][2], const Unit& u, int wr, int wc, int fr, int fq) const {
        const int lane = fr + 16 * fq, wid = wr * 4 + wc;
        const int trow0 = 254 * u.pm - 2, f0 = 128 * u.pn + wc * 32 + 8 * fq;
        f32x4 uu[2][4][2], gg[2][4][2];
#pragma unroll
        for (int ai = 0; ai < 2; ++ai)
#pragma unroll
            for (int m = 0; m < 4; ++m) { const int t = trow0 + ai * HALF + wr * 64 + m * 16 + fr; float s = 0.f;
                if (t >= 0 && t < T) s = __builtin_amdgcn_rsqf(ssq[t] * invD + eps);
#pragma unroll
                for (int n = 0; n < 2; ++n) { uu[ai][m][n] = acc[ai][0][m][n] * s; gg[ai][m][n] = acc[ai][1][m][n] * s; } }
        if (fr >= 14) {
#pragma unroll
            for (int ai = 0; ai < 2; ++ai)
#pragma unroll
                for (int n = 0; n < 2; ++n) *(PG8_LAS f32x4*)(xch + ((((wid * 2 + ai) * 2 + (fr - 14)) * 4 + fq) * 2 + n) * 4) = uu[ai][3][n];
        }
        asm volatile("s_waitcnt lgkmcnt(0)" ::: "memory"); __builtin_amdgcn_s_barrier(); asm volatile("" ::: "memory");
        f32x4 pg[2][2];
#pragma unroll
        for (int ai = 0; ai < 2; ++ai)
#pragma unroll
            for (int n = 0; n < 2; ++n) { pg[ai][n] = (f32x4){0.f, 0.f, 0.f, 0.f};
                const int swid = wr ? wid - 4 : wid + 4, sai = wr ? ai : ai - 1;
                if (fr >= 14 && sai >= 0) pg[ai][n] = *(const PG8_LAS f32x4*)(xch + ((((swid * 2 + sai) * 2 + (fr - 14)) * 4 + fq) * 2 + n) * 4); }
        f32x4 w0[2], w1[2], w2[2], bb[2];
#pragma unroll
        for (int n = 0; n < 2; ++n) { w0[n] = *(const f32x4*)(cw + f0 + 4 * n); w1[n] = *(const f32x4*)(cw + F + f0 + 4 * n); w2[n] = *(const f32x4*)(cw + 2 * F + f0 + 4 * n); bb[n] = *(const f32x4*)(cb + f0 + 4 * n); }
        const int src1 = (lane & ~15) | ((lane - 1) & 15), src2 = (lane & ~15) | ((lane - 2) & 15);
#pragma unroll
        for (int ai = 0; ai < 2; ++ai)
#pragma unroll
            for (int m = 0; m < 4; ++m) { const int r = ai * HALF + wr * 64 + m * 16 + fr, t = trow0 + r; f32x4 o[2];
#pragma unroll
                for (int n = 0; n < 2; ++n) { const f32x4 U = uu[ai][m][n], PG = (m == 0) ? pg[ai][n] : uu[ai][m == 0 ? 0 : m - 1][n];
#pragma unroll
                    for (int c = 0; c < 4; ++c) { const float s1 = (fr == 15) ? PG[c] : U[c], s2 = (fr >= 14) ? PG[c] : U[c];
                        const float p1 = __shfl(s1, src1), p2 = __shfl(s2, src2);
                        const float cv = bb[n][c] + w2[n][c] * U[c] + w1[n][c] * p1 + w0[n][c] * p2;
                        const float sg = cv * __builtin_amdgcn_rcpf(1.0f + __expf(-cv));
                        o[n][c] = sg * gg[ai][m][n][c]; } }
                if (r >= 2 && t < T) { u32x4 w; w.x = cvt_pk_bf16(o[0][0], o[0][1]); w.y = cvt_pk_bf16(o[0][2], o[0][3]); w.z = cvt_pk_bf16(o[1][0], o[1][1]); w.w = cvt_pk_bf16(o[1][2], o[1][3]);
                    *(u32x4*)(act + (size_t)t * F + f0) = w; } }
    }
};
template <class Epi, class Sched, bool ALIGN_EPI = false, bool SP2 = false>
__device__ __forceinline__ void gemm_phase(PG8_LAS unsigned char* lds, const Gemm g, const Sched& S, const Epi& E) {
    const int tid = threadIdx.x, wid = __builtin_amdgcn_readfirstlane(tid >> 6), lane = tid & 63, wr = wid >> 2, wc = wid & 3, fr = lane & 15, fq = lane >> 4;
    const int K = g.K, nt = K / BK;
    unsigned voffA[2], voffB[2];
#pragma unroll
    for (int i = 0; i < 2; ++i) { int R, C; stage_rc(tid * 16 + i * 8192, R, C); const int Rb = Epi::PERM ? ((R & ~31) + perm32(R & 31)) : R;
        voffA[i] = (unsigned)(R * K + C) * 2u; voffB[i] = (unsigned)(Rb * K + C) * 2u; }
    const size_t kstep = (size_t)(BK * 2);
    const size_t hstep = (size_t)HALF * K * 2;
    const size_t tstep = 2 * hstep;
    const unsigned ldsw = (unsigned)wid * 1024u;
    const int aoff = lds_byte(wr * 64 + fr, fq * 8), boff = lds_byte(wc * 32 + fr, fq * 8);
#define PG8_SA(b, h) (((b) * 2 + (h)) * HTB)
#define PG8_SB(b, h) ((4 + (b) * 2 + (h)) * HTB)
#define PG8_STAGE(bufoff, gbase, voff) do { _Pragma("unroll") for (int _i = 0; _i < 2; ++_i) \
        __builtin_amdgcn_global_load_lds((const unsigned*)((const char*)(gbase) + (voff)[_i]), (PG8_LAS unsigned*)(lds + (bufoff) + ldsw + _i * 8192), 16, 0, 0); } while (0)
#define PG8_LDA(dst, b, h) do { _Pragma("unroll") for (int m = 0; m < 4; ++m) _Pragma("unroll") for (int k = 0; k < 2; ++k) dst[m][k] = *(const PG8_LAS bf16x8*)(lds + PG8_SA(b, h) + aoff + m * 2048 + k * 1024); } while (0)
#define PG8_LDB(dst, b, h) do { _Pragma("unroll") for (int n = 0; n < 2; ++n) _Pragma("unroll") for (int k = 0; k < 2; ++k) dst[n][k] = *(const PG8_LAS bf16x8*)(lds + PG8_SB(b, h) + boff + n * 2048 + k * 1024); } while (0)
#define PG8_MMA(ai, bj, At, Bt) do { __builtin_amdgcn_s_setprio(1); _Pragma("unroll") for (int m = 0; m < 4; ++m) _Pragma("unroll") for (int n = 0; n < 2; ++n) _Pragma("unroll") for (int k = 0; k < 2; ++k) \
        acc[ai][bj][m][n] = __builtin_amdgcn_mfma_f32_16x16x32_bf16(Bt[n][k], At[m][k], acc[ai][bj][m][n], 0, 0, 0); __builtin_amdgcn_s_setprio(0); } while (0)
#define PG8_WAIT_V(n) asm volatile("s_waitcnt vmcnt(" #n ")" ::: "memory")
#define PG8_WAIT_L(n) asm volatile("s_waitcnt lgkmcnt(" #n ")" ::: "memory")
#define PG8_BAR __builtin_amdgcn_s_barrier()
#define PG8_SCHED __builtin_amdgcn_sched_barrier(0)
    Unit cur, nxt; int ui = 0;
    if (!S.next(0, cur)) return;
    f32x4 acc[2][2][4][2];
#pragma unroll
    for (int a = 0; a < 2; ++a)
#pragma unroll
        for (int b = 0; b < 2; ++b)
#pragma unroll
            for (int m = 0; m < 4; ++m)
#pragma unroll
                for (int n = 0; n < 2; ++n) acc[a][b][m][n] = (f32x4){0.f, 0.f, 0.f, 0.f};
    bf16x8 At[4][2], B0[2][2], B1[2][2];
    const char* cA = (const char*)g.A + g.a_off + (long)cur.pm * g.a_tstep; const char* cB = (const char*)g.Bt + (size_t)cur.pn * tstep;
    S.a_ready(cur);
    if constexpr (SP2) {
        PG8_STAGE(PG8_SB(0, 0), cB, voffB); PG8_STAGE(PG8_SB(0, 1), cB + hstep, voffB); PG8_STAGE(PG8_SA(0, 0), cA, voffA); PG8_STAGE(PG8_SA(0, 1), cA + hstep, voffA);
        if (wr == 1) PG8_BAR;
        PG8_WAIT_V(2); PG8_BAR;
        PG8_STAGE(PG8_SB(1, 0), cB + kstep, voffB); PG8_STAGE(PG8_SA(1, 0), cA + kstep, voffA); PG8_STAGE(PG8_SB(1, 1), cB + hstep + kstep, voffB);
        PG8_WAIT_V(6); PG8_BAR;
    } else {
        PG8_STAGE(PG8_SB(0, 0), cB, voffB); PG8_STAGE(PG8_SA(0, 0), cA, voffA); PG8_STAGE(PG8_SB(0, 1), cB + hstep, voffB); PG8_STAGE(PG8_SA(0, 1), cA + hstep, voffA);
        if (wr == 1) PG8_BAR;
        PG8_WAIT_V(4); PG8_BAR;
        PG8_STAGE(PG8_SB(1, 0), cB + kstep, voffB); PG8_STAGE(PG8_SA(1, 0), cA + kstep, voffA); PG8_STAGE(PG8_SB(1, 1), cB + hstep + kstep, voffB);
        PG8_WAIT_V(6); PG8_BAR;
    }
    for (;;) {
        const bool has_next = S.next(ui + 1, nxt);
        const char* nA = has_next ? (const char*)g.A + g.a_off + (long)nxt.pm * g.a_tstep : cA; const char* nB = has_next ? (const char*)g.Bt + (size_t)nxt.pn * tstep : cB;
        for (int t = 0; t < nt; t += 2) {
            const bool last = (t == nt - 2);
            const char* a1 = cA + (size_t)(t + 1) * kstep;
            const char* a2 = last ? nA : cA + (size_t)(t + 2) * kstep; const char* b2 = last ? nB : cB + (size_t)(t + 2) * kstep;
            const char* a3 = a2 + kstep; const char* b3 = b2 + kstep;
            if (last && has_next) S.a_ready(nxt);
            if constexpr (SP2) {
            PG8_LDB(B0, 0, 0); PG8_LDB(B1, 0, 1); PG8_SCHED; PG8_LDA(At, 0, 0); PG8_STAGE(PG8_SA(1, 1), a1 + hstep, voffA);
            PG8_WAIT_V(8); PG8_WAIT_L(0); PG8_BAR; PG8_MMA(0, 0, At, B0); PG8_MMA(0, 1, At, B1); PG8_BAR; PG8_SCHED;
            PG8_LDA(At, 0, 1); PG8_STAGE(PG8_SB(0, 0), b2, voffB); PG8_STAGE(PG8_SB(0, 1), b2 + hstep, voffB); PG8_STAGE(PG8_SA(0, 0), a2, voffA);
            PG8_WAIT_V(8); PG8_WAIT_L(0); PG8_BAR; PG8_MMA(1, 0, At, B0); PG8_MMA(1, 1, At, B1); PG8_BAR; PG8_SCHED;
            PG8_LDB(B0, 1, 0); PG8_LDB(B1, 1, 1); PG8_SCHED; PG8_LDA(At, 1, 0); PG8_STAGE(PG8_SA(0, 1), a2 + hstep, voffA);
            PG8_WAIT_V(8); PG8_WAIT_L(0); PG8_BAR; PG8_MMA(0, 0, At, B0); PG8_MMA(0, 1, At, B1); PG8_BAR; PG8_SCHED;
            PG8_LDA(At, 1, 1); PG8_STAGE(PG8_SB(1, 0), b3, voffB); PG8_STAGE(PG8_SB(1, 1), b3 + hstep, voffB); PG8_STAGE(PG8_SA(1, 0), a3, voffA);
            PG8_WAIT_V(8); PG8_WAIT_L(0); PG8_BAR; PG8_MMA(1, 0, At, B0); PG8_MMA(1, 1, At, B1); PG8_BAR; PG8_SCHED;
            } else {
            PG8_LDB(B0, 0, 0); PG8_SCHED; PG8_LDA(At, 0, 0); PG8_STAGE(PG8_SA(1, 1), a1 + hstep, voffA);
            PG8_WAIT_L(8); PG8_BAR; PG8_WAIT_L(0); PG8_MMA(0, 0, At, B0); PG8_BAR; PG8_SCHED;
            PG8_LDB(B1, 0, 1); PG8_STAGE(PG8_SB(0, 0), b2, voffB);
            PG8_BAR; PG8_WAIT_L(0); PG8_MMA(0, 1, At, B1); PG8_BAR;
            PG8_LDA(At, 0, 1); PG8_STAGE(PG8_SA(0, 0), a2, voffA);
            PG8_BAR; PG8_WAIT_L(0); PG8_MMA(1, 0, At, B0); PG8_BAR; PG8_SCHED;
            PG8_STAGE(PG8_SB(0, 1), b2 + hstep, voffB);
            PG8_WAIT_V(6); PG8_BAR; PG8_MMA(1, 1, At, B1); PG8_BAR;
            PG8_LDB(B0, 1, 0); PG8_SCHED; PG8_LDA(At, 1, 0); PG8_STAGE(PG8_SA(0, 1), a2 + hstep, voffA);
            PG8_WAIT_L(8); PG8_BAR; PG8_WAIT_L(0); PG8_MMA(0, 0, At, B0); PG8_BAR; PG8_SCHED;
            PG8_LDB(B1, 1, 1); PG8_STAGE(PG8_SB(1, 0), b3, voffB);
            PG8_BAR; PG8_WAIT_L(0); PG8_MMA(0, 1, At, B1); PG8_BAR;
            PG8_LDA(At, 1, 1); PG8_STAGE(PG8_SA(1, 0), a3, voffA);
            PG8_BAR; PG8_WAIT_L(0); PG8_MMA(1, 0, At, B0); PG8_BAR; PG8_SCHED;
            PG8_STAGE(PG8_SB(1, 1), b3 + hstep, voffB);
            PG8_WAIT_V(6); PG8_BAR; PG8_MMA(1, 1, At, B1); PG8_BAR;
            }
        }
        if constexpr (ALIGN_EPI) { if (wr == 0) PG8_BAR; }
        if constexpr (!Epi::AFTER_DRAIN) { E(acc, cur, wr, wc, fr, fq); S.done(cur); }
        if (!has_next) break;
#pragma unroll
        for (int a = 0; a < 2; ++a)
#pragma unroll
            for (int b = 0; b < 2; ++b)
#pragma unroll
                for (int m = 0; m < 4; ++m)
#pragma unroll
                    for (int n = 0; n < 2; ++n) acc[a][b][m][n] = (f32x4){0.f, 0.f, 0.f, 0.f};
        cur = nxt; cA = nA; cB = nB; ++ui;
        if constexpr (ALIGN_EPI) { if (wr == 1) PG8_BAR; }
    }
    PG8_WAIT_V(0);
    if constexpr (!ALIGN_EPI) { if (wr == 0) PG8_BAR; }
    PG8_BAR;
    if constexpr (Epi::AFTER_DRAIN) { E.fused(acc, cur, wr, wc, fr, fq, lds, wid, lane); S.done(cur); }
#undef PG8_SA
#undef PG8_SB
#undef PG8_STAGE
#undef PG8_LDA
#undef PG8_LDB
#undef PG8_MMA
#undef PG8_WAIT_V
#undef PG8_WAIT_L
#undef PG8_BAR
#undef PG8_SCHED
}
}
constexpr int NWAVES = 8;
#ifndef MK_N_LAUNCHES
#define MK_N_LAUNCHES 1
#endif
constexpr int T_ = 8192, D_ = 2048, INW = 4640, NIN = 4864, RW = 1024, NH = 16, HD = 64, DFF = 5632, NUG = 2 * DFF;
constexpr int COL_R = 0, COL_K = 1024, COL_V = 2048, COL_XW = 3072, COL_XA = 3136, COL_XG = 3200, COL_Q = 3360, COL_KA = 4384, COL_VA = 4512, RIN = 3360;
constexpr float NORM_EPS = 1e-5f, LNX_EPS = 64e-5f;
constexpr size_t MiB = 1u << 20;
constexpr size_t WS_CTL = 0, CTL_ZERO_BYTES = 1 * MiB;
constexpr size_t WS_WIN = 1 * MiB, WS_WOUT = 20 * MiB, WS_HN = 28 * MiB, WS_Z = 61 * MiB, WS_RWA = 137 * MiB, WS_MISC = 250 * MiB, WS_END = 256 * MiB;
constexpr size_t WS_WUG = 61 * MiB, WS_WDN = 105 * MiB, WS_ACT = 127 * MiB, WS_H2 = 216 * MiB;
constexpr size_t RWA_STRIDE = 16 * MiB;
constexpr size_t MISC_BIAS = 0, MISC_ROPE = 64 * 1024;
constexpr int CW_BAR = 4096;
constexpr int CW_SSQA = 65536, CW_SSQ2 = CW_SSQA + T_, CW_SSQ3 = CW_SSQ2 + T_;
static_assert((CW_SSQ3 + T_) * 4 <= (int)CTL_ZERO_BYTES, "ctl");
constexpr int RING_BYTES = 131072, XCH_OFF = RING_BYTES, LDSCTL_OFF = RING_BYTES + 4096, MISC_OFF = LDSCTL_OFF + 320, LDS_BYTES = 147456;

#define GAS __attribute__((address_space(1)))
#define LAS __attribute__((address_space(3)))
typedef unsigned short bf16;
typedef unsigned v4u __attribute__((ext_vector_type(4)));
typedef float f32x4 __attribute__((ext_vector_type(4)));
typedef GAS unsigned gu32;
#define RLX_AGENT __ATOMIC_RELAXED, __HIP_MEMORY_SCOPE_AGENT
#define LDS_WAIT() asm volatile("s_waitcnt lgkmcnt(0)" ::: "memory")
__device__ __forceinline__ unsigned f2bf(float f) { unsigned u = __builtin_bit_cast(unsigned, f); return (u + 0x7fffu + ((u >> 16) & 1u)) >> 16; }
__device__ __forceinline__ unsigned pk2(float lo, float hi) { return f2bf(lo) | (f2bf(hi) << 16); }
__device__ __forceinline__ float bf2f(unsigned h) { return __builtin_bit_cast(float, h << 16); }
__device__ __forceinline__ float wave_sum(float v) {
#pragma unroll
    for (int o = 1; o < 64; o <<= 1) v += __shfl_xor(v, o);
    return v;
}
#define XB_TMO      128
#define XB_XCNT(j)  (256  + 64 * (j))
#define XB_XSUB(j)  (1280 + 64 * (j))
#define XB_XGEN(j)  (2304 + 64 * (j))
#define XB_TOP      3328
#define XB_TOPGEN   3392
#define XCD_BAR_WORDS 3456
#define XB_SPIN_CAP (1u << 18)

__device__ __forceinline__ unsigned xb_ld(unsigned* p)              { return __hip_atomic_load(p, __ATOMIC_RELAXED, __HIP_MEMORY_SCOPE_AGENT); }
__device__ __forceinline__ unsigned xb_add(unsigned* p, unsigned v) { return __hip_atomic_fetch_add(p, v, __ATOMIC_RELAXED, __HIP_MEMORY_SCOPE_AGENT); }
__device__ __forceinline__ unsigned xb_xcc_id() { return (unsigned)__builtin_amdgcn_s_getreg((3 << 11) | 20) & 0xFu; }
#define XB_SPIN(cond, bar) do { unsigned _sp = 0; while (cond) { __builtin_amdgcn_s_sleep(1); \
    if ((++_sp & 255u) == 0u) { if (xb_ld(&(bar)[XB_TMO])) break; if (_sp > XB_SPIN_CAP) { atomicAdd(&(bar)[XB_TMO], 1u); break; } } } } while (0)

struct XcdBarrier {
    unsigned* bar; unsigned x;
    volatile LAS unsigned* st;
};

__device__ __forceinline__ XcdBarrier xcd_barrier_post(unsigned* bar, volatile LAS unsigned* st) {
    XcdBarrier b; b.bar = bar; b.x = xb_xcc_id(); b.st = st;
    if (threadIdx.x == 0) (void)xb_add(&bar[XB_XCNT(b.x)], 1u);
    return b;
}
__device__ __forceinline__ void xcd_barrier_complete(unsigned* bar, unsigned x, unsigned& nloc, unsigned& nx) {
    const unsigned G = gridDim.x * gridDim.y * gridDim.z;
    unsigned sum, cnt, mine, sp = 0u;
    for (;;) {
        sum = 0u; cnt = 0u; mine = 0u;
#pragma unroll
        for (unsigned j = 0; j < 16; ++j) { const unsigned c = xb_ld(&bar[XB_XCNT(j)]); sum += c; cnt += (c > 0u) ? 1u : 0u; mine = (j == x) ? c : mine; }
        if (sum == G) break;
        __builtin_amdgcn_s_sleep(1);
        if ((++sp & 255u) == 0u) { if (xb_ld(&bar[XB_TMO])) break; if (sp > XB_SPIN_CAP) { atomicAdd(&bar[XB_TMO], 1u); break; } }
    }
    nloc = mine > 0u ? mine : 1u; nx = cnt > 0u ? cnt : 1u;
}

__device__ __forceinline__ void xcd_barrier(const XcdBarrier& b) {
    asm volatile("s_waitcnt vmcnt(0)" ::: "memory");
    __syncthreads();
    if (threadIdx.x == 0) {
        unsigned* bar = b.bar;
        __builtin_amdgcn_s_waitcnt(0);
        unsigned nloc = b.st[0], nx = b.st[1];
        if (nloc == 0u) { xcd_barrier_complete(bar, b.x, nloc, nx); b.st[0] = nloc; b.st[1] = nx; }
        const unsigned old = xb_add(&bar[XB_XSUB(b.x)], 1u);
        const unsigned gen = old / nloc;
        if (old + 1u == (gen + 1u) * nloc) {
            __builtin_amdgcn_fence(__ATOMIC_RELEASE, "agent");
            asm volatile("s_waitcnt vmcnt(0)" ::: "memory");
            const unsigned og = xb_add(&bar[XB_TOP], 1u);
            const unsigned tg = og / nx;
            if (og + 1u == (tg + 1u) * nx) xb_add(&bar[XB_TOPGEN], 1u);
            else XB_SPIN(xb_ld(&bar[XB_TOPGEN]) == tg, bar);
            __builtin_amdgcn_fence(__ATOMIC_ACQUIRE, "agent");
            xb_add(&bar[XB_XGEN(b.x)], 1u);
            asm volatile("s_waitcnt vmcnt(0)" ::: "memory");
        } else {
            XB_SPIN(xb_ld(&bar[XB_XGEN(b.x)]) == gen, bar);
            __builtin_amdgcn_fence(__ATOMIC_ACQUIRE, "agent");
            asm volatile("s_waitcnt vmcnt(0)" ::: "memory");
        }
    }
    __syncthreads();
}
struct Ctx {
    LAS unsigned char* lds; int tid, lane, wave, vcu, G;
    const float* in[25]; float* out; unsigned char* ws;
};
#define IN_X 0
#define IN_LN_MIX_G 1
#define IN_W_IN 2
#define IN_B_ATTN 3
#define IN_MU 4
#define IN_W0 5
#define IN_W2 6
#define IN_A0 7
#define IN_A2 8
#define IN_G2 9
#define IN_K_K 10
#define IN_K_A 11
#define IN_R_K 12
#define IN_LNX_G 13
#define IN_LNX_B 14
#define IN_SINKS 15
#define IN_ATTN_G 16
#define IN_W_OUT 17
#define IN_LN_FFN_G 18
#define IN_W_UP 19
#define IN_W_GATE 20
#define IN_CONV_W 21
#define IN_CONV_B 22
#define IN_W_DOWN 23
#define IN_LN_FINAL_G 24

__device__ __forceinline__ void transpose_item(const float* W, int K, int N, bf16* WT, int drow0, LAS float* scr, int k0, int n0, int lane) {
#pragma unroll 8
    for (int i = 0; i < 32; ++i) { const int kk = 2 * i + (lane >> 5); scr[kk * 33 + (lane & 31)] = W[(size_t)(k0 + kk) * N + n0 + (lane & 31)]; }
    LDS_WAIT(); asm volatile("" ::: "memory");
    const int c = lane & 7;
#pragma unroll
    for (int j = 0; j < 4; ++j) { const int n = (lane >> 3) + 8 * j; const LAS float* s = scr + (8 * c) * 33 + n;
        v4u o; o.x = pk2(s[0 * 33], s[1 * 33]); o.y = pk2(s[2 * 33], s[3 * 33]); o.z = pk2(s[4 * 33], s[5 * 33]); o.w = pk2(s[6 * 33], s[7 * 33]);
        *(GAS v4u*)(WT + (size_t)(drow0 + n) * K + k0 + 8 * c) = o; }
    LDS_WAIT(); asm volatile("" ::: "memory");
}
__device__ __forceinline__ void rms_row_to_bf16(const float* xrow, const float* g, bf16* orow, int lane) {
    const GAS f32x4* xr = (const GAS f32x4*)xrow + lane; const GAS f32x4* gr = (const GAS f32x4*)g + lane;
    f32x4 v[8]; float s = 0.f;
#pragma unroll
    for (int j = 0; j < 8; ++j) { v[j] = xr[64 * j]; s += (v[j].x * v[j].x + v[j].y * v[j].y) + (v[j].z * v[j].z + v[j].w * v[j].w); }
    const float rs = 1.0f / sqrtf(wave_sum(s) * (1.f / D_) + NORM_EPS);
    GAS unsigned long long* o8 = (GAS unsigned long long*)orow + lane;
#pragma unroll
    for (int j = 0; j < 8; ++j) { const f32x4 gg = gr[64 * j]; o8[64 * j] = (unsigned long long)pk2(v[j].x * rs * gg.x, v[j].y * rs * gg.y) | ((unsigned long long)pk2(v[j].z * rs * gg.z, v[j].w * rs * gg.w) << 32); }
}

__device__ __forceinline__ void ph_prologue(Ctx& F) {
    LAS float* scr = (LAS float*)(F.lds + F.wave * 16384);
    const int gw = F.vcu * NWAVES + F.wave, NGW = F.G * NWAVES, gt = gw * 64 + F.lane, NGT = NGW * 64;
    bf16* WIN = (bf16*)(F.ws + WS_WIN); bf16* WOUT = (bf16*)(F.ws + WS_WOUT); bf16* HN = (bf16*)(F.ws + WS_HN);
    constexpr int I_IN = (D_ / 64) * (INW / 32), I_OUT = (D_ / 64) * (D_ / 32);
    for (int it = gw; it < I_IN + I_OUT; it += NGW) {
        if (it < I_IN) { const int nblk = INW / 32, kb = it / nblk, nb = it % nblk; transpose_item(F.in[IN_W_IN], D_, INW, WIN, 32 * nb, scr, 64 * kb, 32 * nb, F.lane); }
        else { const int r = it - I_IN, nblk = D_ / 32, kb = r / nblk, nb = r % nblk; transpose_item(F.in[IN_W_OUT], D_, D_, WOUT, 32 * nb, scr, 64 * kb, 32 * nb, F.lane); }
    }
    { GAS v4u* p = (GAS v4u*)(WIN + (size_t)INW * D_); const int n16 = (NIN - INW) * D_ * 2 / 16; for (int i = gt; i < n16; i += NGT) p[i] = (v4u){0u, 0u, 0u, 0u}; }
    { float* b = (float*)(F.ws + WS_MISC + MISC_BIAS); for (int i = gt; i < NIN; i += NGT) b[i] = (i >= RIN && i < INW) ? F.in[IN_B_ATTN][i - RIN] : 0.f; }
    { float* rt = (float*)(F.ws + WS_MISC + MISC_ROPE);
      for (int i = gt; i < T_ * 8; i += NGT) { const int t = i >> 3, k = i & 7;
          const float invf = k == 0 ? 1.0f : k == 1 ? 0x1.8d275ep-3f : k == 2 ? 0x1.341190p-5f : k == 3 ? 0x1.ddee9cp-8f : k == 4 ? 0x1.72ba44p-10f : k == 5 ? 0x1.1f91f0p-12f : k == 6 ? 0x1.be2188p-15f : 0x1.5a0f4ep-17f;
          const float ang = (float)t * invf;
          const double a = (double)ang, kq = rint(a * 0.15915494309189535), rr = fma(-kq, 6.283185307179586, a); const float rf = (float)rr;
          rt[t * 16 + k] = cosf(rf); rt[t * 16 + 8 + k] = sinf(rf); } }
    for (int m = gw; m < T_; m += NGW) rms_row_to_bf16(F.in[IN_X] + (size_t)m * D_, F.in[IN_LN_MIX_G], HN + (size_t)m * D_, F.lane);
}
__device__ __forceinline__ void ph_ffn_weights(Ctx& F) {
    LAS float* scr = (LAS float*)(F.lds + F.wave * 16384);
    const int gw = F.vcu * NWAVES + F.wave, NGW = F.G * NWAVES;
    bf16* WUG = (bf16*)(F.ws + WS_WUG); bf16* WDN = (bf16*)(F.ws + WS_WDN);
    constexpr int I_UP = (D_ / 64) * (DFF / 32), I_DN = (DFF / 64) * (D_ / 32);
    for (int it = gw; it < 2 * I_UP + I_DN; it += NGW) {
        if (it < 2 * I_UP) { const int gate = it >= I_UP, r = gate ? it - I_UP : it, nblk = DFF / 32, kb = r / nblk, nb = r % nblk, n0 = 32 * nb;
            transpose_item(F.in[gate ? IN_W_GATE : IN_W_UP], D_, DFF, WUG, 256 * (n0 >> 7) + (n0 & 127) + (gate ? 128 : 0), scr, 64 * kb, n0, F.lane); }
        else { const int r = it - 2 * I_UP, nblk = D_ / 32, kb = r / nblk, nb = r % nblk; transpose_item(F.in[IN_W_DOWN], DFF, D_, WDN, 32 * nb, scr, 64 * kb, 32 * nb, F.lane); }
    }
}
__device__ __forceinline__ void ph_attention_naive(Ctx& F) {
    const bf16* Z = (const bf16*)(F.ws + WS_Z); bf16* YC = (bf16*)(F.ws + WS_HN); const float* rope = (const float*)(F.ws + WS_MISC + MISC_ROPE);
    float* ssqA = (float*)(F.ws + WS_CTL) + CW_SSQA;
    for (int it = F.vcu; it < 64 * NH; it += F.G) {
        const int nb = it >> 4, h = it & 15, kvh = h >> 3, q = F.tid >> 2, p = F.tid & 3, t = 128 * nb + q;
        float qv[64];
        { const bf16* qp = Z + (size_t)t * NIN + COL_Q + h * 64;
#pragma unroll
          for (int d = 0; d < 64; d += 8) { const v4u w = *(const GAS v4u*)(qp + d); const unsigned ww[4] = {w.x, w.y, w.z, w.w};
#pragma unroll
              for (int e = 0; e < 4; ++e) { qv[d + 2 * e] = bf2f(ww[e] & 0xffffu); qv[d + 2 * e + 1] = bf2f(ww[e] >> 16); } }
#pragma unroll
          for (int i = 0; i < 8; ++i) { const float c = rope[t * 16 + i], s = rope[t * 16 + 8 + i], x1 = qv[i], x2 = qv[8 + i]; qv[i] = x1 * c - x2 * s; qv[8 + i] = x2 * c + x1 * s; } }
        float m = -INFINITY, l = 0.f, o[64];
#pragma unroll
        for (int d = 0; d < 64; ++d) o[d] = 0.f;
        for (int i = 0; i < 32; ++i) {
            const int kp = t - 127 + 32 * p + i;
            if (kp >= 0) {
                const bf16* kr = Z + (size_t)kp * NIN + COL_KA + kvh * 64; const bf16* vr = Z + (size_t)kp * NIN + COL_VA + kvh * 64;
                float kv[16];
                { const v4u w0 = *(const GAS v4u*)(kr), w1 = *(const GAS v4u*)(kr + 8); const unsigned ww[8] = {w0.x, w0.y, w0.z, w0.w, w1.x, w1.y, w1.z, w1.w};
#pragma unroll
                  for (int e = 0; e < 8; ++e) { kv[2 * e] = bf2f(ww[e] & 0xffffu); kv[2 * e + 1] = bf2f(ww[e] >> 16); } }
                float s = 0.f;
#pragma unroll
                for (int j = 0; j < 8; ++j) { const float c = rope[kp * 16 + j], sn = rope[kp * 16 + 8 + j], x1 = kv[j], x2 = kv[8 + j]; s += qv[j] * (x1 * c - x2 * sn) + qv[8 + j] * (x2 * c + x1 * sn); }
#pragma unroll
                for (int d = 16; d < 64; d += 8) { const v4u w = *(const GAS v4u*)(kr + d); const unsigned ww[4] = {w.x, w.y, w.z, w.w};
#pragma unroll
                    for (int e = 0; e < 4; ++e) s += qv[d + 2 * e] * bf2f(ww[e] & 0xffffu) + qv[d + 2 * e + 1] * bf2f(ww[e] >> 16); }
                s *= 0.125f;
                const float mn = fmaxf(m, s), al = __expf(m - mn), pe = __expf(s - mn);
                l = l * al + pe; m = mn;
#pragma unroll
                for (int d = 0; d < 64; d += 8) { const v4u w = *(const GAS v4u*)(vr + d); const unsigned ww[4] = {w.x, w.y, w.z, w.w};
#pragma unroll
                    for (int e = 0; e < 4; ++e) { o[d + 2 * e] = o[d + 2 * e] * al + pe * bf2f(ww[e] & 0xffffu); o[d + 2 * e + 1] = o[d + 2 * e + 1] * al + pe * bf2f(ww[e] >> 16); } }
            }
        }
        float M = fmaxf(m, __shfl_xor(m, 1)); M = fmaxf(M, __shfl_xor(M, 2));
        const float sc = (m == -INFINITY) ? 0.f : __expf(m - M);
        l *= sc; l += __shfl_xor(l, 1); l += __shfl_xor(l, 2);
        const float den = 1.0f / (l + __expf(F.in[IN_SINKS][h] - M));
        float sq = 0.f;
#pragma unroll
        for (int d = 0; d < 64; ++d) { float v = o[d] * sc; v += __shfl_xor(v, 1); v += __shfl_xor(v, 2); o[d] = v * den; sq += o[d] * o[d]; }
        if (p == 0) { bf16* op = YC + (size_t)t * D_ + RW + h * 64;
#pragma unroll
            for (int d = 0; d < 64; d += 8) { v4u w; w.x = pk2(o[d], o[d + 1]); w.y = pk2(o[d + 2], o[d + 3]); w.z = pk2(o[d + 4], o[d + 5]); w.w = pk2(o[d + 6], o[d + 7]); *(GAS v4u*)(op + d) = w; }
            atomicAdd(ssqA + t, sq); }
    }
}
__device__ __forceinline__ float zshift(const bf16* Z, const float* mu, int t, int col) {
    const float zc = bf2f(Z[(size_t)t * NIN + col]); const float zp = t > 0 ? bf2f(Z[(size_t)(t - 1) * NIN + col]) : 0.f; return zc + mu[col] * (zp - zc);
}
__device__ __forceinline__ void ph_rwkv_prep_naive(Ctx& F) {
    const bf16* Z = (const bf16*)(F.ws + WS_Z); const float* mu = F.in[IN_MU];
    bf16* KK = (bf16*)(F.ws + WS_RWA); bf16* BB = KK + RWA_STRIDE / 2; bf16* KM = BB + RWA_STRIDE / 2; bf16* RS = KM + RWA_STRIDE / 2; bf16* VS = RS + RWA_STRIDE / 2; bf16* GG = VS + RWA_STRIDE / 2;
    float* LW = F.out;
    LAS float* aw = (LAS float*)F.lds; LAS float* aa = aw + 8 * 64; LAS float* ag = aa + 8 * 64;
    for (int grp = F.vcu; grp < T_ / 8; grp += F.G) {
        const int t0 = grp * 8;
        __syncthreads();
        for (int e = F.tid; e < 8 * 288; e += 512) { const int tok = e / 288, j = e % 288; const float v = zshift(Z, mu, t0 + tok, COL_XW + j);
            if (j < 64) aw[tok * 64 + j] = tanhf(v); else if (j < 128) aa[tok * 64 + j - 64] = v; else ag[tok * 160 + j - 128] = 1.0f / (1.0f + __expf(-v)); }
        __syncthreads();
#pragma unroll 1
        for (int cc = 0; cc < 2; ++cc) {
            const int c = F.tid + 512 * cc;
            float wl[8], al[8], gl[8];
#pragma unroll
            for (int k = 0; k < 8; ++k) { wl[k] = 0.f; al[k] = 0.f; gl[k] = 0.f; }
            for (int j = 0; j < 64; ++j) { const float w2v = F.in[IN_W2][j * RW + c], a2v = F.in[IN_A2][j * RW + c];
#pragma unroll
                for (int k = 0; k < 8; ++k) { wl[k] += aw[k * 64 + j] * w2v; al[k] += aa[k * 64 + j] * a2v; } }
            for (int j = 0; j < 160; ++j) { const float g2v = F.in[IN_G2][j * RW + c];
#pragma unroll
                for (int k = 0; k < 8; ++k) gl[k] += ag[k * 160 + j] * g2v; }
            const float w0 = F.in[IN_W0][c], a0 = F.in[IN_A0][c], kkc = F.in[IN_K_K][c], kac = F.in[IN_K_A][c];
#pragma unroll
            for (int k = 0; k < 8; ++k) { const int t = t0 + k; const size_t o = (size_t)t * RW + c;
                const float x = w0 + wl[k];
                const float sp = (x < -20.f) ? -x : log1pf(__expf(-x));
                LW[o] = -__expf(-sp - 0.5f);
                const float a = 1.0f / (1.0f + __expf(-(a0 + al[k])));
                const float kraw = zshift(Z, mu, t, COL_K + c), kkv = kraw * kkc;
                const float nrm = fmaxf(sqrtf(wave_sum(kkv * kkv)), 1e-12f); const float kn = kkv / nrm;
                KK[o] = (bf16)f2bf(kn); BB[o] = (bf16)f2bf(kn * a); KM[o] = (bf16)f2bf(kraw * (1.0f + (a - 1.0f) * kac));
                RS[o] = (bf16)f2bf(zshift(Z, mu, t, COL_R + c)); VS[o] = (bf16)f2bf(zshift(Z, mu, t, COL_V + c)); GG[o] = (bf16)f2bf(gl[k]); }
        }
    }
}
__device__ __forceinline__ void ph_rwkv_scan_naive(Ctx& F) {
    if (F.vcu >= NH || F.wave != 0) return;
    const int h = F.vcu, l = F.lane;
    const bf16* KK = (const bf16*)(F.ws + WS_RWA); const bf16* BB = KK + RWA_STRIDE / 2; const bf16* KM = BB + RWA_STRIDE / 2; const bf16* RS = KM + RWA_STRIDE / 2; const bf16* VS = RS + RWA_STRIDE / 2;
    const float* LW = F.out; float* Y = F.out + (size_t)T_ * RW;
    float S[64];
#pragma unroll
    for (int j = 0; j < 64; ++j) S[j] = 0.f;
    size_t o = (size_t)h * 64 + l;
    float n_lw = LW[o]; unsigned n_kk = KK[o], n_bb = BB[o], n_km = KM[o], n_rs = RS[o], n_vs = VS[o];
    for (int t = 0; t < T_; ++t) {
        const float w = __expf(n_lw), kk = bf2f(n_kk), bb = bf2f(n_bb), km = bf2f(n_km), r = bf2f(n_rs), v = bf2f(n_vs);
        if (t + 1 < T_) { const size_t o2 = (size_t)(t + 1) * RW + h * 64 + l; n_lw = LW[o2]; n_kk = KK[o2]; n_bb = BB[o2]; n_km = KM[o2]; n_rs = RS[o2]; n_vs = VS[o2]; }
        float sa = 0.f;
#pragma unroll
        for (int j = 0; j < 64; ++j) sa += S[j] * __builtin_bit_cast(float, __builtin_amdgcn_readlane(__builtin_bit_cast(int, kk), j));
        sa = -sa;
        float y = 0.f;
#pragma unroll
        for (int j = 0; j < 64; ++j) {
            const float wj = __builtin_bit_cast(float, __builtin_amdgcn_readlane(__builtin_bit_cast(int, w), j)), bj = __builtin_bit_cast(float, __builtin_amdgcn_readlane(__builtin_bit_cast(int, bb), j));
            const float kj = __builtin_bit_cast(float, __builtin_amdgcn_readlane(__builtin_bit_cast(int, km), j)), rj = __builtin_bit_cast(float, __builtin_amdgcn_readlane(__builtin_bit_cast(int, r), j));
            S[j] = S[j] * wj + (sa * bj + v * kj); y += S[j] * rj; }
        Y[(size_t)t * RW + h * 64 + l] = y;
    }
}
__device__ __forceinline__ void ph_post(Ctx& F) {
    const bf16* KM = (const bf16*)(F.ws + WS_RWA) + 2 * (RWA_STRIDE / 2); const bf16* RS = KM + RWA_STRIDE / 2; const bf16* VS = RS + RWA_STRIDE / 2; const bf16* GG = VS + RWA_STRIDE / 2;
    const float* Y = F.out + (size_t)T_ * RW; bf16* YC = (bf16*)(F.ws + WS_HN); const float* ssqA = (const float*)(F.ws + WS_CTL) + CW_SSQA;
    const int gw = F.vcu * NWAVES + F.wave, NGW = F.G * NWAVES, l = F.lane;
    for (int it = gw; it < T_ * NH; it += NGW) {
        const int t = it >> 4, h = it & 15, c = h * 64 + l; const size_t o = (size_t)t * RW + c;
        const float y = Y[o]; const float mu = wave_sum(y) * (1.f / 64.f); const float d = y - mu; const float var = wave_sum(d * d) * (1.f / 64.f);
        const float yn = d * (1.0f / sqrtf(var + LNX_EPS)) * F.in[IN_LNX_G][c] + F.in[IN_LNX_B][c];
        const float r = bf2f(RS[o]), k = bf2f(KM[o]), v = bf2f(VS[o]), g = bf2f(GG[o]);
        const float bonus = wave_sum(r * k * F.in[IN_R_K][c]) * v;
        YC[(size_t)t * D_ + c] = (bf16)f2bf((yn + bonus) * g);
    }
    for (int t = gw; t < T_; t += NGW) {
        const float sc = 1.0f / sqrtf(ssqA[t] * (1.f / RW) + NORM_EPS);
        bf16* p = YC + (size_t)t * D_ + RW;
#pragma unroll
        for (int j = 0; j < 16; ++j) { const int c = j * 64 + l; p[c] = (bf16)f2bf(bf2f(p[c]) * sc * F.in[IN_ATTN_G][c]); }
    }
}
__device__ __forceinline__ void ph_final(Ctx& F) {
    const float* ssq3 = (const float*)(F.ws + WS_CTL) + CW_SSQ3; const int gw = F.vcu * NWAVES + F.wave, NGW = F.G * NWAVES;
    for (int t = gw; t < T_; t += NGW) {
        const float sc = 1.0f / sqrtf(ssq3[t] * (1.f / D_) + NORM_EPS);
        GAS f32x4* xr = (GAS f32x4*)(F.out + (size_t)t * D_) + F.lane; const GAS f32x4* gr = (const GAS f32x4*)F.in[IN_LN_FINAL_G] + F.lane;
#pragma unroll
        for (int j = 0; j < 8; ++j) { const f32x4 v = xr[64 * j], g = gr[64 * j]; xr[64 * j] = v * sc * g; }
    }
}
constexpr int N_PHASES = 11;
constexpr int N_LAUNCHES = MK_N_LAUNCHES;
struct Args { const float* in[25]; float* out; unsigned char* ws; int ph_lo, ph_hi, li, pad; };
__global__ void __launch_bounds__(NWAVES * 64, 2) mk_fwd(Args args) {
    extern __shared__ __attribute__((aligned(16))) unsigned char lds[];
    Ctx F;
    F.lds = (LAS unsigned char*)lds;
    F.tid = threadIdx.x; F.lane = F.tid & 63; F.wave = __builtin_amdgcn_readfirstlane(F.tid >> 6);
    F.G = gridDim.x; { const int bx = blockIdx.x; F.vcu = (F.G % 8 == 0) ? (bx % 8) * (F.G / 8) + bx / 8 : bx; }
#pragma unroll
    for (int i = 0; i < 25; ++i) F.in[i] = args.in[i];
    F.out = args.out; F.ws = args.ws;
    volatile LAS unsigned* MISC = (volatile LAS unsigned*)(F.lds + MISC_OFF);
    for (int u = F.tid; u < (LDS_BYTES - LDSCTL_OFF) / 4; u += NWAVES * 64) ((LAS unsigned*)(F.lds + LDSCTL_OFF))[u] = 0u;
    __syncthreads();
    gu32* ctl = (gu32*)(F.ws + WS_CTL);
    XcdBarrier bar; bar.bar = (unsigned*)(ctl + CW_BAR); bar.x = 0; bar.st = nullptr;
    const int lo = args.ph_lo, hi = args.ph_hi;
    if (hi - lo > 1) bar = xcd_barrier_post((unsigned*)(ctl + CW_BAR), MISC + 8);
#define IN(k) (lo <= (k) && (k) < hi)
#define SEAM(k) do { if (IN(k) && IN((k) + 1)) xcd_barrier(bar); } while (0)
    float* ssq = (float*)(F.ws + WS_CTL);
    bf16* HN = (bf16*)(F.ws + WS_HN); bf16* Z = (bf16*)(F.ws + WS_Z); bf16* H2 = (bf16*)(F.ws + WS_H2); bf16* ACT = (bf16*)(F.ws + WS_ACT);

    if (IN(0)) { ph_prologue(F); } SEAM(0);
    if (IN(1)) {
        pg8::Gemm g{HN, (const bf16*)(F.ws + WS_WIN), T_, NIN, D_, 0L, 256L * D_ * 2}; pg8::StaticOrder S; S.init(T_, NIN, F.G, (int)blockIdx.x);
        pg8::EpiZ E{Z, NIN, (const float*)(F.ws + WS_MISC + MISC_BIAS)};
        pg8::gemm_phase<pg8::EpiZ, pg8::StaticOrder, true, true>(F.lds, g, S, E);
    } SEAM(1);
    if (IN(2)) { ph_attention_naive(F); } SEAM(2);
    if (IN(3)) { ph_rwkv_prep_naive(F); } SEAM(3);
    if (IN(4)) { ph_rwkv_scan_naive(F); } SEAM(4);
    if (IN(5)) { ph_post(F); } SEAM(5);
    if (IN(6)) {
        pg8::Gemm g{HN, (const bf16*)(F.ws + WS_WOUT), T_, D_, D_, 0L, 256L * D_ * 2}; pg8::StaticOrder S; S.init(T_, D_, F.G, (int)blockIdx.x);
        pg8::EpiRes E{F.in[IN_X], F.out, D_, H2, F.in[IN_LN_FFN_G], ssq + CW_SSQ2};
        pg8::gemm_phase<pg8::EpiRes, pg8::StaticOrder, true, true>(F.lds, g, S, E);
    } SEAM(6);
    if (IN(7)) { ph_ffn_weights(F); } SEAM(7);
    if (IN(8)) {
        pg8::Gemm g{H2, (const bf16*)(F.ws + WS_WUG), T_, NUG, D_, -2L * D_ * 2, 254L * D_ * 2}; pg8::StaticOrder S; S.initT(33, NUG / 256, F.G, (int)blockIdx.x);
        pg8::EpiUpGate E{ACT, ssq + CW_SSQ2, F.in[IN_CONV_W], F.in[IN_CONV_B], (LAS float*)(F.lds + XCH_OFF), T_, DFF, 1.0f / D_, NORM_EPS};
        pg8::gemm_phase<pg8::EpiUpGate, pg8::StaticOrder, true, true>(F.lds, g, S, E);
    } SEAM(8);
    if (IN(9)) {
        pg8::Gemm g{ACT, (const bf16*)(F.ws + WS_WDN), T_, D_, DFF, 0L, 256L * DFF * 2}; pg8::StaticOrder S; S.init(T_, D_, F.G, (int)blockIdx.x);
        pg8::EpiRes E{F.out, F.out, D_, nullptr, nullptr, ssq + CW_SSQ3};
        pg8::gemm_phase<pg8::EpiRes, pg8::StaticOrder, true, true>(F.lds, g, S, E);
    } SEAM(9);
    if (IN(10)) { ph_final(F); }
#undef IN
#undef SEAM
}

extern "C" void kernel_launch(void* const* d_in, const int* in_sizes, int n_in, void* d_out, int out_size, void* d_ws, size_t ws_size, hipStream_t stream) {
    static int grid = 0;
    if (grid == 0) {
        if (n_in != 25 || in_sizes[0] != T_ * D_ || out_size != T_ * D_ || ws_size < WS_END) { fprintf(stderr, "kernel_launch: unexpected shapes (n_in %d, in0 %d, out %d, ws %zu)\n", n_in, n_in > 0 ? in_sizes[0] : -1, out_size, ws_size); grid = -1; return; }
        int dev = 0, cus = 0;
        if (hipGetDevice(&dev) != hipSuccess || hipDeviceGetAttribute(&cus, hipDeviceAttributeMultiprocessorCount, dev) != hipSuccess) { grid = -1; return; }
        if (hipFuncSetAttribute((const void*)mk_fwd, hipFuncAttributeMaxDynamicSharedMemorySize, LDS_BYTES) != hipSuccess) { fprintf(stderr, "kernel_launch: hipFuncSetAttribute failed\n"); grid = -1; return; }
        (void)hipGetLastError();
        grid = cus;
    }
    if (grid < 0) return;
    if (hipMemsetAsync((char*)d_ws + WS_CTL, 0, CTL_ZERO_BYTES, stream) != hipSuccess) return;
    Args a{};
    for (int i = 0; i < 25; ++i) a.in[i] = (const float*)d_in[i];
    a.out = (float*)d_out; a.ws = (unsigned char*)d_ws;
    if (N_LAUNCHES == 1) { a.ph_lo = 0; a.ph_hi = N_PHASES; a.li = 0; hipLaunchKernelGGL(mk_fwd, dim3(grid), dim3(NWAVES * 64), LDS_BYTES, stream, a); }
    else for (int ph = 0; ph < N_PHASES; ++ph) { a.ph_lo = ph; a.ph_hi = ph + 1; a.li = 0; hipLaunchKernelGGL(mk_fwd, dim3(grid), dim3(NWAVES * 64), LDS_BYTES, stream, a); }
}
```

```cpp
#include <hip/hip_runtime.h>
#include <cstdio>
#include <cstdint>
#define MK_N_LAUNCHES 1
namespace pg8 {
#define PG8_LAS __attribute__((address_space(3)))
typedef unsigned short bf16_t;
typedef short bf16x8 __attribute__((ext_vector_type(8)));
typedef float f32x4 __attribute__((ext_vector_type(4)));
typedef unsigned u32x4 __attribute__((ext_vector_type(4)));
constexpr int BM = 256, BK = 64, HALF = 128, HTB = HALF * BK * 2  , STAGE_BYTES = 8 * HTB, NXCD = 8, WGM = 8;

__host__ __device__ __forceinline__ int lds_byte(int r, int c) { const int st = (r >> 4) * 2 + (c >> 5), rr = r & 15, cc = c & 31, ob = rr * 64 + cc * 2; return st * 1024 + (ob ^ (((ob >> 9) & 1) << 5)); }
__host__ __device__ __forceinline__ void stage_rc(int b, int& R, int& C) { const int st = b / 1024, sb = b % 1024, swz = sb ^ (((sb >> 9) & 1) << 5); R = (st >> 1) * 16 + swz / 64; C = (st & 1) * 32 + (swz % 64) / 2; }
__host__ __device__ __forceinline__ int perm32(int rho) { const int n = rho >> 4, i = rho & 15; return 8 * (i >> 2) + 4 * n + (i & 3); }

struct Unit { int pm, pn; };
struct Gemm { const bf16_t* A; const bf16_t* Bt; int M, N, K; long a_off, a_tstep; };

struct StaticOrder {
    int nM, nN, nwg, G, c;
    __host__ __device__ void init(int M, int N, int G_, int c_) { nM = M / BM; nN = N / BM; nwg = nM * nN; G = G_; c = c_; }
    __host__ __device__ void initT(int nM_, int nN_, int G_, int c_) { nM = nM_; nN = nN_; nwg = nM * nN; G = G_; c = c_; }
    __host__ __device__ bool next(int i, Unit& u) const {
        const long L = (long)i * G + c; if (L >= nwg) return false;
        int wgid = (int)L; { const int q = nwg / NXCD, r = nwg % NXCD, xcd = wgid % NXCD, off = wgid / NXCD; wgid = (xcd < r ? xcd * (q + 1) : r * (q + 1) + (xcd - r) * q) + off; }
        const int nig = WGM * nN, gid = wgid / nig, fm = gid * WGM, gsz = (nM - fm) < WGM ? (nM - fm) : WGM;
        u.pm = fm + ((wgid % nig) % gsz); u.pn = (wgid % nig) / gsz; return true;
    }
    __device__ __forceinline__ void a_ready(const Unit&) const {}
    __device__ __forceinline__ void done(const Unit&) const {}
};

__device__ __forceinline__ unsigned cvt_pk_bf16(float lo, float hi) { unsigned r; asm volatile("v_cvt_pk_bf16_f32 %0, %1, %2" : "=v"(r) : "v"(lo), "v"(hi)); return r; }
typedef unsigned u32x2 __attribute__((ext_vector_type(2)));

struct EpiZ {
    static constexpr bool PERM = true, AFTER_DRAIN = false;
    bf16_t* O; int ldc; const float* bias;
    __device__ __forceinline__ void operator()(const f32x4 (&acc)[2][2][4][2], const Unit& u, int wr, int wc, int fr, int fq) const {
        const int row0 = u.pm * BM + wr * 64 + fr; const int col0 = u.pn * BM + wc * 32 + 8 * fq;
        f32x4 bv[2][2];
#pragma unroll
        for (int bj = 0; bj < 2; ++bj)
#pragma unroll
            for (int n = 0; n < 2; ++n) bv[bj][n] = *(const f32x4*)(bias + col0 + bj * HALF + 4 * n);
#pragma unroll
        for (int ai = 0; ai < 2; ++ai)
#pragma unroll
            for (int m = 0; m < 4; ++m) { bf16_t* rowp = O + (size_t)(row0 + ai * HALF + m * 16) * ldc + col0;
#pragma unroll
                for (int bj = 0; bj < 2; ++bj) { const f32x4 v0 = acc[ai][bj][m][0] + bv[bj][0], v1 = acc[ai][bj][m][1] + bv[bj][1];
                    u32x4 w; w.x = cvt_pk_bf16(v0[0], v0[1]); w.y = cvt_pk_bf16(v0[2], v0[3]); w.z = cvt_pk_bf16(v1[0], v1[1]); w.w = cvt_pk_bf16(v1[2], v1[3]);
                    *(u32x4*)(rowp + bj * HALF) = w; } }
    }
};
struct EpiRes {
    static constexpr bool PERM = false, AFTER_DRAIN = false;
    const float* base; float* out; int ldc; bf16_t* hb; const float* gain; float* ssq;
    __device__ __forceinline__ void operator()(const f32x4 (&acc)[2][2][4][2], const Unit& u, int wr, int wc, int fr, int fq) const {
        const int row0 = u.pm * BM + wr * 64 + fr, col0 = u.pn * BM + wc * 32 + 4 * fq;
        f32x4 gv[2][2];
#pragma unroll
        for (int bj = 0; bj < 2; ++bj)
#pragma unroll
            for (int n = 0; n < 2; ++n) gv[bj][n] = hb ? *(const f32x4*)(gain + col0 + bj * HALF + n * 16) : (f32x4){0.f, 0.f, 0.f, 0.f};
#pragma unroll
        for (int ai = 0; ai < 2; ++ai)
#pragma unroll
            for (int m = 0; m < 4; ++m) { const int row = row0 + ai * HALF + m * 16; const size_t off = (size_t)row * ldc + col0; float q = 0.f;
#pragma unroll
                for (int bj = 0; bj < 2; ++bj)
#pragma unroll
                    for (int n = 0; n < 2; ++n) { const f32x4 x1 = *(const f32x4*)(base + off + bj * HALF + n * 16) + acc[ai][bj][m][n];
                        *(f32x4*)(out + off + bj * HALF + n * 16) = x1; q += (x1[0] * x1[0] + x1[1] * x1[1]) + (x1[2] * x1[2] + x1[3] * x1[3]);
                        if (hb) { const f32x4 h = x1 * gv[bj][n]; u32x2 w; w.x = cvt_pk_bf16(h[0], h[1]); w.y = cvt_pk_bf16(h[2], h[3]); *(u32x2*)(hb + off + bj * HALF + n * 16) = w; } }
                q += __shfl_xor(q, 16); q += __shfl_xor(q, 32);
                if (fq == 0) atomicAdd(ssq + row, q); }
    }
};
struct EpiUpGate {
    static constexpr bool PERM = true, AFTER_DRAIN = false;
    bf16_t* act; const float* ssq; const float* cw; const float* cb; PG8_LAS float* xch; int T, F; float invD, eps;
    __device__ __forceinline__ void operator()(const f32x4 (&acc)[2][2][4][2], const Unit& u, int wr, int wc, int fr, int fq) const {
        const int lane = fr + 16 * fq, wid = wr * 4 + wc;
        const int trow0 = 254 * u.pm - 2, f0 = 128 * u.pn + wc * 32 + 8 * fq;
        f32x4 uu[2][4][2], gg[2][4][2];
#pragma unroll
        for (int ai = 0; ai < 2; ++ai)
#pragma unroll
            for (int m = 0; m < 4; ++m) { const int t = trow0 + ai * HALF + wr * 64 + m * 16 + fr; float s = 0.f;
                if (t >= 0 && t < T) s = __builtin_amdgcn_rsqf(ssq[t] * invD + eps);
#pragma unroll
                for (int n = 0; n < 2; ++n) { uu[ai][m][n] = acc[ai][0][m][n] * s; gg[ai][m][n] = acc[ai][1][m][n] * s; } }
        if (fr >= 14) {
#pragma unroll
            for (int ai = 0; ai < 2; ++ai)
#pragma unroll
                for (int n = 0; n < 2; ++n) *(PG8_LAS f32x4*)(xch + ((((wid * 2 + ai) * 2 + (fr - 14)) * 4 + fq) * 2 + n) * 4) = uu[ai][3][n];
        }
        asm volatile("s_waitcnt lgkmcnt(0)" ::: "memory"); __builtin_amdgcn_s_barrier(); asm volatile("" ::: "memory");
        f32x4 pg[2][2];
#pragma unroll
        for (int ai = 0; ai < 2; ++ai)
#pragma unroll
            for (int n = 0; n < 2; ++n) { pg[ai][n] = (f32x4){0.f, 0.f, 0.f, 0.f};
                const int swid = wr ? wid - 4 : wid + 4, sai = wr ? ai : ai - 1;
                if (fr >= 14 && sai >= 0) pg[ai][n] = *(const PG8_LAS f32x4*)(xch + ((((swid * 2 + sai) * 2 + (fr - 14)) * 4 + fq) * 2 + n) * 4); }
        f32x4 w0[2], w1[2], w2[2], bb[2];
#pragma unroll
        for (int n = 0; n < 2; ++n) { w0[n] = *(const f32x4*)(cw + f0 + 4 * n); w1[n] = *(const f32x4*)(cw + F + f0 + 4 * n); w2[n] = *(const f32x4*)(cw + 2 * F + f0 + 4 * n); bb[n] = *(const f32x4*)(cb + f0 + 4 * n); }
        const int src1 = (lane & ~15) | ((lane - 1) & 15), src2 = (lane & ~15) | ((lane - 2) & 15);
#pragma unroll
        for (int ai = 0; ai < 2; ++ai)
#pragma unroll
            for (int m = 0; m < 4; ++m) { const int r = ai * HALF + wr * 64 + m * 16 + fr, t = trow0 + r; f32x4 o[2];
#pragma unroll
                for (int n = 0; n < 2; ++n) { const f32x4 U = uu[ai][m][n], PG = (m == 0) ? pg[ai][n] : uu[ai][m == 0 ? 0 : m - 1][n];
#pragma unroll
                    for (int c = 0; c < 4; ++c) { const float s1 = (fr == 15) ? PG[c] : U[c], s2 = (fr >= 14) ? PG[c] : U[c];
                        const float p1 = __shfl(s1, src1), p2 = __shfl(s2, src2);
                        const float cv = bb[n][c] + w2[n][c] * U[c] + w1[n][c] * p1 + w0[n][c] * p2;
                        const float sg = cv * __builtin_amdgcn_rcpf(1.0f + __expf(-cv));
                        o[n][c] = sg * gg[ai][m][n][c]; } }
                if (r >= 2 && t < T) { u32x4 w; w.x = cvt_pk_bf16(o[0][0], o[0][1]); w.y = cvt_pk_bf16(o[0][2], o[0][3]); w.z = cvt_pk_bf16(o[1][0], o[1][1]); w.w = cvt_pk_bf16(o[1][2], o[1][3]);
                    *(u32x4*)(act + (size_t)t * F + f0) = w; } }
    }
};
template <class Epi, class Sched, bool ALIGN_EPI = false, bool SP2 = false>
__device__ __forceinline__ void gemm_phase(PG8_LAS unsigned char* lds, const Gemm g, const Sched& S, const Epi& E) {
    const int tid = threadIdx.x, wid = __builtin_amdgcn_readfirstlane(tid >> 6), lane = tid & 63, wr = wid >> 2, wc = wid & 3, fr = lane & 15, fq = lane >> 4;
    const int K = g.K, nt = K / BK;
    unsigned voffA[2], voffB[2];
#pragma unroll
    for (int i = 0; i < 2; ++i) { int R, C; stage_rc(tid * 16 + i * 8192, R, C); const int Rb = Epi::PERM ? ((R & ~31) + perm32(R & 31)) : R;
        voffA[i] = (unsigned)(R * K + C) * 2u; voffB[i] = (unsigned)(Rb * K + C) * 2u; }
    const size_t kstep = (size_t)(BK * 2);
    const size_t hstep = (size_t)HALF * K * 2;
    const size_t tstep = 2 * hstep;
    const unsigned ldsw = (unsigned)wid * 1024u;
    const int aoff = lds_byte(wr * 64 + fr, fq * 8), boff = lds_byte(wc * 32 + fr, fq * 8);
#define PG8_SA(b, h) (((b) * 2 + (h)) * HTB)
#define PG8_SB(b, h) ((4 + (b) * 2 + (h)) * HTB)
#define PG8_STAGE(bufoff, gbase, voff) do { _Pragma("unroll") for (int _i = 0; _i < 2; ++_i) \
        __builtin_amdgcn_global_load_lds((const unsigned*)((const char*)(gbase) + (voff)[_i]), (PG8_LAS unsigned*)(lds + (bufoff) + ldsw + _i * 8192), 16, 0, 0); } while (0)
#define PG8_LDA(dst, b, h) do { _Pragma("unroll") for (int m = 0; m < 4; ++m) _Pragma("unroll") for (int k = 0; k < 2; ++k) dst[m][k] = *(const PG8_LAS bf16x8*)(lds + PG8_SA(b, h) + aoff + m * 2048 + k * 1024); } while (0)
#define PG8_LDB(dst, b, h) do { _Pragma("unroll") for (int n = 0; n < 2; ++n) _Pragma("unroll") for (int k = 0; k < 2; ++k) dst[n][k] = *(const PG8_LAS bf16x8*)(lds + PG8_SB(b, h) + boff + n * 2048 + k * 1024); } while (0)
#define PG8_MMA(ai, bj, At, Bt) do { __builtin_amdgcn_s_setprio(1); _Pragma("unroll") for (int m = 0; m < 4; ++m) _Pragma("unroll") for (int n = 0; n < 2; ++n) _Pragma("unroll") for (int k = 0; k < 2; ++k) \
        acc[ai][bj][m][n] = __builtin_amdgcn_mfma_f32_16x16x32_bf16(Bt[n][k], At[m][k], acc[ai][bj][m][n], 0, 0, 0); __builtin_amdgcn_s_setprio(0); } while (0)
#define PG8_WAIT_V(n) asm volatile("s_waitcnt vmcnt(" #n ")" ::: "memory")
#define PG8_WAIT_L(n) asm volatile("s_waitcnt lgkmcnt(" #n ")" ::: "memory")
#define PG8_BAR __builtin_amdgcn_s_barrier()
#define PG8_SCHED __builtin_amdgcn_sched_barrier(0)
    Unit cur, nxt; int ui = 0;
    if (!S.next(0, cur)) return;
    f32x4 acc[2][2][4][2];
#pragma unroll
    for (int a = 0; a < 2; ++a)
#pragma unroll
        for (int b = 0; b < 2; ++b)
#pragma unroll
            for (int m = 0; m < 4; ++m)
#pragma unroll
                for (int n = 0; n < 2; ++n) acc[a][b][m][n] = (f32x4){0.f, 0.f, 0.f, 0.f};
    bf16x8 At[4][2], B0[2][2], B1[2][2];
    const char* cA = (const char*)g.A + g.a_off + (long)cur.pm * g.a_tstep; const char* cB = (const char*)g.Bt + (size_t)cur.pn * tstep;
    S.a_ready(cur);
    if constexpr (SP2) {
        PG8_STAGE(PG8_SB(0, 0), cB, voffB); PG8_STAGE(PG8_SB(0, 1), cB + hstep, voffB); PG8_STAGE(PG8_SA(0, 0), cA, voffA); PG8_STAGE(PG8_SA(0, 1), cA + hstep, voffA);
        if (wr == 1) PG8_BAR;
        PG8_WAIT_V(2); PG8_BAR;
        PG8_STAGE(PG8_SB(1, 0), cB + kstep, voffB); PG8_STAGE(PG8_SA(1, 0), cA + kstep, voffA); PG8_STAGE(PG8_SB(1, 1), cB + hstep + kstep, voffB);
        PG8_WAIT_V(6); PG8_BAR;
    } else {
        PG8_STAGE(PG8_SB(0, 0), cB, voffB); PG8_STAGE(PG8_SA(0, 0), cA, voffA); PG8_STAGE(PG8_SB(0, 1), cB + hstep, voffB); PG8_STAGE(PG8_SA(0, 1), cA + hstep, voffA);
        if (wr == 1) PG8_BAR;
        PG8_WAIT_V(4); PG8_BAR;
        PG8_STAGE(PG8_SB(1, 0), cB + kstep, voffB); PG8_STAGE(PG8_SA(1, 0), cA + kstep, voffA); PG8_STAGE(PG8_SB(1, 1), cB + hstep + kstep, voffB);
        PG8_WAIT_V(6); PG8_BAR;
    }
    for (;;) {
        const bool has_next = S.next(ui + 1, nxt);
        const char* nA = has_next ? (const char*)g.A + g.a_off + (long)nxt.pm * g.a_tstep : cA; const char* nB = has_next ? (const char*)g.Bt + (size_t)nxt.pn * tstep : cB;
        for (int t = 0; t < nt; t += 2) {
            const bool last = (t == nt - 2);
            const char* a1 = cA + (size_t)(t + 1) * kstep;
            const char* a2 = last ? nA : cA + (size_t)(t + 2) * kstep; const char* b2 = last ? nB : cB + (size_t)(t + 2) * kstep;
            const char* a3 = a2 + kstep; const char* b3 = b2 + kstep;
            if (last && has_next) S.a_ready(nxt);
            if constexpr (SP2) {
            PG8_LDB(B0, 0, 0); PG8_LDB(B1, 0, 1); PG8_SCHED; PG8_LDA(At, 0, 0); PG8_STAGE(PG8_SA(1, 1), a1 + hstep, voffA);
            PG8_WAIT_V(8); PG8_WAIT_L(0); PG8_BAR; PG8_MMA(0, 0, At, B0); PG8_MMA(0, 1, At, B1); PG8_BAR; PG8_SCHED;
            PG8_LDA(At, 0, 1); PG8_STAGE(PG8_SB(0, 0), b2, voffB); PG8_STAGE(PG8_SB(0, 1), b2 + hstep, voffB); PG8_STAGE(PG8_SA(0, 0), a2, voffA);
            PG8_WAIT_V(8); PG8_WAIT_L(0); PG8_BAR; PG8_MMA(1, 0, At, B0); PG8_MMA(1, 1, At, B1); PG8_BAR; PG8_SCHED;
            PG8_LDB(B0, 1, 0); PG8_LDB(B1, 1, 1); PG8_SCHED; PG8_LDA(At, 1, 0); PG8_STAGE(PG8_SA(0, 1), a2 + hstep, voffA);
            PG8_WAIT_V(8); PG8_WAIT_L(0); PG8_BAR; PG8_MMA(0, 0, At, B0); PG8_MMA(0, 1, At, B1); PG8_BAR; PG8_SCHED;
            PG8_LDA(At, 1, 1); PG8_STAGE(PG8_SB(1, 0), b3, voffB); PG8_STAGE(PG8_SB(1, 1), b3 + hstep, voffB); PG8_STAGE(PG8_SA(1, 0), a3, voffA);
            PG8_WAIT_V(8); PG8_WAIT_L(0); PG8_BAR; PG8_MMA(1, 0, At, B0); PG8_MMA(1, 1, At, B1); PG8_BAR; PG8_SCHED;
            } else {
            PG8_LDB(B0, 0, 0); PG8_SCHED; PG8_LDA(At, 0, 0); PG8_STAGE(PG8_SA(1, 1), a1 + hstep, voffA);
            PG8_WAIT_L(8); PG8_BAR; PG8_WAIT_L(0); PG8_MMA(0, 0, At, B0); PG8_BAR; PG8_SCHED;
            PG8_LDB(B1, 0, 1); PG8_STAGE(PG8_SB(0, 0), b2, voffB);
            PG8_BAR; PG8_WAIT_L(0); PG8_MMA(0, 1, At, B1); PG8_BAR;
            PG8_LDA(At, 0, 1); PG8_STAGE(PG8_SA(0, 0), a2, voffA);
            PG8_BAR; PG8_WAIT_L(0); PG8_MMA(1, 0, At, B0); PG8_BAR; PG8_SCHED;
            PG8_STAGE(PG8_SB(0, 1), b2 + hstep, voffB);
            PG8_WAIT_V(6); PG8_BAR; PG8_MMA(1, 1, At, B1); PG8_BAR;
            PG8_LDB(B0, 1, 0); PG8_SCHED; PG8_LDA(At, 1, 0); PG8_STAGE(PG8_SA(0, 1), a2 + hstep, voffA);
            PG8_WAIT_L(8); PG8_BAR; PG8_WAIT_L(0); PG8_MMA(0, 0, At, B0); PG8_BAR; PG8_SCHED;
            PG8_LDB(B1, 1, 1); PG8_STAGE(PG8_SB(1, 0), b3, voffB);
            PG8_BAR; PG8_WAIT_L(0); PG8_MMA(0, 1, At, B1); PG8_BAR;
            PG8_LDA(At, 1, 1); PG8_STAGE(PG8_SA(1, 0), a3, voffA);
            PG8_BAR; PG8_WAIT_L(0); PG8_MMA(1, 0, At, B0); PG8_BAR; PG8_SCHED;
            PG8_STAGE(PG8_SB(1, 1), b3 + hstep, voffB);
            PG8_WAIT_V(6); PG8_BAR; PG8_MMA(1, 1, At, B1); PG8_BAR;
            }
        }
        if constexpr (ALIGN_EPI) { if (wr == 0) PG8_BAR; }
        if constexpr (!Epi::AFTER_DRAIN) { E(acc, cur, wr, wc, fr, fq); S.done(cur); }
        if (!has_next) break;
#pragma unroll
        for (int a = 0; a < 2; ++a)
#pragma unroll
            for (int b = 0; b < 2; ++b)
#pragma unroll
                for (int m = 0; m < 4; ++m)
#pragma unroll
                    for (int n = 0; n < 2; ++n) acc[a][b][m][n] = (f32x4){0.f, 0.f, 0.f, 0.f};
        cur = nxt; cA = nA; cB = nB; ++ui;
        if constexpr (ALIGN_EPI) { if (wr == 1) PG8_BAR; }
    }
    PG8_WAIT_V(0);
    if constexpr (!ALIGN_EPI) { if (wr == 0) PG8_BAR; }
    PG8_BAR;
    if constexpr (Epi::AFTER_DRAIN) { E.fused(acc, cur, wr, wc, fr, fq, lds, wid, lane); S.done(cur); }
#undef PG8_SA
#undef PG8_SB
#undef PG8_STAGE
#undef PG8_LDA
#undef PG8_LDB
#undef PG8_MMA
#undef PG8_WAIT_V
#undef PG8_WAIT_L
#undef PG8_BAR
#undef PG8_SCHED
}
}
constexpr int NWAVES = 8;
#ifndef MK_N_LAUNCHES
#define MK_N_LAUNCHES 1
#endif
constexpr int T_ = 8192, D_ = 2048, INW = 4640, NIN = 4864, RW = 1024, NH = 16, HD = 64, DFF = 5632, NUG = 2 * DFF;
constexpr int COL_R = 0, COL_K = 1024, COL_V = 2048, COL_XW = 3072, COL_XA = 3136, COL_XG = 3200, COL_Q = 3360, COL_KA = 4384, COL_VA = 4512, RIN = 3360;
constexpr float NORM_EPS = 1e-5f, LNX_EPS = 64e-5f;
constexpr size_t MiB = 1u << 20;
constexpr size_t WS_CTL = 0, CTL_ZERO_BYTES = 1 * MiB;
constexpr size_t WS_WIN = 1 * MiB, WS_WOUT = 20 * MiB, WS_HN = 28 * MiB, WS_Z = 61 * MiB, WS_RWA = 137 * MiB, WS_MISC = 250 * MiB, WS_END = 256 * MiB;
constexpr size_t WS_WUG = 61 * MiB, WS_WDN = 105 * MiB, WS_ACT = 127 * MiB, WS_H2 = 216 * MiB;
constexpr size_t RWA_STRIDE = 16 * MiB;
constexpr size_t MISC_BIAS = 0, MISC_ROPE = 64 * 1024;
constexpr int CW_BAR = 4096;
constexpr int CW_SSQA = 65536, CW_SSQ2 = CW_SSQA + T_, CW_SSQ3 = CW_SSQ2 + T_;
static_assert((CW_SSQ3 + T_) * 4 <= (int)CTL_ZERO_BYTES, "ctl");
constexpr int RING_BYTES = 131072, XCH_OFF = RING_BYTES, LDSCTL_OFF = RING_BYTES + 4096, MISC_OFF = LDSCTL_OFF + 320, LDS_BYTES = 147456;

#define GAS __attribute__((address_space(1)))
#define LAS __attribute__((address_space(3)))
typedef unsigned short bf16;
typedef unsigned v4u __attribute__((ext_vector_type(4)));
typedef float f32x4 __attribute__((ext_vector_type(4)));
typedef GAS unsigned gu32;
#define RLX_AGENT __ATOMIC_RELAXED, __HIP_MEMORY_SCOPE_AGENT
#define LDS_WAIT() asm volatile("s_waitcnt lgkmcnt(0)" ::: "memory")
__device__ __forceinline__ unsigned f2bf(float f) { unsigned u = __builtin_bit_cast(unsigned, f); return (u + 0x7fffu + ((u >> 16) & 1u)) >> 16; }
__device__ __forceinline__ unsigned pk2(float lo, float hi) { return f2bf(lo) | (f2bf(hi) << 16); }
__device__ __forceinline__ float bf2f(unsigned h) { return __builtin_bit_cast(float, h << 16); }
__device__ __forceinline__ float wave_sum(float v) {
#pragma unroll
    for (int o = 1; o < 64; o <<= 1) v += __shfl_xor(v, o);
    return v;
}
#define XB_TMO      128
#define XB_XCNT(j)  (256  + 64 * (j))
#define XB_XSUB(j)  (1280 + 64 * (j))
#define XB_XGEN(j)  (2304 + 64 * (j))
#define XB_TOP      3328
#define XB_TOPGEN   3392
#define XCD_BAR_WORDS 3456
#define XB_SPIN_CAP (1u << 18)

__device__ __forceinline__ unsigned xb_ld(unsigned* p)              { return __hip_atomic_load(p, __ATOMIC_RELAXED, __HIP_MEMORY_SCOPE_AGENT); }
__device__ __forceinline__ unsigned xb_add(unsigned* p, unsigned v) { return __hip_atomic_fetch_add(p, v, __ATOMIC_RELAXED, __HIP_MEMORY_SCOPE_AGENT); }
__device__ __forceinline__ unsigned xb_xcc_id() { return (unsigned)__builtin_amdgcn_s_getreg((3 << 11) | 20) & 0xFu; }
#define XB_SPIN(cond, bar) do { unsigned _sp = 0; while (cond) { __builtin_amdgcn_s_sleep(1); \
    if ((++_sp & 255u) == 0u) { if (xb_ld(&(bar)[XB_TMO])) break; if (_sp > XB_SPIN_CAP) { atomicAdd(&(bar)[XB_TMO], 1u); break; } } } } while (0)

struct XcdBarrier {
    unsigned* bar; unsigned x;
    volatile LAS unsigned* st;
};

__device__ __forceinline__ XcdBarrier xcd_barrier_post(unsigned* bar, volatile LAS unsigned* st) {
    XcdBarrier b; b.bar = bar; b.x = xb_xcc_id(); b.st = st;
    if (threadIdx.x == 0) (void)xb_add(&bar[XB_XCNT(b.x)], 1u);
    return b;
}
__device__ __forceinline__ void xcd_barrier_complete(unsigned* bar, unsigned x, unsigned& nloc, unsigned& nx) {
    const unsigned G = gridDim.x * gridDim.y * gridDim.z;
    unsigned sum, cnt, mine, sp = 0u;
    for (;;) {
        sum = 0u; cnt = 0u; mine = 0u;
#pragma unroll
        for (unsigned j = 0; j < 16; ++j) { const unsigned c = xb_ld(&bar[XB_XCNT(j)]); sum += c; cnt += (c > 0u) ? 1u : 0u; mine = (j == x) ? c : mine; }
        if (sum == G) break;
        __builtin_amdgcn_s_sleep(1);
        if ((++sp & 255u) == 0u) { if (xb_ld(&bar[XB_TMO])) break; if (sp > XB_SPIN_CAP) { atomicAdd(&bar[XB_TMO], 1u); break; } }
    }
    nloc = mine > 0u ? mine : 1u; nx = cnt > 0u ? cnt : 1u;
}

__device__ __forceinline__ void xcd_barrier(const XcdBarrier& b) {
    asm volatile("s_waitcnt vmcnt(0)" ::: "memory");
    __syncthreads();
    if (threadIdx.x == 0) {
        unsigned* bar = b.bar;
        __builtin_amdgcn_s_waitcnt(0);
        unsigned nloc = b.st[0], nx = b.st[1];
        if (nloc == 0u) { xcd_barrier_complete(bar, b.x, nloc, nx); b.st[0] = nloc; b.st[1] = nx; }
        const unsigned old = xb_add(&bar[XB_XSUB(b.x)], 1u);
        const unsigned gen = old / nloc;
        if (old + 1u == (gen + 1u) * nloc) {
            __builtin_amdgcn_fence(__ATOMIC_RELEASE, "agent");
            asm volatile("s_waitcnt vmcnt(0)" ::: "memory");
            const unsigned og = xb_add(&bar[XB_TOP], 1u);
            const unsigned tg = og / nx;
            if (og + 1u == (tg + 1u) * nx) xb_add(&bar[XB_TOPGEN], 1u);
            else XB_SPIN(xb_ld(&bar[XB_TOPGEN]) == tg, bar);
            __builtin_amdgcn_fence(__ATOMIC_ACQUIRE, "agent");
            xb_add(&bar[XB_XGEN(b.x)], 1u);
            asm volatile("s_waitcnt vmcnt(0)" ::: "memory");
        } else {
            XB_SPIN(xb_ld(&bar[XB_XGEN(b.x)]) == gen, bar);
            __builtin_amdgcn_fence(__ATOMIC_ACQUIRE, "agent");
            asm volatile("s_waitcnt vmcnt(0)" ::: "memory");
        }
    }
    __syncthreads();
}
struct Ctx {
    LAS unsigned char* lds; int tid, lane, wave, vcu, G;
    const float* in[25]; float* out; unsigned char* ws;
};
#define IN_X 0
#define IN_LN_MIX_G 1
#define IN_W_IN 2
#define IN_B_ATTN 3
#define IN_MU 4
#define IN_W0 5
#define IN_W2 6
#define IN_A0 7
#define IN_A2 8
#define IN_G2 9
#define IN_K_K 10
#define IN_K_A 11
#define IN_R_K 12
#define IN_LNX_G 13
#define IN_LNX_B 14
#define IN_SINKS 15
#define IN_ATTN_G 16
#define IN_W_OUT 17
#define IN_LN_FFN_G 18
#define IN_W_UP 19
#define IN_W_GATE 20
#define IN_CONV_W 21
#define IN_CONV_B 22
#define IN_W_DOWN 23
#define IN_LN_FINAL_G 24

__device__ __forceinline__ void transpose_item(const float* W, int K, int N, bf16* WT, int drow0, LAS float* scr, int k0, int n0, int lane) {
#pragma unroll 8
    for (int i = 0; i < 32; ++i) { const int kk = 2 * i + (lane >> 5); scr[kk * 33 + (lane & 31)] = W[(size_t)(k0 + kk) * N + n0 + (lane & 31)]; }
    LDS_WAIT(); asm volatile("" ::: "memory");
    const int c = lane & 7;
#pragma unroll
    for (int j = 0; j < 4; ++j) { const int n = (lane >> 3) + 8 * j; const LAS float* s = scr + (8 * c) * 33 + n;
        v4u o; o.x = pk2(s[0 * 33], s[1 * 33]); o.y = pk2(s[2 * 33], s[3 * 33]); o.z = pk2(s[4 * 33], s[5 * 33]); o.w = pk2(s[6 * 33], s[7 * 33]);
        *(GAS v4u*)(WT + (size_t)(drow0 + n) * K + k0 + 8 * c) = o; }
    LDS_WAIT(); asm volatile("" ::: "memory");
}
__device__ __forceinline__ void rms_row_to_bf16(const float* xrow, const float* g, bf16* orow, int lane) {
    const GAS f32x4* xr = (const GAS f32x4*)xrow + lane; const GAS f32x4* gr = (const GAS f32x4*)g + lane;
    f32x4 v[8]; float s = 0.f;
#pragma unroll
    for (int j = 0; j < 8; ++j) { v[j] = xr[64 * j]; s += (v[j].x * v[j].x + v[j].y * v[j].y) + (v[j].z * v[j].z + v[j].w * v[j].w); }
    const float rs = 1.0f / sqrtf(wave_sum(s) * (1.f / D_) + NORM_EPS);
    GAS unsigned long long* o8 = (GAS unsigned long long*)orow + lane;
#pragma unroll
    for (int j = 0; j < 8; ++j) { const f32x4 gg = gr[64 * j]; o8[64 * j] = (unsigned long long)pk2(v[j].x * rs * gg.x, v[j].y * rs * gg.y) | ((unsigned long long)pk2(v[j].z * rs * gg.z, v[j].w * rs * gg.w) << 32); }
}

__device__ __forceinline__ void ph_prologue(Ctx& F) {
    LAS float* scr = (LAS float*)(F.lds + F.wave * 16384);
    const int gw = F.vcu * NWAVES + F.wave, NGW = F.G * NWAVES, gt = gw * 64 + F.lane, NGT = NGW * 64;
    bf16* WIN = (bf16*)(F.ws + WS_WIN); bf16* WOUT = (bf16*)(F.ws + WS_WOUT); bf16* HN = (bf16*)(F.ws + WS_HN);
    constexpr int I_IN = (D_ / 64) * (INW / 32), I_OUT = (D_ / 64) * (D_ / 32);
    for (int it = gw; it < I_IN + I_OUT; it += NGW) {
        if (it < I_IN) { const int nblk = INW / 32, kb = it / nblk, nb = it % nblk; transpose_item(F.in[IN_W_IN], D_, INW, WIN, 32 * nb, scr, 64 * kb, 32 * nb, F.lane); }
        else { const int r = it - I_IN, nblk = D_ / 32, kb = r / nblk, nb = r % nblk; transpose_item(F.in[IN_W_OUT], D_, D_, WOUT, 32 * nb, scr, 64 * kb, 32 * nb, F.lane); }
    }
    { GAS v4u* p = (GAS v4u*)(WIN + (size_t)INW * D_); const int n16 = (NIN - INW) * D_ * 2 / 16; for (int i = gt; i < n16; i += NGT) p[i] = (v4u){0u, 0u, 0u, 0u}; }
    { float* b = (float*)(F.ws + WS_MISC + MISC_BIAS); for (int i = gt; i < NIN; i += NGT) b[i] = (i >= RIN && i < INW) ? F.in[IN_B_ATTN][i - RIN] : 0.f; }
    { float* rt = (float*)(F.ws + WS_MISC + MISC_ROPE);
      for (int i = gt; i < T_ * 8; i += NGT) { const int t = i >> 3, k = i & 7;
          const float invf = k == 0 ? 1.0f : k == 1 ? 0x1.8d275ep-3f : k == 2 ? 0x1.341190p-5f : k == 3 ? 0x1.ddee9cp-8f : k == 4 ? 0x1.72ba44p-10f : k == 5 ? 0x1.1f91f0p-12f : k == 6 ? 0x1.be2188p-15f : 0x1.5a0f4ep-17f;
          const float ang = (float)t * invf;
          const double a = (double)ang, kq = rint(a * 0.15915494309189535), rr = fma(-kq, 6.283185307179586, a); const float rf = (float)rr;
          rt[t * 16 + k] = cosf(rf); rt[t * 16 + 8 + k] = sinf(rf); } }
    for (int m = gw; m < T_; m += NGW) rms_row_to_bf16(F.in[IN_X] + (size_t)m * D_, F.in[IN_LN_MIX_G], HN + (size_t)m * D_, F.lane);
}
__device__ __forceinline__ void ph_ffn_weights(Ctx& F) {
    LAS float* scr = (LAS float*)(F.lds + F.wave * 16384);
    const int gw = F.vcu * NWAVES + F.wave, NGW = F.G * NWAVES;
    bf16* WUG = (bf16*)(F.ws + WS_WUG); bf16* WDN = (bf16*)(F.ws + WS_WDN);
    constexpr int I_UP = (D_ / 64) * (DFF / 32), I_DN = (DFF / 64) * (D_ / 32);
    for (int it = gw; it < 2 * I_UP + I_DN; it += NGW) {
        if (it < 2 * I_UP) { const int gate = it >= I_UP, r = gate ? it - I_UP : it, nblk = DFF / 32, kb = r / nblk, nb = r % nblk, n0 = 32 * nb;
            transpose_item(F.in[gate ? IN_W_GATE : IN_W_UP], D_, DFF, WUG, 256 * (n0 >> 7) + (n0 & 127) + (gate ? 128 : 0), scr, 64 * kb, n0, F.lane); }
        else { const int r = it - 2 * I_UP, nblk = D_ / 32, kb = r / nblk, nb = r % nblk; transpose_item(F.in[IN_W_DOWN], DFF, D_, WDN, 32 * nb, scr, 64 * kb, 32 * nb, F.lane); }
    }
}
__device__ __forceinline__ void ph_attention_naive(Ctx& F) {
    const bf16* Z = (const bf16*)(F.ws + WS_Z); bf16* YC = (bf16*)(F.ws + WS_HN); const float* rope = (const float*)(F.ws + WS_MISC + MISC_ROPE);
    float* ssqA = (float*)(F.ws + WS_CTL) + CW_SSQA;
    for (int it = F.vcu; it < 64 * NH; it += F.G) {
        const int nb = it >> 4, h = it & 15, kvh = h >> 3, q = F.tid >> 2, p = F.tid & 3, t = 128 * nb + q;
        float qv[64];
        { const bf16* qp = Z + (size_t)t * NIN + COL_Q + h * 64;
#pragma unroll
          for (int d = 0; d < 64; d += 8) { const v4u w = *(const GAS v4u*)(qp + d); const unsigned ww[4] = {w.x, w.y, w.z, w.w};
#pragma unroll
              for (int e = 0; e < 4; ++e) { qv[d + 2 * e] = bf2f(ww[e] & 0xffffu); qv[d + 2 * e + 1] = bf2f(ww[e] >> 16); } }
#pragma unroll
          for (int i = 0; i < 8; ++i) { const float c = rope[t * 16 + i], s = rope[t * 16 + 8 + i], x1 = qv[i], x2 = qv[8 + i]; qv[i] = x1 * c - x2 * s; qv[8 + i] = x2 * c + x1 * s; } }
        float m = -INFINITY, l = 0.f, o[64];
#pragma unroll
        for (int d = 0; d < 64; ++d) o[d] = 0.f;
        for (int i = 0; i < 32; ++i) {
            const int kp = t - 127 + 32 * p + i;
            if (kp >= 0) {
                const bf16* kr = Z + (size_t)kp * NIN + COL_KA + kvh * 64; const bf16* vr = Z + (size_t)kp * NIN + COL_VA + kvh * 64;
                float kv[16];
                { const v4u w0 = *(const GAS v4u*)(kr), w1 = *(const GAS v4u*)(kr + 8); const unsigned ww[8] = {w0.x, w0.y, w0.z, w0.w, w1.x, w1.y, w1.z, w1.w};
#pragma unroll
                  for (int e = 0; e < 8; ++e) { kv[2 * e] = bf2f(ww[e] & 0xffffu); kv[2 * e + 1] = bf2f(ww[e] >> 16); } }
                float s = 0.f;
#pragma unroll
                for (int j = 0; j < 8; ++j) { const float c = rope[kp * 16 + j], sn = rope[kp * 16 + 8 + j], x1 = kv[j], x2 = kv[8 + j]; s += qv[j] * (x1 * c - x2 * sn) + qv[8 + j] * (x2 * c + x1 * sn); }
#pragma unroll
                for (int d = 16; d < 64; d += 8) { const v4u w = *(const GAS v4u*)(kr + d); const unsigned ww[4] = {w.x, w.y, w.z, w.w};
#pragma unroll
                    for (int e = 0; e < 4; ++e) s += qv[d + 2 * e] * bf2f(ww[e] & 0xffffu) + qv[d + 2 * e + 1] * bf2f(ww[e] >> 16); }
                s *= 0.125f;
                const float mn = fmaxf(m, s), al = __expf(m - mn), pe = __expf(s - mn);
                l = l * al + pe; m = mn;
#pragma unroll
                for (int d = 0; d < 64; d += 8) { const v4u w = *(const GAS v4u*)(vr + d); const unsigned ww[4] = {w.x, w.y, w.z, w.w};
#pragma unroll
                    for (int e = 0; e < 4; ++e) { o[d + 2 * e] = o[d + 2 * e] * al + pe * bf2f(ww[e] & 0xffffu); o[d + 2 * e + 1] = o[d + 2 * e + 1] * al + pe * bf2f(ww[e] >> 16); } }
            }
        }
        float M = fmaxf(m, __shfl_xor(m, 1)); M = fmaxf(M, __shfl_xor(M, 2));
        const float sc = (m == -INFINITY) ? 0.f : __expf(m - M);
        l *= sc; l += __shfl_xor(l, 1); l += __shfl_xor(l, 2);
        const float den = 1.0f / (l + __expf(F.in[IN_SINKS][h] - M));
        float sq = 0.f;
#pragma unroll
        for (int d = 0; d < 64; ++d) { float v = o[d] * sc; v += __shfl_xor(v, 1); v += __shfl_xor(v, 2); o[d] = v * den; sq += o[d] * o[d]; }
        if (p == 0) { bf16* op = YC + (size_t)t * D_ + RW + h * 64;
#pragma unroll
            for (int d = 0; d < 64; d += 8) { v4u w; w.x = pk2(o[d], o[d + 1]); w.y = pk2(o[d + 2], o[d + 3]); w.z = pk2(o[d + 4], o[d + 5]); w.w = pk2(o[d + 6], o[d + 7]); *(GAS v4u*)(op + d) = w; }
            atomicAdd(ssqA + t, sq); }
    }
}
__device__ __forceinline__ float zshift(const bf16* Z, const float* mu, int t, int col) {
    const float zc = bf2f(Z[(size_t)t * NIN + col]); const float zp = t > 0 ? bf2f(Z[(size_t)(t - 1) * NIN + col]) : 0.f; return zc + mu[col] * (zp - zc);
}
__device__ __forceinline__ void ph_rwkv_prep_naive(Ctx& F) {
    const bf16* Z = (const bf16*)(F.ws + WS_Z); const float* mu = F.in[IN_MU];
    bf16* KK = (bf16*)(F.ws + WS_RWA); bf16* BB = KK + RWA_STRIDE / 2; bf16* KM = BB + RWA_STRIDE / 2; bf16* RS = KM + RWA_STRIDE / 2; bf16* VS = RS + RWA_STRIDE / 2; bf16* GG = VS + RWA_STRIDE / 2;
    float* LW = F.out;
    LAS float* aw = (LAS float*)F.lds; LAS float* aa = aw + 8 * 64; LAS float* ag = aa + 8 * 64;
    for (int grp = F.vcu; grp < T_ / 8; grp += F.G) {
        const int t0 = grp * 8;
        __syncthreads();
        for (int e = F.tid; e < 8 * 288; e += 512) { const int tok = e / 288, j = e % 288; const float v = zshift(Z, mu, t0 + tok, COL_XW + j);
            if (j < 64) aw[tok * 64 + j] = tanhf(v); else if (j < 128) aa[tok * 64 + j - 64] = v; else ag[tok * 160 + j - 128] = 1.0f / (1.0f + __expf(-v)); }
        __syncthreads();
#pragma unroll 1
        for (int cc = 0; cc < 2; ++cc) {
            const int c = F.tid + 512 * cc;
            float wl[8], al[8], gl[8];
#pragma unroll
            for (int k = 0; k < 8; ++k) { wl[k] = 0.f; al[k] = 0.f; gl[k] = 0.f; }
            for (int j = 0; j < 64; ++j) { const float w2v = F.in[IN_W2][j * RW + c], a2v = F.in[IN_A2][j * RW + c];
#pragma unroll
                for (int k = 0; k < 8; ++k) { wl[k] += aw[k * 64 + j] * w2v; al[k] += aa[k * 64 + j] * a2v; } }
            for (int j = 0; j < 160; ++j) { const float g2v = F.in[IN_G2][j * RW + c];
#pragma unroll
                for (int k = 0; k < 8; ++k) gl[k] += ag[k * 160 + j] * g2v; }
            const float w0 = F.in[IN_W0][c], a0 = F.in[IN_A0][c], kkc = F.in[IN_K_K][c], kac = F.in[IN_K_A][c];
#pragma unroll
            for (int k = 0; k < 8; ++k) { const int t = t0 + k; const size_t o = (size_t)t * RW + c;
                const float x = w0 + wl[k];
                const float sp = (x < -20.f) ? -x : log1pf(__expf(-x));
                LW[o] = -__expf(-sp - 0.5f);
                const float a = 1.0f / (1.0f + __expf(-(a0 + al[k])));
                const float kraw = zshift(Z, mu, t, COL_K + c), kkv = kraw * kkc;
                const float nrm = fmaxf(sqrtf(wave_sum(kkv * kkv)), 1e-12f); const float kn = kkv / nrm;
                KK[o] = (bf16)f2bf(kn); BB[o] = (bf16)f2bf(kn * a); KM[o] = (bf16)f2bf(kraw * (1.0f + (a - 1.0f) * kac));
                RS[o] = (bf16)f2bf(zshift(Z, mu, t, COL_R + c)); VS[o] = (bf16)f2bf(zshift(Z, mu, t, COL_V + c)); GG[o] = (bf16)f2bf(gl[k]); }
        }
    }
}
__device__ __forceinline__ void ph_rwkv_scan_naive(Ctx& F) {
    if (F.vcu >= NH || F.wave != 0) return;
    const int h = F.vcu, l = F.lane;
    const bf16* KK = (const bf16*)(F.ws + WS_RWA); const bf16* BB = KK + RWA_STRIDE / 2; const bf16* KM = BB + RWA_STRIDE / 2; const bf16* RS = KM + RWA_STRIDE / 2; const bf16* VS = RS + RWA_STRIDE / 2;
    const float* LW = F.out; float* Y = F.out + (size_t)T_ * RW;
    float S[64];
#pragma unroll
    for (int j = 0; j < 64; ++j) S[j] = 0.f;
    size_t o = (size_t)h * 64 + l;
    float n_lw = LW[o]; unsigned n_kk = KK[o], n_bb = BB[o], n_km = KM[o], n_rs = RS[o], n_vs = VS[o];
    for (int t = 0; t < T_; ++t) {
        const float w = __expf(n_lw), kk = bf2f(n_kk), bb = bf2f(n_bb), km = bf2f(n_km), r = bf2f(n_rs), v = bf2f(n_vs);
        if (t + 1 < T_) { const size_t o2 = (size_t)(t + 1) * RW + h * 64 + l; n_lw = LW[o2]; n_kk = KK[o2]; n_bb = BB[o2]; n_km = KM[o2]; n_rs = RS[o2]; n_vs = VS[o2]; }
        float sa = 0.f;
#pragma unroll
        for (int j = 0; j < 64; ++j) sa += S[j] * __builtin_bit_cast(float, __builtin_amdgcn_readlane(__builtin_bit_cast(int, kk), j));
        sa = -sa;
        float y = 0.f;
#pragma unroll
        for (int j = 0; j < 64; ++j) {
            const float wj = __builtin_bit_cast(float, __builtin_amdgcn_readlane(__builtin_bit_cast(int, w), j)), bj = __builtin_bit_cast(float, __builtin_amdgcn_readlane(__builtin_bit_cast(int, bb), j));
            const float kj = __builtin_bit_cast(float, __builtin_amdgcn_readlane(__builtin_bit_cast(int, km), j)), rj = __builtin_bit_cast(float, __builtin_amdgcn_readlane(__builtin_bit_cast(int, r), j));
            S[j] = S[j] * wj + (sa * bj + v * kj); y += S[j] * rj; }
        Y[(size_t)t * RW + h * 64 + l] = y;
    }
}
__device__ __forceinline__ void ph_post(Ctx& F) {
    const bf16* KM = (const bf16*)(F.ws + WS_RWA) + 2 * (RWA_STRIDE / 2); const bf16* RS = KM + RWA_STRIDE / 2; const bf16* VS = RS + RWA_STRIDE / 2; const bf16* GG = VS + RWA_STRIDE / 2;
    const float* Y = F.out + (size_t)T_ * RW; bf16* YC = (bf16*)(F.ws + WS_HN); const float* ssqA = (const float*)(F.ws + WS_CTL) + CW_SSQA;
    const int gw = F.vcu * NWAVES + F.wave, NGW = F.G * NWAVES, l = F.lane;
    for (int it = gw; it < T_ * NH; it += NGW) {
        const int t = it >> 4, h = it & 15, c = h * 64 + l; const size_t o = (size_t)t * RW + c;
        const float y = Y[o]; const float mu = wave_sum(y) * (1.f / 64.f); const float d = y - mu; const float var = wave_sum(d * d) * (1.f / 64.f);
        const float yn = d * (1.0f / sqrtf(var + LNX_EPS)) * F.in[IN_LNX_G][c] + F.in[IN_LNX_B][c];
        const float r = bf2f(RS[o]), k = bf2f(KM[o]), v = bf2f(VS[o]), g = bf2f(GG[o]);
        const float bonus = wave_sum(r * k * F.in[IN_R_K][c]) * v;
        YC[(size_t)t * D_ + c] = (bf16)f2bf((yn + bonus) * g);
    }
    for (int t = gw; t < T_; t += NGW) {
        const float sc = 1.0f / sqrtf(ssqA[t] * (1.f / RW) + NORM_EPS);
        bf16* p = YC + (size_t)t * D_ + RW;
#pragma unroll
        for (int j = 0; j < 16; ++j) { const int c = j * 64 + l; p[c] = (bf16)f2bf(bf2f(p[c]) * sc * F.in[IN_ATTN_G][c]); }
    }
}
__device__ __forceinline__ void ph_final(Ctx& F) {
    const float* ssq3 = (const float*)(F.ws + WS_CTL) + CW_SSQ3; const int gw = F.vcu * NWAVES + F.wave, NGW = F.G * NWAVES;
    for (int t = gw; t < T_; t += NGW) {
        const float sc = 1.0f / sqrtf(ssq3[t] * (1.f / D_) + NORM_EPS);
        GAS f32x4* xr = (GAS f32x4*)(F.out + (size_t)t * D_) + F.lane; const GAS f32x4* gr = (const GAS f32x4*)F.in[IN_LN_FINAL_G] + F.lane;
#pragma unroll
        for (int j = 0; j < 8; ++j) { const f32x4 v = xr[64 * j], g = gr[64 * j]; xr[64 * j] = v * sc * g; }
    }
}
constexpr int N_PHASES = 11;
constexpr int N_LAUNCHES = MK_N_LAUNCHES;
struct Args { const float* in[25]; float* out; unsigned char* ws; int ph_lo, ph_hi, li, pad; };
__global__ void __launch_bounds__(NWAVES * 64, 2) mk_fwd(Args args) {
    extern __shared__ __attribute__((aligned(16))) unsigned char lds[];
    Ctx F;
    F.lds = (LAS unsigned char*)lds;
    F.tid = threadIdx.x; F.lane = F.tid & 63; F.wave = __builtin_amdgcn_readfirstlane(F.tid >> 6);
    F.G = gridDim.x; { const int bx = blockIdx.x; F.vcu = (F.G % 8 == 0) ? (bx % 8) * (F.G / 8) + bx / 8 : bx; }
#pragma unroll
    for (int i = 0; i < 25; ++i) F.in[i] = args.in[i];
    F.out = args.out; F.ws = args.ws;
    volatile LAS unsigned* MISC = (volatile LAS unsigned*)(F.lds + MISC_OFF);
    for (int u = F.tid; u < (LDS_BYTES - LDSCTL_OFF) / 4; u += NWAVES * 64) ((LAS unsigned*)(F.lds + LDSCTL_OFF))[u] = 0u;
    __syncthreads();
    gu32* ctl = (gu32*)(F.ws + WS_CTL);
    XcdBarrier bar; bar.bar = (unsigned*)(ctl + CW_BAR); bar.x = 0; bar.st = nullptr;
    const int lo = args.ph_lo, hi = args.ph_hi;
    if (hi - lo > 1) bar = xcd_barrier_post((unsigned*)(ctl + CW_BAR), MISC + 8);
#define IN(k) (lo <= (k) && (k) < hi)
#define SEAM(k) do { if (IN(k) && IN((k) + 1)) xcd_barrier(bar); } while (0)
    float* ssq = (float*)(F.ws + WS_CTL);
    bf16* HN = (bf16*)(F.ws + WS_HN); bf16* Z = (bf16*)(F.ws + WS_Z); bf16* H2 = (bf16*)(F.ws + WS_H2); bf16* ACT = (bf16*)(F.ws + WS_ACT);

    if (IN(0)) { ph_prologue(F); } SEAM(0);
    if (IN(1)) {
        pg8::Gemm g{HN, (const bf16*)(F.ws + WS_WIN), T_, NIN, D_, 0L, 256L * D_ * 2}; pg8::StaticOrder S; S.init(T_, NIN, F.G, (int)blockIdx.x);
        pg8::EpiZ E{Z, NIN, (const float*)(F.ws + WS_MISC + MISC_BIAS)};
        pg8::gemm_phase<pg8::EpiZ, pg8::StaticOrder, true, true>(F.lds, g, S, E);
    } SEAM(1);
    if (IN(2)) { ph_attention_naive(F); } SEAM(2);
    if (IN(3)) { ph_rwkv_prep_naive(F); } SEAM(3);
    if (IN(4)) { ph_rwkv_scan_naive(F); } SEAM(4);
    if (IN(5)) { ph_post(F); } SEAM(5);
    if (IN(6)) {
        pg8::Gemm g{HN, (const bf16*)(F.ws + WS_WOUT), T_, D_, D_, 0L, 256L * D_ * 2}; pg8::StaticOrder S; S.init(T_, D_, F.G, (int)blockIdx.x);
        pg8::EpiRes E{F.in[IN_X], F.out, D_, H2, F.in[IN_LN_FFN_G], ssq + CW_SSQ2};
        pg8::gemm_phase<pg8::EpiRes, pg8::StaticOrder, true, true>(F.lds, g, S, E);
    } SEAM(6);
    if (IN(7)) { ph_ffn_weights(F); } SEAM(7);
    if (IN(8)) {
        pg8::Gemm g{H2, (const bf16*)(F.ws + WS_WUG), T_, NUG, D_, -2L * D_ * 2, 254L * D_ * 2}; pg8::StaticOrder S; S.initT(33, NUG / 256, F.G, (int)blockIdx.x);
        pg8::EpiUpGate E{ACT, ssq + CW_SSQ2, F.in[IN_CONV_W], F.in[IN_CONV_B], (LAS float*)(F.lds + XCH_OFF), T_, DFF, 1.0f / D_, NORM_EPS};
        pg8::gemm_phase<pg8::EpiUpGate, pg8::StaticOrder, true, true>(F.lds, g, S, E);
    } SEAM(8);
    if (IN(9)) {
        pg8::Gemm g{ACT, (const bf16*)(F.ws + WS_WDN), T_, D_, DFF, 0L, 256L * DFF * 2}; pg8::StaticOrder S; S.init(T_, D_, F.G, (int)blockIdx.x);
        pg8::EpiRes E{F.out, F.out, D_, nullptr, nullptr, ssq + CW_SSQ3};
        pg8::gemm_phase<pg8::EpiRes, pg8::StaticOrder, true, true>(F.lds, g, S, E);
    } SEAM(9);
    if (IN(10)) { ph_final(F); }
#undef IN
#undef SEAM
}

extern "C" void kernel_launch(void* const* d_in, const int* in_sizes, int n_in, void* d_out, int out_size, void* d_ws, size_t ws_size, hipStream_t stream) {
    static int grid = 0;
    if (grid == 0) {
        if (n_in != 25 || in_sizes[0] != T_ * D_ || out_size != T_ * D_ || ws_size < WS_END) { fprintf(stderr, "kernel_launch: unexpected shapes (n_in %d, in0 %d, out %d, ws %zu)\n", n_in, n_in > 0 ? in_sizes[0] : -1, out_size, ws_size); grid = -1; return; }
        int dev = 0, cus = 0;
        if (hipGetDevice(&dev) != hipSuccess || hipDeviceGetAttribute(&cus, hipDeviceAttributeMultiprocessorCount, dev) != hipSuccess) { grid = -1; return; }
        if (hipFuncSetAttribute((const void*)mk_fwd, hipFuncAttributeMaxDynamicSharedMemorySize, LDS_BYTES) != hipSuccess) { fprintf(stderr, "kernel_launch: hipFuncSetAttribute failed\n"); grid = -1; return; }
        (void)hipGetLastError();
        grid = cus;
    }
    if (grid < 0) return;
    if (hipMemsetAsync((char*)d_ws + WS_CTL, 0, CTL_ZERO_BYTES, stream) != hipSuccess) return;
    Args a{};
    for (int i = 0; i < 25; ++i) a.in[i] = (const float*)d_in[i];
    a.out = (float*)d_out; a.ws = (unsigned char*)d_ws;
    if (N_LAUNCHES == 1) { a.ph_lo = 0; a.ph_hi = N_PHASES; a.li = 0; hipLaunchKernelGGL(mk_fwd, dim3(grid), dim3(NWAVES * 64), LDS_BYTES, stream, a); }
    else for (int ph = 0; ph < N_PHASES; ++ph) { a.ph_lo = ph; a.ph_hi = ph + 1; a.li = 0; hipLaunchKernelGGL(mk_fwd, dim3(grid), dim3(NWAVES * 64), LDS_BYTES, stream, a); }
}
```

```cpp
#include <hip/hip_runtime.h>
#include <cstdio>
#include <cstdint>
#define MK_N_LAUNCHES 1
namespace pg8 {
#define PG8_LAS __attribute__((address_space(3)))
typedef unsigned short bf16_t;
typedef short bf16x8 __attribute__((ext_vector_type(8)));
typedef float f32x4 __attribute__((ext_vector_type(4)));
typedef unsigned u32x4 __attribute__((ext_vector_type(4)));
constexpr int BM = 256, BK = 64, HALF = 128, HTB = HALF * BK * 2  , STAGE_BYTES = 8 * HTB, NXCD = 8, WGM = 8;

__host__ __device__ __forceinline__ int lds_byte(int r, int c) { const int st = (r >> 4) * 2 + (c >> 5), rr = r & 15, cc = c & 31, ob = rr * 64 + cc * 2; return st * 1024 + (ob ^ (((ob >> 9) & 1) << 5)); }
__host__ __device__ __forceinline__ void stage_rc(int b, int& R, int& C) { const int st = b / 1024, sb = b % 1024, swz = sb ^ (((sb >> 9) & 1) << 5); R = (st >> 1) * 16 + swz / 64; C = (st & 1) * 32 + (swz % 64) / 2; }
__host__ __device__ __forceinline__ int perm32(int rho) { const int n = rho >> 4, i = rho & 15; return 8 * (i >> 2) + 4 * n + (i & 3); }

struct Unit { int pm, pn; };
struct Gemm { const bf16_t* A; const bf16_t* Bt; int M, N, K; long a_off, a_tstep; };

struct StaticOrder {
    int nM, nN, nwg, G, c;
    __host__ __device__ void init(int M, int N, int G_, int c_) { nM = M / BM; nN = N / BM; nwg = nM * nN; G = G_; c = c_; }
    __host__ __device__ void initT(int nM_, int nN_, int G_, int c_) { nM = nM_; nN = nN_; nwg = nM * nN; G = G_; c = c_; }
    __host__ __device__ bool next(int i, Unit& u) const {
        const long L = (long)i * G + c; if (L >= nwg) return false;
        int wgid = (int)L; { const int q = nwg / NXCD, r = nwg % NXCD, xcd = wgid % NXCD, off = wgid / NXCD; wgid = (xcd < r ? xcd * (q + 1) : r * (q + 1) + (xcd - r) * q) + off; }
        const int nig = WGM * nN, gid = wgid / nig, fm = gid * WGM, gsz = (nM - fm) < WGM ? (nM - fm) : WGM;
        u.pm = fm + ((wgid % nig) % gsz); u.pn = (wgid % nig) / gsz; return true;
    }
    __device__ __forceinline__ void a_ready(const Unit&) const {}
    __device__ __forceinline__ void done(const Unit&) const {}
};

__device__ __forceinline__ unsigned cvt_pk_bf16(float lo, float hi) { unsigned r; asm volatile("v_cvt_pk_bf16_f32 %0, %1, %2" : "=v"(r) : "v"(lo), "v"(hi)); return r; }
typedef unsigned u32x2 __attribute__((ext_vector_type(2)));

struct EpiZ {
    static constexpr bool PERM = true, AFTER_DRAIN = false;
    bf16_t* O; int ldc; const float* bias;
    __device__ __forceinline__ void operator()(const f32x4 (&acc)[2][2][4][2], const Unit& u, int wr, int wc, int fr, int fq) const {
        const int row0 = u.pm * BM + wr * 64 + fr; const int col0 = u.pn * BM + wc * 32 + 8 * fq;
        f32x4 bv[2][2];
#pragma unroll
        for (int bj = 0; bj < 2; ++bj)
#pragma unroll
            for (int n = 0; n < 2; ++n) bv[bj][n] = *(const f32x4*)(bias + col0 + bj * HALF + 4 * n);
#pragma unroll
        for (int ai = 0; ai < 2; ++ai)
#pragma unroll
            for (int m = 0; m < 4; ++m) { bf16_t* rowp = O + (size_t)(row0 + ai * HALF + m * 16) * ldc + col0;
#pragma unroll
                for (int bj = 0; bj < 2; ++bj) { const f32x4 v0 = acc[ai][bj][m][0] + bv[bj][0], v1 = acc[ai][bj][m][1] + bv[bj][1];
                    u32x4 w; w.x = cvt_pk_bf16(v0[0], v0[1]); w.y = cvt_pk_bf16(v0[2], v0[3]); w.z = cvt_pk_bf16(v1[0], v1[1]); w.w = cvt_pk_bf16(v1[2], v1[3]);
                    *(u32x4*)(rowp + bj * HALF) = w; } }
    }
};
struct EpiRes {
    static constexpr bool PERM = false, AFTER_DRAIN = false;
    const float* base; float* out; int ldc; bf16_t* hb; const float* gain; float* ssq;
    __device__ __forceinline__ void operator()(const f32x4 (&acc)[2][2][4][2], const Unit& u, int wr, int wc, int fr, int fq) const {
        const int row0 = u.pm * BM + wr * 64 + fr, col0 = u.pn * BM + wc * 32 + 4 * fq;
        f32x4 gv[2][2];
#pragma unroll
        for (int bj = 0; bj < 2; ++bj)
#pragma unroll
            for (int n = 0; n < 2; ++n) gv[bj][n] = hb ? *(const f32x4*)(gain + col0 + bj * HALF + n * 16) : (f32x4){0.f, 0.f, 0.f, 0.f};
#pragma unroll
        for (int ai = 0; ai < 2; ++ai)
#pragma unroll
            for (int m = 0; m < 4; ++m) { const int row = row0 + ai * HALF + m * 16; const size_t off = (size_t)row * ldc + col0; float q = 0.f;
#pragma unroll
                for (int bj = 0; bj < 2; ++bj)
#pragma unroll
                    for (int n = 0; n < 2; ++n) { const f32x4 x1 = *(const f32x4*)(base + off + bj * HALF + n * 16) + acc[ai][bj][m][n];
                        *(f32x4*)(out + off + bj * HALF + n * 16) = x1; q += (x1[0] * x1[0] + x1[1] * x1[1]) + (x1[2] * x1[2] + x1[3] * x1[3]);
                        if (hb) { const f32x4 h = x1 * gv[bj][n]; u32x2 w; w.x = cvt_pk_bf16(h[0], h[1]); w.y = cvt_pk_bf16(h[2], h[3]); *(u32x2*)(hb + off + bj * HALF + n * 16) = w; } }
                q += __shfl_xor(q, 16); q += __shfl_xor(q, 32);
                if (fq == 0) atomicAdd(ssq + row, q); }
    }
};
struct EpiUpGate {
    static constexpr bool PERM = true, AFTER_DRAIN = false;
    bf16_t* act; const float* ssq; const float* cw; const float* cb; PG8_LAS float* xch; int T, F; float invD, eps;
    __device__ __forceinline__ void operator()(const f32x4 (&acc)[2][2][4][2], const Unit& u, int wr, int wc, int fr, int fq) const {
        const int lane = fr + 16 * fq, wid = wr * 4 + wc;
        const int trow0 = 254 * u.pm - 2, f0 = 128 * u.pn + wc * 32 + 8 * fq;
        f32x4 uu[2][4][2], gg[2][4][2];
#pragma unroll
        for (int ai = 0; ai < 2; ++ai)
#pragma unroll
            for (int m = 0; m < 4; ++m) { const int t = trow0 + ai * HALF + wr * 64 + m * 16 + fr; float s = 0.f;
                if (t >= 0 && t < T) s = __builtin_amdgcn_rsqf(ssq[t] * invD + eps);
#pragma unroll
                for (int n = 0; n < 2; ++n) { uu[ai][m][n] = acc[ai][0][m][n] * s; gg[ai][m][n] = acc[ai][1][m][n] * s; } }
        if (fr >= 14) {
#pragma unroll
            for (int ai = 0; ai < 2; ++ai)
#pragma unroll
                for (int n = 0; n < 2; ++n) *(PG8_LAS f32x4*)(xch + ((((wid * 2 + ai) * 2 + (fr - 14)) * 4 + fq) * 2 + n) * 4) = uu[ai][3][n];
        }
        asm volatile("s_waitcnt lgkmcnt(0)" ::: "memory"); __builtin_amdgcn_s_barrier(); asm volatile("" ::: "memory");
        f32x4 pg[2][2];
#pragma unroll
        for (int ai = 0; ai < 2; ++ai)
#pragma unroll
            for (int n = 0; n < 2; ++n) { pg[ai][n] = (f32x4){0.f, 0.f, 0.f, 0.f};
                const int swid = wr ? wid - 4 : wid + 4, sai = wr ? ai : ai - 1;
                if (fr >= 14 && sai >= 0) pg[ai][n] = *(const PG8_LAS f32x4*)(xch + ((((swid * 2 + sai) * 2 + (fr - 14)) * 4 + fq) * 2 + n) * 4); }
        f32x4 w0[2], w1[2], w2[2], bb[2];
#pragma unroll
        for (int n = 0; n < 2; ++n) { w0[n] = *(const f32x4*)(cw + f0 + 4 * n); w1[n] = *(const f32x4*)(cw + F + f0 + 4 * n); w2[n] = *(const f32x4*)(cw + 2 * F + f0 + 4 * n); bb[n] = *(const f32x4*)(cb + f0 + 4 * n); }
        const int src1 = (lane & ~15) | ((lane - 1) & 15), src2 = (lane & ~15) | ((lane - 2) & 15);
#pragma unroll
        for (int ai = 0; ai < 2; ++ai)
#pragma unroll
            for (int m = 0; m < 4; ++m) { const int r = ai * HALF + wr * 64 + m * 16 + fr, t = trow0 + r; f32x4 o[2];
#pragma unroll
                for (int n = 0; n < 2; ++n) { const f32x4 U = uu[ai][m][n], PG = (m == 0) ? pg[ai][n] : uu[ai][m == 0 ? 0 : m - 1][n];
#pragma unroll
                    for (int c = 0; c < 4; ++c) { const float s1 = (fr == 15) ? PG[c] : U[c], s2 = (fr >= 14) ? PG[c] : U[c];
                        const float p1 = __shfl(s1, src1), p2 = __shfl(s2, src2);
                        const float cv = bb[n][c] + w2[n][c] * U[c] + w1[n][c] * p1 + w0[n][c] * p2;
                        const float sg = cv * __builtin_amdgcn_rcpf(1.0f + __expf(-cv));
                        o[n][c] = sg * gg[ai][m][n][c]; } }
                if (r >= 2 && t < T) { u32x4 w; w.x = cvt_pk_bf16(o[0][0], o[0][1]); w.y = cvt_pk_bf16(o[0][2], o[0][3]); w.z = cvt_pk_bf16(o[1][0], o[1][1]); w.w = cvt_pk_bf16(o[1][2], o[1][3]);
                    *(u32x4*)(act + (size_t)t * F + f0) = w; } }
    }
};
template <class Epi, class Sched, bool ALIGN_EPI = false, bool SP2 = false>
__device__ __forceinline__ void gemm_phase(PG8_LAS unsigned char* lds, const Gemm g, const Sched& S, const Epi& E) {
    const int tid = threadIdx.x, wid = __builtin_amdgcn_readfirstlane(tid >> 6), lane = tid & 63, wr = wid >> 2, wc = wid & 3, fr = lane & 15, fq = lane >> 4;
    const int K = g.K, nt = K / BK;
    unsigned voffA[2], voffB[2];
#pragma unroll
    for (int i = 0; i < 2; ++i) { int R, C; stage_rc(tid * 16 + i * 8192, R, C); const int Rb = Epi::PERM ? ((R & ~31) + perm32(R & 31)) : R;
        voffA[i] = (unsigned)(R * K + C) * 2u; voffB[i] = (unsigned)(Rb * K + C) * 2u; }
    const size_t kstep = (size_t)(BK * 2);
    const size_t hstep = (size_t)HALF * K * 2;
    const size_t tstep = 2 * hstep;
    const unsigned ldsw = (unsigned)wid * 1024u;
    const int aoff = lds_byte(wr * 64 + fr, fq * 8), boff = lds_byte(wc * 32 + fr, fq * 8);
#define PG8_SA(b, h) (((b) * 2 + (h)) * HTB)
#define PG8_SB(b, h) ((4 + (b) * 2 + (h)) * HTB)
#define PG8_STAGE(bufoff, gbase, voff) do { _Pragma("unroll") for (int _i = 0; _i < 2; ++_i) \
        __builtin_amdgcn_global_load_lds((const unsigned*)((const char*)(gbase) + (voff)[_i]), (PG8_LAS unsigned*)(lds + (bufoff) + ldsw + _i * 8192), 16, 0, 0); } while (0)
#define PG8_LDA(dst, b, h) do { _Pragma("unroll") for (int m = 0; m < 4; ++m) _Pragma("unroll") for (int k = 0; k < 2; ++k) dst[m][k] = *(const PG8_LAS bf16x8*)(lds + PG8_SA(b, h) + aoff + m * 2048 + k * 1024); } while (0)
#define PG8_LDB(dst, b, h) do { _Pragma("unroll") for (int n = 0; n < 2; ++n) _Pragma("unroll") for (int k = 0; k < 2; ++k) dst[n][k] = *(const PG8_LAS bf16x8*)(lds + PG8_SB(b, h) + boff + n * 2048 + k * 1024); } while (0)
#define PG8_MMA(ai, bj, At, Bt) do { __builtin_amdgcn_s_setprio(1); _Pragma("unroll") for (int m = 0; m < 4; ++m) _Pragma("unroll") for (int n = 0; n < 2; ++n) _Pragma("unroll") for (int k = 0; k < 2; ++k) \
        acc[ai][bj][m][n] = __builtin_amdgcn_mfma_f32_16x16x32_bf16(Bt[n][k], At[m][k], acc[ai][bj][m][n], 0, 0, 0); __builtin_amdgcn_s_setprio(0); } while (0)
#define PG8_WAIT_V(n) asm volatile("s_waitcnt vmcnt(" #n ")" ::: "memory")
#define PG8_WAIT_L(n) asm volatile("s_waitcnt lgkmcnt(" #n ")" ::: "memory")
#define PG8_BAR __builtin_amdgcn_s_barrier()
#define PG8_SCHED __builtin_amdgcn_sched_barrier(0)
    Unit cur, nxt; int ui = 0;
    if (!S.next(0, cur)) return;
    f32x4 acc[2][2][4][2];
#pragma unroll
    for (int a = 0; a < 2; ++a)
#pragma unroll
        for (int b = 0; b < 2; ++b)
#pragma unroll
            for (int m = 0; m < 4; ++m)
#pragma unroll
                for (int n = 0; n < 2; ++n) acc[a][b][m][n] = (f32x4){0.f, 0.f, 0.f, 0.f};
    bf16x8 At[4][2], B0[2][2], B1[2][2];
    const char* cA = (const char*)g.A + g.a_off + (long)cur.pm * g.a_tstep; const char* cB = (const char*)g.Bt + (size_t)cur.pn * tstep;
    S.a_ready(cur);
    if constexpr (SP2) {
        PG8_STAGE(PG8_SB(0, 0), cB, voffB); PG8_STAGE(PG8_SB(0, 1), cB + hstep, voffB); PG8_STAGE(PG8_SA(0, 0), cA, voffA); PG8_STAGE(PG8_SA(0, 1), cA + hstep, voffA);
        if (wr == 1) PG8_BAR;
        PG8_WAIT_V(2); PG8_BAR;
        PG8_STAGE(PG8_SB(1, 0), cB + kstep, voffB); PG8_STAGE(PG8_SA(1, 0), cA + kstep, voffA); PG8_STAGE(PG8_SB(1, 1), cB + hstep + kstep, voffB);
        PG8_WAIT_V(6); PG8_BAR;
    } else {
        PG8_STAGE(PG8_SB(0, 0), cB, voffB); PG8_STAGE(PG8_SA(0, 0), cA, voffA); PG8_STAGE(PG8_SB(0, 1), cB + hstep, voffB); PG8_STAGE(PG8_SA(0, 1), cA + hstep, voffA);
        if (wr == 1) PG8_BAR;
        PG8_WAIT_V(4); PG8_BAR;
        PG8_STAGE(PG8_SB(1, 0), cB + kstep, voffB); PG8_STAGE(PG8_SA(1, 0), cA + kstep, voffA); PG8_STAGE(PG8_SB(1, 1), cB + hstep + kstep, voffB);
        PG8_WAIT_V(6); PG8_BAR;
    }
    for (;;) {
        const bool has_next = S.next(ui + 1, nxt);
        const char* nA = has_next ? (const char*)g.A + g.a_off + (long)nxt.pm * g.a_tstep : cA; const char* nB = has_next ? (const char*)g.Bt + (size_t)nxt.pn * tstep : cB;
        for (int t = 0; t < nt; t += 2) {
            const bool last = (t == nt - 2);
            const char* a1 = cA + (size_t)(t + 1) * kstep;
            const char* a2 = last ? nA : cA + (size_t)(t + 2) * kstep; const char* b2 = last ? nB : cB + (size_t)(t + 2) * kstep;
            const char* a3 = a2 + kstep; const char* b3 = b2 + kstep;
            if (last && has_next) S.a_ready(nxt);
            if constexpr (SP2) {
            PG8_LDB(B0, 0, 0); PG8_LDB(B1, 0, 1); PG8_SCHED; PG8_LDA(At, 0, 0); PG8_STAGE(PG8_SA(1, 1), a1 + hstep, voffA);
            PG8_WAIT_V(8); PG8_WAIT_L(0); PG8_BAR; PG8_MMA(0, 0, At, B0); PG8_MMA(0, 1, At, B1); PG8_BAR; PG8_SCHED;
            PG8_LDA(At, 0, 1); PG8_STAGE(PG8_SB(0, 0), b2, voffB); PG8_STAGE(PG8_SB(0, 1), b2 + hstep, voffB); PG8_STAGE(PG8_SA(0, 0), a2, voffA);
            PG8_WAIT_V(8); PG8_WAIT_L(0); PG8_BAR; PG8_MMA(1, 0, At, B0); PG8_MMA(1, 1, At, B1); PG8_BAR; PG8_SCHED;
            PG8_LDB(B0, 1, 0); PG8_LDB(B1, 1, 1); PG8_SCHED; PG8_LDA(At, 1, 0); PG8_STAGE(PG8_SA(0, 1), a2 + hstep, voffA);
            PG8_WAIT_V(8); PG8_WAIT_L(0); PG8_BAR; PG8_MMA(0, 0, At, B0); PG8_MMA(0, 1, At, B1); PG8_BAR; PG8_SCHED;
            PG8_LDA(At, 1, 1); PG8_STAGE(PG8_SB(1, 0), b3, voffB); PG8_STAGE(PG8_SB(1, 1), b3 + hstep, voffB); PG8_STAGE(PG8_SA(1, 0), a3, voffA);
            PG8_WAIT_V(8); PG8_WAIT_L(0); PG8_BAR; PG8_MMA(1, 0, At, B0); PG8_MMA(1, 1, At, B1); PG8_BAR; PG8_SCHED;
            } else {
            PG8_LDB(B0, 0, 0); PG8_SCHED; PG8_LDA(At, 0, 0); PG8_STAGE(PG8_SA(1, 1), a1 + hstep, voffA);
            PG8_WAIT_L(8); PG8_BAR; PG8_WAIT_L(0); PG8_MMA(0, 0, At, B0); PG8_BAR; PG8_SCHED;
            PG8_LDB(B1, 0, 1); PG8_STAGE(PG8_SB(0, 0), b2, voffB);
            PG8_BAR; PG8_WAIT_L(0); PG8_MMA(0, 1, At, B1); PG8_BAR;
            PG8_LDA(At, 0, 1); PG8_STAGE(PG8_SA(0, 0), a2, voffA);
            PG8_BAR; PG8_WAIT_L(0); PG8_MMA(1, 0, At, B0); PG8_BAR; PG8_SCHED;
            PG8_STAGE(PG8_SB(0, 1), b2 + hstep, voffB);
            PG8_WAIT_V(6); PG8_BAR; PG8_MMA(1, 1, At, B1); PG8_BAR;
            PG8_LDB(B0, 1, 0); PG8_SCHED; PG8_LDA(At, 1, 0); PG8_STAGE(PG8_SA(0, 1), a2 + hstep, voffA);
            PG8_WAIT_L(8); PG8_BAR; PG8_WAIT_L(0); PG8_MMA(0, 0, At, B0); PG8_BAR; PG8_SCHED;
            PG8_LDB(B1, 1, 1); PG8_STAGE(PG8_SB(1, 0), b3, voffB);
            PG8_BAR; PG8_WAIT_L(0); PG8_MMA(0, 1, At, B1); PG8_BAR;
            PG8_LDA(At, 1, 1); PG8_STAGE(PG8_SA(1, 0), a3, voffA);
            PG8_BAR; PG8_WAIT_L(0); PG8_MMA(1, 0, At, B0); PG8_BAR; PG8_SCHED;
            PG8_STAGE(PG8_SB(1, 1), b3 + hstep, voffB);
            PG8_WAIT_V(6); PG8_BAR; PG8_MMA(1, 1, At, B1); PG8_BAR;
            }
        }
        if constexpr (ALIGN_EPI) { if (wr == 0) PG8_BAR; }
        if constexpr (!Epi::AFTER_DRAIN) { E(acc, cur, wr, wc, fr, fq); S.done(cur); }
        if (!has_next) break;
#pragma unroll
        for (int a = 0; a < 2; ++a)
#pragma unroll
            for (int b = 0; b < 2; ++b)
#pragma unroll
                for (int m = 0; m < 4; ++m)
#pragma unroll
                    for (int n = 0; n < 2; ++n) acc[a][b][m][n] = (f32x4){0.f, 0.f, 0.f, 0.f};
        cur = nxt; cA = nA; cB = nB; ++ui;
        if constexpr (ALIGN_EPI) { if (wr == 1) PG8_BAR; }
    }
    PG8_WAIT_V(0);
    if constexpr (!ALIGN_EPI) { if (wr == 0) PG8_BAR; }
    PG8_BAR;
    if constexpr (Epi::AFTER_DRAIN) { E.fused(acc, cur, wr, wc, fr, fq, lds, wid, lane); S.done(cur); }
#undef PG8_SA
#undef PG8_SB
#undef PG8_STAGE
#undef PG8_LDA
#undef PG8_LDB
#undef PG8_MMA
#undef PG8_WAIT_V
#undef PG8_WAIT_L
#undef PG8_BAR
#undef PG8_SCHED
}
}
constexpr int NWAVES = 8;
#ifndef MK_N_LAUNCHES
#define MK_N_LAUNCHES 1
#endif
constexpr int T_ = 8192, D_ = 2048, INW = 4640, NIN = 4864, RW = 1024, NH = 16, HD = 64, DFF = 5632, NUG = 2 * DFF;
constexpr int COL_R = 0, COL_K = 1024, COL_V = 2048, COL_XW = 3072, COL_XA = 3136, COL_XG = 3200, COL_Q = 3360, COL_KA = 4384, COL_VA = 4512, RIN = 3360;
constexpr float NORM_EPS = 1e-5f, LNX_EPS = 64e-5f;
constexpr size_t MiB = 1u << 20;
constexpr size_t WS_CTL = 0, CTL_ZERO_BYTES = 1 * MiB;
constexpr size_t WS_WIN = 1 * MiB, WS_WOUT = 20 * MiB, WS_HN = 28 * MiB, WS_Z = 61 * MiB, WS_RWA = 137 * MiB, WS_MISC = 250 * MiB, WS_END = 256 * MiB;
constexpr size_t WS_WUG = 61 * MiB, WS_WDN = 105 * MiB, WS_ACT = 127 * MiB, WS_H2 = 216 * MiB;
constexpr size_t RWA_STRIDE = 16 * MiB;
constexpr size_t MISC_BIAS = 0, MISC_ROPE = 64 * 1024, MISC_BON = 1 * MiB;
constexpr int CW_BAR = 4096;
constexpr int CW_SSQA = 65536, CW_SSQ2 = CW_SSQA + T_, CW_SSQ3 = CW_SSQ2 + T_;
static_assert((CW_SSQ3 + T_) * 4 <= (int)CTL_ZERO_BYTES, "ctl");
constexpr int RING_BYTES = 131072, XCH_OFF = RING_BYTES, LDSCTL_OFF = RING_BYTES + 4096, MISC_OFF = LDSCTL_OFF + 320, LDS_BYTES = 147456;

#define GAS __attribute__((address_space(1)))
#define LAS __attribute__((address_space(3)))
typedef unsigned short bf16;
typedef unsigned v4u __attribute__((ext_vector_type(4)));
typedef float f32x4 __attribute__((ext_vector_type(4)));
typedef GAS unsigned gu32;
#define RLX_AGENT __ATOMIC_RELAXED, __HIP_MEMORY_SCOPE_AGENT
#define LDS_WAIT() asm volatile("s_waitcnt lgkmcnt(0)" ::: "memory")
__device__ __forceinline__ unsigned f2bf(float f) { unsigned u = __builtin_bit_cast(unsigned, f); return (u + 0x7fffu + ((u >> 16) & 1u)) >> 16; }
__device__ __forceinline__ unsigned pk2(float lo, float hi) { return f2bf(lo) | (f2bf(hi) << 16); }
__device__ __forceinline__ float bf2f(unsigned h) { return __builtin_bit_cast(float, h << 16); }
__device__ __forceinline__ float wave_sum(float v) {
#pragma unroll
    for (int o = 1; o < 64; o <<= 1) v += __shfl_xor(v, o);
    return v;
}
#define XB_TMO      128
#define XB_XCNT(j)  (256  + 64 * (j))
#define XB_XSUB(j)  (1280 + 64 * (j))
#define XB_XGEN(j)  (2304 + 64 * (j))
#define XB_TOP      3328
#define XB_TOPGEN   3392
#define XCD_BAR_WORDS 3456
#define XB_SPIN_CAP (1u << 18)

__device__ __forceinline__ unsigned xb_ld(unsigned* p)              { return __hip_atomic_load(p, __ATOMIC_RELAXED, __HIP_MEMORY_SCOPE_AGENT); }
__device__ __forceinline__ unsigned xb_add(unsigned* p, unsigned v) { return __hip_atomic_fetch_add(p, v, __ATOMIC_RELAXED, __HIP_MEMORY_SCOPE_AGENT); }
__device__ __forceinline__ unsigned xb_xcc_id() { return (unsigned)__builtin_amdgcn_s_getreg((3 << 11) | 20) & 0xFu; }
#define XB_SPIN(cond, bar) do { unsigned _sp = 0; while (cond) { __builtin_amdgcn_s_sleep(1); \
    if ((++_sp & 255u) == 0u) { if (xb_ld(&(bar)[XB_TMO])) break; if (_sp > XB_SPIN_CAP) { atomicAdd(&(bar)[XB_TMO], 1u); break; } } } } while (0)

struct XcdBarrier {
    unsigned* bar; unsigned x;
    volatile LAS unsigned* st;
};

__device__ __forceinline__ XcdBarrier xcd_barrier_post(unsigned* bar, volatile LAS unsigned* st) {
    XcdBarrier b; b.bar = bar; b.x = xb_xcc_id(); b.st = st;
    if (threadIdx.x == 0) (void)xb_add(&bar[XB_XCNT(b.x)], 1u);
    return b;
}
__device__ __forceinline__ void xcd_barrier_complete(unsigned* bar, unsigned x, unsigned& nloc, unsigned& nx) {
    const unsigned G = gridDim.x * gridDim.y * gridDim.z;
    unsigned sum, cnt, mine, sp = 0u;
    for (;;) {
        sum = 0u; cnt = 0u; mine = 0u;
#pragma unroll
        for (unsigned j = 0; j < 16; ++j) { const unsigned c = xb_ld(&bar[XB_XCNT(j)]); sum += c; cnt += (c > 0u) ? 1u : 0u; mine = (j == x) ? c : mine; }
        if (sum == G) break;
        __builtin_amdgcn_s_sleep(1);
        if ((++sp & 255u) == 0u) { if (xb_ld(&bar[XB_TMO])) break; if (sp > XB_SPIN_CAP) { atomicAdd(&bar[XB_TMO], 1u); break; } }
    }
    nloc = mine > 0u ? mine : 1u; nx = cnt > 0u ? cnt : 1u;
}

__device__ __forceinline__ void xcd_barrier(const XcdBarrier& b) {
    asm volatile("s_waitcnt vmcnt(0)" ::: "memory");
    __syncthreads();
    if (threadIdx.x == 0) {
        unsigned* bar = b.bar;
        __builtin_amdgcn_s_waitcnt(0);
        unsigned nloc = b.st[0], nx = b.st[1];
        if (nloc == 0u) { xcd_barrier_complete(bar, b.x, nloc, nx); b.st[0] = nloc; b.st[1] = nx; }
        const unsigned old = xb_add(&bar[XB_XSUB(b.x)], 1u);
        const unsigned gen = old / nloc;
        if (old + 1u == (gen + 1u) * nloc) {
            __builtin_amdgcn_fence(__ATOMIC_RELEASE, "agent");
            asm volatile("s_waitcnt vmcnt(0)" ::: "memory");
            const unsigned og = xb_add(&bar[XB_TOP], 1u);
            const unsigned tg = og / nx;
            if (og + 1u == (tg + 1u) * nx) xb_add(&bar[XB_TOPGEN], 1u);
            else XB_SPIN(xb_ld(&bar[XB_TOPGEN]) == tg, bar);
            __builtin_amdgcn_fence(__ATOMIC_ACQUIRE, "agent");
            xb_add(&bar[XB_XGEN(b.x)], 1u);
            asm volatile("s_waitcnt vmcnt(0)" ::: "memory");
        } else {
            XB_SPIN(xb_ld(&bar[XB_XGEN(b.x)]) == gen, bar);
            __builtin_amdgcn_fence(__ATOMIC_ACQUIRE, "agent");
            asm volatile("s_waitcnt vmcnt(0)" ::: "memory");
        }
    }
    __syncthreads();
}
struct Ctx {
    LAS unsigned char* lds; int tid, lane, wave, vcu, G;
    const float* in[25]; float* out; unsigned char* ws;
};
#define IN_X 0
#define IN_LN_MIX_G 1
#define IN_W_IN 2
#define IN_B_ATTN 3
#define IN_MU 4
#define IN_W0 5
#define IN_W2 6
#define IN_A0 7
#define IN_A2 8
#define IN_G2 9
#define IN_K_K 10
#define IN_K_A 11
#define IN_R_K 12
#define IN_LNX_G 13
#define IN_LNX_B 14
#define IN_SINKS 15
#define IN_ATTN_G 16
#define IN_W_OUT 17
#define IN_LN_FFN_G 18
#define IN_W_UP 19
#define IN_W_GATE 20
#define IN_CONV_W 21
#define IN_CONV_B 22
#define IN_W_DOWN 23
#define IN_LN_FINAL_G 24

__device__ __forceinline__ void transpose_item(const float* W, int K, int N, bf16* WT, int drow0, LAS float* scr, int k0, int n0, int lane) {
#pragma unroll 8
    for (int i = 0; i < 32; ++i) { const int kk = 2 * i + (lane >> 5); scr[kk * 33 + (lane & 31)] = W[(size_t)(k0 + kk) * N + n0 + (lane & 31)]; }
    LDS_WAIT(); asm volatile("" ::: "memory");
    const int c = lane & 7;
#pragma unroll
    for (int j = 0; j < 4; ++j) { const int n = (lane >> 3) + 8 * j; const LAS float* s = scr + (8 * c) * 33 + n;
        v4u o; o.x = pk2(s[0 * 33], s[1 * 33]); o.y = pk2(s[2 * 33], s[3 * 33]); o.z = pk2(s[4 * 33], s[5 * 33]); o.w = pk2(s[6 * 33], s[7 * 33]);
        *(GAS v4u*)(WT + (size_t)(drow0 + n) * K + k0 + 8 * c) = o; }
    LDS_WAIT(); asm volatile("" ::: "memory");
}
__device__ __forceinline__ void rms_row_to_bf16(const float* xrow, const float* g, bf16* orow, int lane) {
    const GAS f32x4* xr = (const GAS f32x4*)xrow + lane; const GAS f32x4* gr = (const GAS f32x4*)g + lane;
    f32x4 v[8]; float s = 0.f;
#pragma unroll
    for (int j = 0; j < 8; ++j) { v[j] = xr[64 * j]; s += (v[j].x * v[j].x + v[j].y * v[j].y) + (v[j].z * v[j].z + v[j].w * v[j].w); }
    const float rs = 1.0f / sqrtf(wave_sum(s) * (1.f / D_) + NORM_EPS);
    GAS unsigned long long* o8 = (GAS unsigned long long*)orow + lane;
#pragma unroll
    for (int j = 0; j < 8; ++j) { const f32x4 gg = gr[64 * j]; o8[64 * j] = (unsigned long long)pk2(v[j].x * rs * gg.x, v[j].y * rs * gg.y) | ((unsigned long long)pk2(v[j].z * rs * gg.z, v[j].w * rs * gg.w) << 32); }
}

__device__ __forceinline__ void ph_prologue(Ctx& F) {
    LAS float* scr = (LAS float*)(F.lds + F.wave * 16384);
    const int gw = F.vcu * NWAVES + F.wave, NGW = F.G * NWAVES, gt = gw * 64 + F.lane, NGT = NGW * 64;
    bf16* WIN = (bf16*)(F.ws + WS_WIN); bf16* WOUT = (bf16*)(F.ws + WS_WOUT); bf16* HN = (bf16*)(F.ws + WS_HN);
    constexpr int I_IN = (D_ / 64) * (INW / 32), I_OUT = (D_ / 64) * (D_ / 32);
    for (int it = gw; it < I_IN + I_OUT; it += NGW) {
        if (it < I_IN) { const int nblk = INW / 32, kb = it / nblk, nb = it % nblk; transpose_item(F.in[IN_W_IN], D_, INW, WIN, 32 * nb, scr, 64 * kb, 32 * nb, F.lane); }
        else { const int r = it - I_IN, nblk = D_ / 32, kb = r / nblk, nb = r % nblk; transpose_item(F.in[IN_W_OUT], D_, D_, WOUT, 32 * nb, scr, 64 * kb, 32 * nb, F.lane); }
    }
    { GAS v4u* p = (GAS v4u*)(WIN + (size_t)INW * D_); const int n16 = (NIN - INW) * D_ * 2 / 16; for (int i = gt; i < n16; i += NGT) p[i] = (v4u){0u, 0u, 0u, 0u}; }
    { float* b = (float*)(F.ws + WS_MISC + MISC_BIAS); for (int i = gt; i < NIN; i += NGT) b[i] = (i >= RIN && i < INW) ? F.in[IN_B_ATTN][i - RIN] : 0.f; }
    { float* rt = (float*)(F.ws + WS_MISC + MISC_ROPE);
      for (int i = gt; i < T_ * 8; i += NGT) { const int t = i >> 3, k = i & 7;
          const float invf = k == 0 ? 1.0f : k == 1 ? 0x1.8d275ep-3f : k == 2 ? 0x1.341190p-5f : k == 3 ? 0x1.ddee9cp-8f : k == 4 ? 0x1.72ba44p-10f : k == 5 ? 0x1.1f91f0p-12f : k == 6 ? 0x1.be2188p-15f : 0x1.5a0f4ep-17f;
          const float ang = (float)t * invf;
          const double a = (double)ang, kq = rint(a * 0.15915494309189535), rr = fma(-kq, 6.283185307179586, a); const float rf = (float)rr;
          rt[t * 16 + k] = cosf(rf); rt[t * 16 + 8 + k] = sinf(rf); } }
    for (int m = gw; m < T_; m += NGW) rms_row_to_bf16(F.in[IN_X] + (size_t)m * D_, F.in[IN_LN_MIX_G], HN + (size_t)m * D_, F.lane);
}
__device__ __forceinline__ void ph_ffn_weights(Ctx& F, int gw, int NGW, int part) {
    LAS float* scr = (LAS float*)(F.lds + F.wave * 16384);
    bf16* WUG = (bf16*)(F.ws + WS_WUG); bf16* WDN = (bf16*)(F.ws + WS_WDN);
    constexpr int I_UP = (D_ / 64) * (DFF / 32), I_DN = (DFF / 64) * (D_ / 32);
    const int it_lo = (part == 1) ? 2 * I_UP : 0, it_hi = (part == 0) ? 2 * I_UP : 2 * I_UP + I_DN;
    for (int it = it_lo + gw; it < it_hi; it += NGW) {
        if (it < 2 * I_UP) { const int gate = it >= I_UP, r = gate ? it - I_UP : it, nblk = DFF / 32, kb = r / nblk, nb = r % nblk, n0 = 32 * nb;
            transpose_item(F.in[gate ? IN_W_GATE : IN_W_UP], D_, DFF, WUG, 256 * (n0 >> 7) + (n0 & 127) + (gate ? 128 : 0), scr, 64 * kb, n0, F.lane); }
        else { const int r = it - 2 * I_UP, nblk = D_ / 32, kb = r / nblk, nb = r % nblk; transpose_item(F.in[IN_W_DOWN], DFF, D_, WDN, 32 * nb, scr, 64 * kb, 32 * nb, F.lane); }
    }
}
__device__ __forceinline__ void ph_attention_naive(Ctx& F) {
    const bf16* Z = (const bf16*)(F.ws + WS_Z); bf16* YC = (bf16*)(F.ws + WS_HN); const float* rope = (const float*)(F.ws + WS_MISC + MISC_ROPE);
    float* ssqA = (float*)(F.ws + WS_CTL) + CW_SSQA;
    for (int it = F.vcu; it < 64 * NH; it += F.G) {
        const int nb = it >> 4, h = it & 15, kvh = h >> 3, q = F.tid >> 2, p = F.tid & 3, t = 128 * nb + q;
        float qv[64];
        { const bf16* qp = Z + (size_t)t * NIN + COL_Q + h * 64;
#pragma unroll
          for (int d = 0; d < 64; d += 8) { const v4u w = *(const GAS v4u*)(qp + d); const unsigned ww[4] = {w.x, w.y, w.z, w.w};
#pragma unroll
              for (int e = 0; e < 4; ++e) { qv[d + 2 * e] = bf2f(ww[e] & 0xffffu); qv[d + 2 * e + 1] = bf2f(ww[e] >> 16); } }
#pragma unroll
          for (int i = 0; i < 8; ++i) { const float c = rope[t * 16 + i], s = rope[t * 16 + 8 + i], x1 = qv[i], x2 = qv[8 + i]; qv[i] = x1 * c - x2 * s; qv[8 + i] = x2 * c + x1 * s; } }
        float m = -INFINITY, l = 0.f, o[64];
#pragma unroll
        for (int d = 0; d < 64; ++d) o[d] = 0.f;
        for (int i = 0; i < 32; ++i) {
            const int kp = t - 127 + 32 * p + i;
            if (kp >= 0) {
                const bf16* kr = Z + (size_t)kp * NIN + COL_KA + kvh * 64; const bf16* vr = Z + (size_t)kp * NIN + COL_VA + kvh * 64;
                float kv[16];
                { const v4u w0 = *(const GAS v4u*)(kr), w1 = *(const GAS v4u*)(kr + 8); const unsigned ww[8] = {w0.x, w0.y, w0.z, w0.w, w1.x, w1.y, w1.z, w1.w};
#pragma unroll
                  for (int e = 0; e < 8; ++e) { kv[2 * e] = bf2f(ww[e] & 0xffffu); kv[2 * e + 1] = bf2f(ww[e] >> 16); } }
                float s = 0.f;
#pragma unroll
                for (int j = 0; j < 8; ++j) { const float c = rope[kp * 16 + j], sn = rope[kp * 16 + 8 + j], x1 = kv[j], x2 = kv[8 + j]; s += qv[j] * (x1 * c - x2 * sn) + qv[8 + j] * (x2 * c + x1 * sn); }
#pragma unroll
                for (int d = 16; d < 64; d += 8) { const v4u w = *(const GAS v4u*)(kr + d); const unsigned ww[4] = {w.x, w.y, w.z, w.w};
#pragma unroll
                    for (int e = 0; e < 4; ++e) s += qv[d + 2 * e] * bf2f(ww[e] & 0xffffu) + qv[d + 2 * e + 1] * bf2f(ww[e] >> 16); }
                s *= 0.125f;
                const float mn = fmaxf(m, s), al = __expf(m - mn), pe = __expf(s - mn);
                l = l * al + pe; m = mn;
#pragma unroll
                for (int d = 0; d < 64; d += 8) { const v4u w = *(const GAS v4u*)(vr + d); const unsigned ww[4] = {w.x, w.y, w.z, w.w};
#pragma unroll
                    for (int e = 0; e < 4; ++e) { o[d + 2 * e] = o[d + 2 * e] * al + pe * bf2f(ww[e] & 0xffffu); o[d + 2 * e + 1] = o[d + 2 * e + 1] * al + pe * bf2f(ww[e] >> 16); } }
            }
        }
        float M = fmaxf(m, __shfl_xor(m, 1)); M = fmaxf(M, __shfl_xor(M, 2));
        const float sc = (m == -INFINITY) ? 0.f : __expf(m - M);
        l *= sc; l += __shfl_xor(l, 1); l += __shfl_xor(l, 2);
        const float den = 1.0f / (l + __expf(F.in[IN_SINKS][h] - M));
        float sq = 0.f;
#pragma unroll
        for (int d = 0; d < 64; ++d) { float v = o[d] * sc; v += __shfl_xor(v, 1); v += __shfl_xor(v, 2); o[d] = v * den; sq += o[d] * o[d]; }
        if (p == 0) { bf16* op = YC + (size_t)t * D_ + RW + h * 64;
#pragma unroll
            for (int d = 0; d < 64; d += 8) { v4u w; w.x = pk2(o[d], o[d + 1]); w.y = pk2(o[d + 2], o[d + 3]); w.z = pk2(o[d + 4], o[d + 5]); w.w = pk2(o[d + 6], o[d + 7]); *(GAS v4u*)(op + d) = w; }
            atomicAdd(ssqA + t, sq); }
    }
}
__device__ __forceinline__ float zshift(const bf16* Z, const float* mu, int t, int col) {
    const float zc = bf2f(Z[(size_t)t * NIN + col]); const float zp = t > 0 ? bf2f(Z[(size_t)(t - 1) * NIN + col]) : 0.f; return zc + mu[col] * (zp - zc);
}
__device__ __forceinline__ void ph_rwkv_prep_naive(Ctx& F) {
    const bf16* Z = (const bf16*)(F.ws + WS_Z); const float* mu = F.in[IN_MU];
    bf16* KK = (bf16*)(F.ws + WS_RWA); bf16* BB = KK + RWA_STRIDE / 2; bf16* KM = BB + RWA_STRIDE / 2; bf16* RS = KM + RWA_STRIDE / 2; bf16* VS = RS + RWA_STRIDE / 2; bf16* GG = VS + RWA_STRIDE / 2;
    float* LW = F.out; float* BON = (float*)(F.ws + WS_MISC + MISC_BON);
    LAS float* aw = (LAS float*)F.lds; LAS float* aa = aw + 8 * 64; LAS float* ag = aa + 8 * 64;
    for (int grp = F.vcu; grp < T_ / 8; grp += F.G) {
        const int t0 = grp * 8;
        __syncthreads();
        for (int e = F.tid; e < 8 * 288; e += 512) { const int tok = e / 288, j = e % 288; const float v = zshift(Z, mu, t0 + tok, COL_XW + j);
            if (j < 64) aw[tok * 64 + j] = tanhf(v); else if (j < 128) aa[tok * 64 + j - 64] = v; else ag[tok * 160 + j - 128] = 1.0f / (1.0f + __expf(-v)); }
        __syncthreads();
#pragma unroll 1
        for (int cc = 0; cc < 2; ++cc) {
            const int c = F.tid + 512 * cc;
            float wl[8], al[8], gl[8];
#pragma unroll
            for (int k = 0; k < 8; ++k) { wl[k] = 0.f; al[k] = 0.f; gl[k] = 0.f; }
            for (int j = 0; j < 64; ++j) { const float w2v = F.in[IN_W2][j * RW + c], a2v = F.in[IN_A2][j * RW + c];
#pragma unroll
                for (int k = 0; k < 8; ++k) { wl[k] += aw[k * 64 + j] * w2v; al[k] += aa[k * 64 + j] * a2v; } }
            for (int j = 0; j < 160; ++j) { const float g2v = F.in[IN_G2][j * RW + c];
#pragma unroll
                for (int k = 0; k < 8; ++k) gl[k] += ag[k * 160 + j] * g2v; }
            const float w0 = F.in[IN_W0][c], a0 = F.in[IN_A0][c], kkc = F.in[IN_K_K][c], kac = F.in[IN_K_A][c];
#pragma unroll
            for (int k = 0; k < 8; ++k) { const int t = t0 + k; const size_t o = (size_t)t * RW + c;
                const float x = w0 + wl[k];
                const float sp = (x < -20.f) ? -x : log1pf(__expf(-x));
                LW[o] = -__expf(-sp - 0.5f);
                const float a = 1.0f / (1.0f + __expf(-(a0 + al[k])));
                const float kraw = zshift(Z, mu, t, COL_K + c), kkv = kraw * kkc;
                const float nrm = fmaxf(sqrtf(wave_sum(kkv * kkv)), 1e-12f); const float kn = kkv / nrm;
                KK[o] = (bf16)f2bf(kn); BB[o] = (bf16)f2bf(kn * a); KM[o] = (bf16)f2bf(kraw * (1.0f + (a - 1.0f) * kac));
                const float rsh = zshift(Z, mu, t, COL_R + c), kmd = kraw * (1.0f + (a - 1.0f) * kac);
                const float bon = wave_sum(rsh * kmd * F.in[IN_R_K][c]); if (F.lane == 0) BON[t * 16 + (c >> 6)] = bon;
                RS[o] = (bf16)f2bf(rsh); VS[o] = (bf16)f2bf(zshift(Z, mu, t, COL_V + c)); GG[o] = (bf16)f2bf(gl[k]); }
        }
    }
}
__device__ __forceinline__ void ph_rwkv_scan_naive(Ctx& F) {
    if (F.vcu >= NH || F.wave != 0) return;
    const int h = F.vcu, l = F.lane;
    const bf16* KK = (const bf16*)(F.ws + WS_RWA); const bf16* BB = KK + RWA_STRIDE / 2; const bf16* KM = BB + RWA_STRIDE / 2; const bf16* RS = KM + RWA_STRIDE / 2; const bf16* VS = RS + RWA_STRIDE / 2;
    const float* LW = F.out; float* Y = F.out + (size_t)T_ * RW;
    float S[64];
#pragma unroll
    for (int j = 0; j < 64; ++j) S[j] = 0.f;
    size_t o = (size_t)h * 64 + l;
    float n_lw = LW[o]; unsigned n_kk = KK[o], n_bb = BB[o], n_km = KM[o], n_rs = RS[o], n_vs = VS[o];
    for (int t = 0; t < T_; ++t) {
        const float w = __expf(n_lw), kk = bf2f(n_kk), bb = bf2f(n_bb), km = bf2f(n_km), r = bf2f(n_rs), v = bf2f(n_vs);
        if (t + 1 < T_) { const size_t o2 = (size_t)(t + 1) * RW + h * 64 + l; n_lw = LW[o2]; n_kk = KK[o2]; n_bb = BB[o2]; n_km = KM[o2]; n_rs = RS[o2]; n_vs = VS[o2]; }
        float sa = 0.f;
#pragma unroll
        for (int j = 0; j < 64; ++j) sa += S[j] * __builtin_bit_cast(float, __builtin_amdgcn_readlane(__builtin_bit_cast(int, kk), j));
        sa = -sa;
        float y = 0.f;
#pragma unroll
        for (int j = 0; j < 64; ++j) {
            const float wj = __builtin_bit_cast(float, __builtin_amdgcn_readlane(__builtin_bit_cast(int, w), j)), bj = __builtin_bit_cast(float, __builtin_amdgcn_readlane(__builtin_bit_cast(int, bb), j));
            const float kj = __builtin_bit_cast(float, __builtin_amdgcn_readlane(__builtin_bit_cast(int, km), j)), rj = __builtin_bit_cast(float, __builtin_amdgcn_readlane(__builtin_bit_cast(int, r), j));
            S[j] = S[j] * wj + (sa * bj + v * kj); y += S[j] * rj; }
        Y[(size_t)t * RW + h * 64 + l] = y;
    }
}
__device__ __forceinline__ void ph_post(Ctx& F) {
    const bf16* KM = (const bf16*)(F.ws + WS_RWA) + 2 * (RWA_STRIDE / 2); const bf16* RS = KM + RWA_STRIDE / 2; const bf16* VS = RS + RWA_STRIDE / 2; const bf16* GG = VS + RWA_STRIDE / 2;
    const float* Y = F.out + (size_t)T_ * RW; bf16* YC = (bf16*)(F.ws + WS_HN); const float* ssqA = (const float*)(F.ws + WS_CTL) + CW_SSQA;
    const int gw = F.vcu * NWAVES + F.wave, NGW = F.G * NWAVES, l = F.lane;
    for (int it = gw; it < T_ * NH; it += NGW) {
        const int t = it >> 4, h = it & 15, c = h * 64 + l; const size_t o = (size_t)t * RW + c;
        const float y = Y[o]; const float mu = wave_sum(y) * (1.f / 64.f); const float d = y - mu; const float var = wave_sum(d * d) * (1.f / 64.f);
        const float yn = d * (1.0f / sqrtf(var + LNX_EPS)) * F.in[IN_LNX_G][c] + F.in[IN_LNX_B][c];
        const float r = bf2f(RS[o]), k = bf2f(KM[o]), v = bf2f(VS[o]), g = bf2f(GG[o]);
        const float bonus = wave_sum(r * k * F.in[IN_R_K][c]) * v;
        YC[(size_t)t * D_ + c] = (bf16)f2bf((yn + bonus) * g);
    }
    for (int t = gw; t < T_; t += NGW) {
        const float sc = 1.0f / sqrtf(ssqA[t] * (1.f / RW) + NORM_EPS);
        bf16* p = YC + (size_t)t * D_ + RW;
#pragma unroll
        for (int j = 0; j < 16; ++j) { const int c = j * 64 + l; p[c] = (bf16)f2bf(bf2f(p[c]) * sc * F.in[IN_ATTN_G][c]); }
    }
}
__device__ __forceinline__ void ph_final(Ctx& F) {
    const float* ssq3 = (const float*)(F.ws + WS_CTL) + CW_SSQ3; const int gw = F.vcu * NWAVES + F.wave, NGW = F.G * NWAVES;
    for (int t = gw; t < T_; t += NGW) {
        const float sc = 1.0f / sqrtf(ssq3[t] * (1.f / D_) + NORM_EPS);
        GAS f32x4* xr = (GAS f32x4*)(F.out + (size_t)t * D_) + F.lane; const GAS f32x4* gr = (const GAS f32x4*)F.in[IN_LN_FINAL_G] + F.lane;
#pragma unroll
        for (int j = 0; j < 8; ++j) { const f32x4 v = xr[64 * j], g = gr[64 * j]; xr[64 * j] = v * sc * g; }
    }
}
typedef short bf16x8 __attribute__((ext_vector_type(8)));
typedef unsigned u32x2v __attribute__((ext_vector_type(2)));
constexpr int RS_ = 144;
constexpr int MATB = 64 * RS_;
constexpr int L_RMA = 0, L_RMR = MATB, L_RMB = 2 * MATB, L_RMK = 3 * MATB;
constexpr int L_XTA = L_RMB, L_XTV = L_RMK;
constexpr int L_CMA = 4 * MATB, L_CMBH = 5 * MATB, L_CMKH = 6 * MATB, L_CMV = 7 * MATB;
constexpr int L_LAB = 8 * MATB, L_LAK = 9 * MATB, L_LRB = 10 * MATB, L_LRK = 11 * MATB;
constexpr int L_LD = 12 * MATB, L_TI = L_LD + 4096, L_TOT = L_TI + 2048, L_R1END = L_TOT + 2048;
static_assert(L_R1END <= RING_BYTES, "R1 LDS");
constexpr size_t WS_SC = 1 * MiB, WS_WC = 17 * MiB, WS_H = 105 * MiB, WS_YB = 233 * MiB;
constexpr size_t OUT_GP = 32 * MiB, OUT_RB = 48 * MiB, OUT_LW = 0;


__device__ __forceinline__ f32x4 mfma16(bf16x8 a, bf16x8 b, f32x4 c) { return __builtin_amdgcn_mfma_f32_16x16x32_bf16(a, b, c, 0, 0, 0); }
__device__ __forceinline__ bf16x8 ld128(const LAS unsigned char* p) { return *(const LAS bf16x8*)p; }
__device__ __forceinline__ u32x2v ld64(const LAS unsigned char* p) { return *(const LAS u32x2v*)p; }
__device__ __forceinline__ u32x2v pack4(f32x4 v) { u32x2v r; r.x = pk2(v[0], v[1]); r.y = pk2(v[2], v[3]); return r; }
__device__ __forceinline__ f32x4 unpack4(u32x2v w) { return (f32x4){bf2f(w.x & 0xffffu), bf2f(w.x >> 16), bf2f(w.y & 0xffffu), bf2f(w.y >> 16)}; }
__device__ __forceinline__ bf16x8 cat8(u32x2v lo, u32x2v hi) { v4u t; t.x = lo.x; t.y = lo.y; t.z = hi.x; t.w = hi.y; return __builtin_bit_cast(bf16x8, t); }

__device__ __forceinline__ void ph_rwkv_chunk(Ctx& F) {
    const bf16* KK = (const bf16*)(F.ws + WS_RWA); const bf16* BB = KK + RWA_STRIDE / 2; const bf16* KM = BB + RWA_STRIDE / 2; const bf16* RSg = KM + RWA_STRIDE / 2; const bf16* VSg = RSg + RWA_STRIDE / 2;
    const float* LWg = (const float*)((const unsigned char*)F.out + OUT_LW);
    unsigned char* GPg = (unsigned char*)F.out + OUT_GP; unsigned char* RBg = (unsigned char*)F.out + OUT_RB;
    float* WCg = (float*)(F.ws + WS_WC); float* Hg = (float*)(F.ws + WS_H); unsigned char* YBg = F.ws + WS_YB;
    LAS unsigned char* lds = F.lds;
    const int w = F.wave, l = F.lane, r = l & 15, q = l >> 4;
    const u32x2v zero2 = (u32x2v){0u, 0u};
    for (int it = F.vcu; it < 128 * NH; it += F.G) {
        const int c = it >> 4, h = it & 15;
        __syncthreads();
        {
            float lwv[8], kkv[8], bbv[8], kmv[8], rsv[8], vsv[8];
#pragma unroll
            for (int i = 0; i < 8; ++i) { const size_t idx = (size_t)(64 * c + 8 * w + i) * RW + h * 64 + l;
                lwv[i] = LWg[idx]; kkv[i] = bf2f(KK[idx]); bbv[i] = bf2f(BB[idx]); kmv[i] = bf2f(KM[idx]); rsv[i] = bf2f(RSg[idx]); vsv[i] = bf2f(VSg[idx]); }
            float cs[8]; cs[0] = lwv[0];
#pragma unroll
            for (int i = 1; i < 8; ++i) cs[i] = cs[i - 1] + lwv[i];
            LAS float* tot = (LAS float*)(lds + L_TOT);
            tot[w * 64 + l] = cs[7];
            __syncthreads();
            float pre = 0.f, total = 0.f;
#pragma unroll
            for (int ww = 0; ww < 8; ++ww) { const float tv = tot[ww * 64 + l]; total += tv; if (ww < w) pre += tv; }
            if (w == 0) WCg[it * 64 + l] = __expf(total);
            unsigned pa[4], pbh[4], pkh[4], pv[4];
#pragma unroll
            for (int i = 0; i < 8; ++i) { const float LWt = pre + cs[i], LWm = LWt - lwv[i];
                const float eA = __expf(LWm), eR = __expf(LWt), eN = __expf(-LWt), eH = __expf(total - LWt);
                const unsigned vA = f2bf(-kkv[i] * eA), vR = f2bf(rsv[i] * eR), vB = f2bf(bbv[i] * eN), vK = f2bf(kmv[i] * eN), vBh = f2bf(bbv[i] * eH), vKh = f2bf(kmv[i] * eH), vV = f2bf(vsv[i]);
                const int t = 8 * w + i;
                *(LAS unsigned short*)(lds + L_RMA + t * RS_ + l * 2) = (unsigned short)vA; *(LAS unsigned short*)(lds + L_RMR + t * RS_ + l * 2) = (unsigned short)vR;
                *(LAS unsigned short*)(lds + L_RMB + t * RS_ + l * 2) = (unsigned short)vB; *(LAS unsigned short*)(lds + L_RMK + t * RS_ + l * 2) = (unsigned short)vK;
                if (i & 1) { pa[i >> 1] |= vA << 16; pbh[i >> 1] |= vBh << 16; pkh[i >> 1] |= vKh << 16; pv[i >> 1] |= vV << 16; }
                else { pa[i >> 1] = vA; pbh[i >> 1] = vBh; pkh[i >> 1] = vKh; pv[i >> 1] = vV; } }
            *(LAS v4u*)(lds + L_CMA + l * RS_ + w * 16) = (v4u){pa[0], pa[1], pa[2], pa[3]}; *(LAS v4u*)(lds + L_CMBH + l * RS_ + w * 16) = (v4u){pbh[0], pbh[1], pbh[2], pbh[3]};
            *(LAS v4u*)(lds + L_CMKH + l * RS_ + w * 16) = (v4u){pkh[0], pkh[1], pkh[2], pkh[3]}; *(LAS v4u*)(lds + L_CMV + l * RS_ + w * 16) = (v4u){pv[0], pv[1], pv[2], pv[3]};
        }
        __syncthreads();
        {
            const int p = w >> 1, half = w & 1; const int Arm = (p & 1) ? L_RMK : L_RMB, Brm = (p >> 1) ? L_RMR : L_RMA, Lout = L_LAB + p * MATB; const bool strict = p < 2;
            bf16x8 Bf[2][2];
#pragma unroll
            for (int tbi = 0; tbi < 2; ++tbi)
#pragma unroll
                for (int ks = 0; ks < 2; ++ks) Bf[tbi][ks] = ld128(lds + Brm + (16 * (2 * half + tbi) + r) * RS_ + (32 * ks + 8 * q) * 2);
#pragma unroll
            for (int sb = 0; sb < 4; ++sb) {
                const bf16x8 A0 = ld128(lds + Arm + (16 * sb + r) * RS_ + (8 * q) * 2), A1 = ld128(lds + Arm + (16 * sb + r) * RS_ + (32 + 8 * q) * 2);
#pragma unroll
                for (int tbi = 0; tbi < 2; ++tbi) { const int tb = 2 * half + tbi;
                    f32x4 acc = (f32x4){0.f, 0.f, 0.f, 0.f}; acc = mfma16(A0, Bf[tbi][0], acc); acc = mfma16(A1, Bf[tbi][1], acc);
                    const int t = 16 * tb + r, s0 = 16 * sb + 4 * q;
#pragma unroll
                    for (int e = 0; e < 4; ++e) { const bool keep = strict ? (s0 + e < t) : (s0 + e <= t); acc[e] = keep ? acc[e] : 0.f; }
                    *(LAS u32x2v*)(lds + Lout + t * RS_ + s0 * 2) = pack4(acc);
                    if (p == 0 && sb == tb) *(LAS f32x4*)(lds + L_LD + ((sb * 16 + r) * 16 + 4 * q) * 4) = acc; }
            }
        }
        __syncthreads();
        f32x4 acc[4];
        if (w >= 4) {
            const int nbv = w - 4;
            const bf16x8 V0 = ld128(lds + L_CMV + (16 * nbv + r) * RS_ + (8 * q) * 2), V1 = ld128(lds + L_CMV + (16 * nbv + r) * RS_ + (32 + 8 * q) * 2);
#pragma unroll
            for (int I = 0; I < 4; ++I) { acc[I] = (f32x4){0.f, 0.f, 0.f, 0.f};
                acc[I] = mfma16(ld128(lds + L_LAK + (16 * I + r) * RS_ + (8 * q) * 2), V0, acc[I]); acc[I] = mfma16(ld128(lds + L_LAK + (16 * I + r) * RS_ + (32 + 8 * q) * 2), V1, acc[I]); }
        } else {
#pragma unroll
            for (int I = 0; I < 4; ++I) acc[I] = unpack4(ld64(lds + L_CMA + (16 * w + r) * RS_ + (16 * I + 4 * q) * 2));
            if (w == 3) {
                const int b = q, cc = r; float x[16];
#pragma unroll
                for (int t = 0; t < 16; ++t) { float a = (t == cc) ? 1.f : 0.f;
#pragma unroll
                    for (int s4 = 0; s4 * 4 < t; ++s4) { const f32x4 lv = *(const LAS f32x4*)(lds + L_LD + ((b * 16 + t) * 16 + 4 * s4) * 4);
#pragma unroll
                        for (int e = 0; e < 4; ++e) if (4 * s4 + e < t) a += lv[e] * x[4 * s4 + e]; }
                    x[t] = a; *(LAS unsigned short*)(lds + L_TI + ((b * 16 + t) * 16 + cc) * 2) = (unsigned short)f2bf(a); }
            }
        }
        __syncthreads();
        {
            const f32x4 z4 = (f32x4){0.f, 0.f, 0.f, 0.f};
#define TIF(I) cat8(ld64(lds + L_TI + (((I) * 16 + r) * 16 + 4 * q) * 2), zero2)
#define LF1(I, K1) cat8(ld64(lds + L_LAB + (16 * (I) + r) * RS_ + (16 * (K1) + 4 * q) * 2), zero2)
#define LF2(I, K1, K2) cat8(ld64(lds + L_LAB + (16 * (I) + r) * RS_ + (16 * (K1) + 4 * q) * 2), ld64(lds + L_LAB + (16 * (I) + r) * RS_ + (16 * (K2) + 4 * q) * 2))
            const f32x4 X0 = mfma16(TIF(0), cat8(pack4(acc[0]), zero2), z4);
            const f32x4 Q1 = mfma16(LF1(1, 0), cat8(pack4(X0), zero2), acc[1]);
            const f32x4 X1 = mfma16(TIF(1), cat8(pack4(Q1), zero2), z4);
            const bf16x8 B01 = cat8(pack4(X0), pack4(X1));
            const f32x4 Q2 = mfma16(LF2(2, 0, 1), B01, acc[2]);
            const f32x4 X2 = mfma16(TIF(2), cat8(pack4(Q2), zero2), z4);
            f32x4 Q3 = mfma16(LF2(3, 0, 1), B01, acc[3]); Q3 = mfma16(LF1(3, 2), cat8(pack4(X2), zero2), Q3);
            const f32x4 X3 = mfma16(TIF(3), cat8(pack4(Q3), zero2), z4);
#undef TIF
#undef LF1
#undef LF2
            const int xo = (w < 4 ? L_XTA : L_XTV) + (16 * (w & 3) + r) * RS_ + (4 * q) * 2;
            *(LAS u32x2v*)(lds + xo) = pack4(X0); *(LAS u32x2v*)(lds + xo + 32) = pack4(X1); *(LAS u32x2v*)(lds + xo + 64) = pack4(X2); *(LAS u32x2v*)(lds + xo + 96) = pack4(X3);
        }
        __syncthreads();
        {
            const int lo4 = w & 3, hi2 = w >> 2; const f32x4 z4 = (f32x4){0.f, 0.f, 0.f, 0.f};
#define FR(base, row0, ks) ld128(lds + (base) + ((row0) + r) * RS_ + (32 * (ks) + 8 * q) * 2)
            {
                const bf16x8 B0 = FR(L_CMBH, 16 * lo4, 0), B1 = FR(L_CMBH, 16 * lo4, 1); u32x2v o[2];
#pragma unroll
                for (int hf = 0; hf < 2; ++hf) { const int jb = 2 * hi2 + hf; f32x4 a = mfma16(FR(L_XTA, 16 * jb, 0), B0, z4); a = mfma16(FR(L_XTA, 16 * jb, 1), B1, a); o[hf] = pack4(a); }
                *(GAS v4u*)(GPg + (size_t)it * 8192 + ((lo4 * 2 + hi2) * 64 + l) * 16) = (v4u){o[0].x, o[0].y, o[1].x, o[1].y};
            }
            {
                const bf16x8 B0 = FR(L_LRB, 16 * lo4, 0), B1 = FR(L_LRB, 16 * lo4, 1); const int t = 16 * lo4 + r;
#pragma unroll
                for (int hf = 0; hf < 2; ++hf) { const int jb = 2 * hi2 + hf; f32x4 a = unpack4(ld64(lds + L_RMR + t * RS_ + (16 * jb + 4 * q) * 2));
                    a = mfma16(FR(L_XTA, 16 * jb, 0), B0, a); a = mfma16(FR(L_XTA, 16 * jb, 1), B1, a);
                    *(GAS u32x2v*)(RBg + (size_t)it * 8192 + t * 128 + (16 * jb + 4 * q) * 2) = pack4(a); }
            }
            {
                const bf16x8 XV0 = FR(L_XTV, 16 * lo4, 0), XV1 = FR(L_XTV, 16 * lo4, 1), V0 = FR(L_CMV, 16 * lo4, 0), V1 = FR(L_CMV, 16 * lo4, 1);
#pragma unroll
                for (int hf = 0; hf < 2; ++hf) { const int ib = 2 * hi2 + hf;
                    f32x4 a = mfma16(FR(L_CMBH, 16 * ib, 0), XV0, z4); a = mfma16(FR(L_CMBH, 16 * ib, 1), XV1, a); a = mfma16(FR(L_CMKH, 16 * ib, 0), V0, a); a = mfma16(FR(L_CMKH, 16 * ib, 1), V1, a);
                    *(GAS f32x4*)(Hg + (size_t)it * 4096 + ((lo4 * 4 + ib) * 64 + l) * 4) = a;
                    f32x4 y = mfma16(FR(L_LRB, 16 * ib, 0), XV0, z4); y = mfma16(FR(L_LRB, 16 * ib, 1), XV1, y); y = mfma16(FR(L_LRK, 16 * ib, 0), V0, y); y = mfma16(FR(L_LRK, 16 * ib, 1), V1, y);
                    *(GAS u32x2v*)(YBg + (size_t)it * 8192 + ((lo4 * 4 + ib) * 64 + l) * 8) = pack4(y); }
            }
#undef FR
        }
    }
}
constexpr int CH_SS = 4;
constexpr int CH_STEP_BYTES = 8192 + 4096 + 256;
constexpr int CH_BUF_BYTES = CH_SS * CH_STEP_BYTES;
static_assert(2 * CH_BUF_BYTES <= RING_BYTES, "chain LDS");
__device__ __forceinline__ void chain_stage(Ctx& F, int h, int cb, int ss, int bufoff) {
    const unsigned char* GPg = (const unsigned char*)F.out + OUT_GP; const unsigned char* Hg = (const unsigned char*)(F.ws + WS_H); const unsigned char* WCg = (const unsigned char*)(F.ws + WS_WC);
#pragma unroll
    for (int st = 0; st < CH_SS; ++st) { const int c = ss * CH_SS + st; const size_t it = (size_t)c * 16 + h; const int sb = bufoff + st * CH_STEP_BYTES;
#pragma unroll
        for (int p = 0; p < 13; ++p) { if (((st * 13 + p) & 7) != F.wave) continue;
            if (p < 8) __builtin_amdgcn_global_load_lds((const unsigned*)(GPg + it * 8192 + p * 1024 + F.lane * 16), (LAS unsigned*)(F.lds + sb + p * 1024), 16, 0, 0);
            else if (p < 12) __builtin_amdgcn_global_load_lds((const unsigned*)(Hg + it * 16384 + (size_t)(cb * 4 + (p - 8)) * 1024 + F.lane * 16), (LAS unsigned*)(F.lds + sb + 8192 + (p - 8) * 1024), 16, 0, 0);
            else __builtin_amdgcn_global_load_lds((const unsigned*)(WCg + it * 256 + F.lane * 4), (LAS unsigned*)(F.lds + sb + 12288), 4, 0, 0); } }
}
__device__ __forceinline__ void ph_rwkv_chain(Ctx& F, int cid) {
    const int h = cid >> 2, cb = cid & 3, l = F.lane, cc = l & 15, q = l >> 4;
    unsigned char* SCg = F.ws + WS_SC;
    f32x4 S[4];
#pragma unroll
    for (int m = 0; m < 4; ++m) S[m] = (f32x4){0.f, 0.f, 0.f, 0.f};
    chain_stage(F, h, cb, 0, 0);
    for (int ss = 0; ss < 128 / CH_SS; ++ss) {
        const int bo = (ss & 1) * CH_BUF_BYTES;
        asm volatile("s_waitcnt vmcnt(0)" ::: "memory");
        __syncthreads();
        if (ss + 1 < 128 / CH_SS) chain_stage(F, h, cb, ss + 1, ((ss + 1) & 1) * CH_BUF_BYTES);
        if (F.wave == 0) {
#pragma unroll
            for (int st = 0; st < CH_SS; ++st) { const int c = ss * CH_SS + st; const size_t it = (size_t)c * 16 + h; const LAS unsigned char* sb = F.lds + bo + st * CH_STEP_BYTES;
                u32x2v ps[4];
#pragma unroll
                for (int m = 0; m < 4; ++m) { ps[m] = pack4(S[m]); *(GAS u32x2v*)(SCg + it * 8192 + (16 * cb + cc) * 128 + (16 * m + 4 * q) * 2) = ps[m]; }
                const bf16x8 b0 = cat8(ps[0], ps[1]), b1 = cat8(ps[2], ps[3]);
#pragma unroll
                for (int m = 0; m < 4; ++m) { const f32x4 wc = *(const LAS f32x4*)(sb + 12288 + (16 * m + 4 * q) * 4), hh = *(const LAS f32x4*)(sb + 8192 + (m * 64 + l) * 16);
                    f32x4 a = wc * S[m] + hh;
                    a = mfma16(ld128(sb + ((m * 2 + 0) * 64 + l) * 16), b0, a); a = mfma16(ld128(sb + ((m * 2 + 1) * 64 + l) * 16), b1, a);
                    S[m] = a; }
            }
        }
    }
    asm volatile("s_waitcnt vmcnt(0)" ::: "memory"); __syncthreads();
}
__device__ __forceinline__ void ph_post_b(Ctx& F) {
    const bf16* VSg = (const bf16*)(F.ws + WS_RWA) + 4 * (RWA_STRIDE / 2); const bf16* GGg = VSg + RWA_STRIDE / 2;
    const unsigned char* SCg = F.ws + WS_SC; const unsigned char* RBg = (const unsigned char*)F.out + OUT_RB; const unsigned char* YBg = F.ws + WS_YB;
    const float* BON = (const float*)(F.ws + WS_MISC + MISC_BON);
    bf16* YC = (bf16*)(F.ws + WS_HN); const float* ssqA = (const float*)(F.ws + WS_CTL) + CW_SSQA;
    const int l = F.lane, cc = l & 15, q = l >> 4, tb = F.wave & 3;
    for (int it = F.vcu * 2 + (F.wave >> 2); it < 128 * NH; it += 2 * F.G) {
        const int c = it >> 4, h = it & 15;
        const bf16x8 A0 = *(const GAS bf16x8*)(RBg + (size_t)it * 8192 + (16 * tb + cc) * 128 + (8 * q) * 2), A1 = *(const GAS bf16x8*)(RBg + (size_t)it * 8192 + (16 * tb + cc) * 128 + (32 + 8 * q) * 2);
        f32x4 y[4];
#pragma unroll
        for (int nb = 0; nb < 4; ++nb) {
            const bf16x8 B0 = *(const GAS bf16x8*)(SCg + (size_t)it * 8192 + (16 * nb + cc) * 128 + (8 * q) * 2), B1 = *(const GAS bf16x8*)(SCg + (size_t)it * 8192 + (16 * nb + cc) * 128 + (32 + 8 * q) * 2);
            y[nb] = unpack4(*(const GAS u32x2v*)(YBg + (size_t)it * 8192 + ((nb * 4 + tb) * 64 + l) * 8));
            y[nb] = mfma16(A0, B0, y[nb]); y[nb] = mfma16(A1, B1, y[nb]); }
        float lg[4], lb[4];
#pragma unroll
        for (int nb = 0; nb < 4; ++nb) { lg[nb] = F.in[IN_LNX_G][h * 64 + 16 * nb + cc]; lb[nb] = F.in[IN_LNX_B][h * 64 + 16 * nb + cc]; }
#pragma unroll
        for (int e = 0; e < 4; ++e) {
            const int t = 64 * c + 16 * tb + 4 * q + e;
            float s = (y[0][e] + y[1][e]) + (y[2][e] + y[3][e]);
            s += __shfl_xor(s, 1); s += __shfl_xor(s, 2); s += __shfl_xor(s, 4); s += __shfl_xor(s, 8);
            const float mu = s * (1.f / 64.f);
            float d[4], v2 = 0.f;
#pragma unroll
            for (int nb = 0; nb < 4; ++nb) { d[nb] = y[nb][e] - mu; v2 += d[nb] * d[nb]; }
            v2 += __shfl_xor(v2, 1); v2 += __shfl_xor(v2, 2); v2 += __shfl_xor(v2, 4); v2 += __shfl_xor(v2, 8);
            const float rstd = 1.0f / sqrtf(v2 * (1.f / 64.f) + LNX_EPS), bon = BON[t * 16 + h];
#pragma unroll
            for (int nb = 0; nb < 4; ++nb) { const size_t o = (size_t)t * RW + h * 64 + 16 * nb + cc;
                const float val = (d[nb] * rstd * lg[nb] + lb[nb] + bon * bf2f(VSg[o])) * bf2f(GGg[o]);
                YC[(size_t)t * D_ + h * 64 + 16 * nb + cc] = (bf16)f2bf(val); }
        }
    }
    const int gw = F.vcu * NWAVES + F.wave, NGW = F.G * NWAVES;
    for (int t = gw; t < T_; t += NGW) {
        const float sc = 1.0f / sqrtf(ssqA[t] * (1.f / RW) + NORM_EPS);
        bf16* p = YC + (size_t)t * D_ + RW;
#pragma unroll
        for (int j = 0; j < 16; ++j) { const int c2 = j * 64 + l; p[c2] = (bf16)f2bf(bf2f(p[c2]) * sc * F.in[IN_ATTN_G][c2]); }
    }
}
constexpr int N_PHASES = 11;
constexpr int N_LAUNCHES = MK_N_LAUNCHES;
struct Args { const float* in[25]; float* out; unsigned char* ws; int ph_lo, ph_hi, li, pad; };
__global__ void __launch_bounds__(NWAVES * 64, 2) mk_fwd(Args args) {
    extern __shared__ __attribute__((aligned(16))) unsigned char lds[];
    Ctx F;
    F.lds = (LAS unsigned char*)lds;
    F.tid = threadIdx.x; F.lane = F.tid & 63; F.wave = __builtin_amdgcn_readfirstlane(F.tid >> 6);
    F.G = gridDim.x; { const int bx = blockIdx.x; F.vcu = (F.G % 8 == 0) ? (bx % 8) * (F.G / 8) + bx / 8 : bx; }
#pragma unroll
    for (int i = 0; i < 25; ++i) F.in[i] = args.in[i];
    F.out = args.out; F.ws = args.ws;
    volatile LAS unsigned* MISC = (volatile LAS unsigned*)(F.lds + MISC_OFF);
    for (int u = F.tid; u < (LDS_BYTES - LDSCTL_OFF) / 4; u += NWAVES * 64) ((LAS unsigned*)(F.lds + LDSCTL_OFF))[u] = 0u;
    __syncthreads();
    gu32* ctl = (gu32*)(F.ws + WS_CTL);
    XcdBarrier bar; bar.bar = (unsigned*)(ctl + CW_BAR); bar.x = 0; bar.st = nullptr;
    const int lo = args.ph_lo, hi = args.ph_hi;
    if (hi - lo > 1) bar = xcd_barrier_post((unsigned*)(ctl + CW_BAR), MISC + 8);
#define IN(k) (lo <= (k) && (k) < hi)
#define SEAM(k) do { if (IN(k) && IN((k) + 1)) xcd_barrier(bar); } while (0)
    float* ssq = (float*)(F.ws + WS_CTL);
    bf16* HN = (bf16*)(F.ws + WS_HN); bf16* Z = (bf16*)(F.ws + WS_Z); bf16* H2 = (bf16*)(F.ws + WS_H2); bf16* ACT = (bf16*)(F.ws + WS_ACT);

    if (IN(0)) { ph_prologue(F); } SEAM(0);
    if (IN(1)) {
        pg8::Gemm g{HN, (const bf16*)(F.ws + WS_WIN), T_, NIN, D_, 0L, 256L * D_ * 2}; pg8::StaticOrder S; S.init(T_, NIN, F.G, (int)blockIdx.x);
        pg8::EpiZ E{Z, NIN, (const float*)(F.ws + WS_MISC + MISC_BIAS)};
        pg8::gemm_phase<pg8::EpiZ, pg8::StaticOrder, true, true>(F.lds, g, S, E);
    } SEAM(1);
    if (IN(2)) { ph_attention_naive(F); } SEAM(2);
    if (IN(3)) { ph_rwkv_prep_naive(F); } SEAM(3);
    if (IN(4)) { ph_rwkv_chunk(F); } SEAM(4);
    if (IN(5)) {
        if ((int)blockIdx.x < 64) ph_rwkv_chain(F, (int)blockIdx.x); else ph_ffn_weights(F, ((int)blockIdx.x - 64) * NWAVES + F.wave, (F.G - 64) * NWAVES, 0);
    } SEAM(5);
    if (IN(6)) { ph_post_b(F); ph_ffn_weights(F, F.vcu * NWAVES + F.wave, F.G * NWAVES, 1); } SEAM(6);
    if (IN(7)) {
        pg8::Gemm g{HN, (const bf16*)(F.ws + WS_WOUT), T_, D_, D_, 0L, 256L * D_ * 2}; pg8::StaticOrder S; S.init(T_, D_, F.G, (int)blockIdx.x);
        pg8::EpiRes E{F.in[IN_X], F.out, D_, H2, F.in[IN_LN_FFN_G], ssq + CW_SSQ2};
        pg8::gemm_phase<pg8::EpiRes, pg8::StaticOrder, true, true>(F.lds, g, S, E);
    } SEAM(7);
    if (IN(8)) {
        pg8::Gemm g{H2, (const bf16*)(F.ws + WS_WUG), T_, NUG, D_, -2L * D_ * 2, 254L * D_ * 2}; pg8::StaticOrder S; S.initT(33, NUG / 256, F.G, (int)blockIdx.x);
        pg8::EpiUpGate E{ACT, ssq + CW_SSQ2, F.in[IN_CONV_W], F.in[IN_CONV_B], (LAS float*)(F.lds + XCH_OFF), T_, DFF, 1.0f / D_, NORM_EPS};
        pg8::gemm_phase<pg8::EpiUpGate, pg8::StaticOrder, true, true>(F.lds, g, S, E);
    } SEAM(8);
    if (IN(9)) {
        pg8::Gemm g{ACT, (const bf16*)(F.ws + WS_WDN), T_, D_, DFF, 0L, 256L * DFF * 2}; pg8::StaticOrder S; S.init(T_, D_, F.G, (int)blockIdx.x);
        pg8::EpiRes E{F.out, F.out, D_, nullptr, nullptr, ssq + CW_SSQ3};
        pg8::gemm_phase<pg8::EpiRes, pg8::StaticOrder, true, true>(F.lds, g, S, E);
    } SEAM(9);
    if (IN(10)) { ph_final(F); }
#undef IN
#undef SEAM
}

extern "C" void kernel_launch(void* const* d_in, const int* in_sizes, int n_in, void* d_out, int out_size, void* d_ws, size_t ws_size, hipStream_t stream) {
    static int grid = 0;
    if (grid == 0) {
        if (n_in != 25 || in_sizes[0] != T_ * D_ || out_size != T_ * D_ || ws_size < WS_END) { fprintf(stderr, "kernel_launch: unexpected shapes (n_in %d, in0 %d, out %d, ws %zu)\n", n_in, n_in > 0 ? in_sizes[0] : -1, out_size, ws_size); grid = -1; return; }
        int dev = 0, cus = 0;
        if (hipGetDevice(&dev) != hipSuccess || hipDeviceGetAttribute(&cus, hipDeviceAttributeMultiprocessorCount, dev) != hipSuccess) { grid = -1; return; }
        if (hipFuncSetAttribute((const void*)mk_fwd, hipFuncAttributeMaxDynamicSharedMemorySize, LDS_BYTES) != hipSuccess) { fprintf(stderr, "kernel_launch: hipFuncSetAttribute failed\n"); grid = -1; return; }
        (void)hipGetLastError();
        grid = cus;
    }
    if (grid < 0) return;
    if (hipMemsetAsync((char*)d_ws + WS_CTL, 0, CTL_ZERO_BYTES, stream) != hipSuccess) return;
    Args a{};
    for (int i = 0; i < 25; ++i) a.in[i] = (const float*)d_in[i];
    a.out = (float*)d_out; a.ws = (unsigned char*)d_ws;
    if (N_LAUNCHES == 1) { a.ph_lo = 0; a.ph_hi = N_PHASES; a.li = 0; hipLaunchKernelGGL(mk_fwd, dim3(grid), dim3(NWAVES * 64), LDS_BYTES, stream, a); }
    else for (int ph = 0; ph < N_PHASES; ++ph) { a.ph_lo = ph; a.ph_hi = ph + 1; a.li = 0; hipLaunchKernelGGL(mk_fwd, dim3(grid), dim3(NWAVES * 64), LDS_BYTES, stream, a); }
}
```

```cpp
#include <hip/hip_runtime.h>
#include <cstdio>
#include <cstdint>
#define MK_N_LAUNCHES 1
#define MK_REPEAT_MASK 0
#define MK_FILLER_IN_CHAIN 1
namespace pg8 {
#define PG8_LAS __attribute__((address_space(3)))
typedef unsigned short bf16_t;
typedef short bf16x8 __attribute__((ext_vector_type(8)));
typedef float f32x4 __attribute__((ext_vector_type(4)));
typedef unsigned u32x4 __attribute__((ext_vector_type(4)));
constexpr int BM = 256, BK = 64, HALF = 128, HTB = HALF * BK * 2  , STAGE_BYTES = 8 * HTB, NXCD = 8, WGM = 8;

__host__ __device__ __forceinline__ int lds_byte(int r, int c) { const int st = (r >> 4) * 2 + (c >> 5), rr = r & 15, cc = c & 31, ob = rr * 64 + cc * 2; return st * 1024 + (ob ^ (((ob >> 9) & 1) << 5)); }
__host__ __device__ __forceinline__ void stage_rc(int b, int& R, int& C) { const int st = b / 1024, sb = b % 1024, swz = sb ^ (((sb >> 9) & 1) << 5); R = (st >> 1) * 16 + swz / 64; C = (st & 1) * 32 + (swz % 64) / 2; }
__host__ __device__ __forceinline__ int perm32(int rho) { const int n = rho >> 4, i = rho & 15; return 8 * (i >> 2) + 4 * n + (i & 3); }

struct Unit { int pm, pn; };
struct Gemm { const bf16_t* A; const bf16_t* Bt; int M, N, K; long a_off, a_tstep; };

struct StaticOrder {
    int nM, nN, nwg, G, c;
    __host__ __device__ void init(int M, int N, int G_, int c_) { nM = M / BM; nN = N / BM; nwg = nM * nN; G = G_; c = c_; }
    __host__ __device__ void initT(int nM_, int nN_, int G_, int c_) { nM = nM_; nN = nN_; nwg = nM * nN; G = G_; c = c_; }
    __host__ __device__ bool next(int i, Unit& u) const {
        const long L = (long)i * G + c; if (L >= nwg) return false;
        int wgid = (int)L; { const int q = nwg / NXCD, r = nwg % NXCD, xcd = wgid % NXCD, off = wgid / NXCD; wgid = (xcd < r ? xcd * (q + 1) : r * (q + 1) + (xcd - r) * q) + off; }
        const int nig = WGM * nN, gid = wgid / nig, fm = gid * WGM, gsz = (nM - fm) < WGM ? (nM - fm) : WGM;
        u.pm = fm + ((wgid % nig) % gsz); u.pn = (wgid % nig) / gsz; return true;
    }
    __device__ __forceinline__ void a_ready(const Unit&) const {}
    __device__ __forceinline__ void done(const Unit&) const {}
};

__device__ __forceinline__ unsigned cvt_pk_bf16(float lo, float hi) { unsigned r; asm volatile("v_cvt_pk_bf16_f32 %0, %1, %2" : "=v"(r) : "v"(lo), "v"(hi)); return r; }
typedef unsigned u32x2 __attribute__((ext_vector_type(2)));

struct EpiZ {
    static constexpr bool PERM = true, AFTER_DRAIN = false;
    bf16_t* O; int ldc; const float* bias;
    __device__ __forceinline__ void operator()(const f32x4 (&acc)[2][2][4][2], const Unit& u, int wr, int wc, int fr, int fq) const {
        const int row0 = u.pm * BM + wr * 64 + fr; const int col0 = u.pn * BM + wc * 32 + 8 * fq;
        f32x4 bv[2][2];
#pragma unroll
        for (int bj = 0; bj < 2; ++bj)
#pragma unroll
            for (int n = 0; n < 2; ++n) bv[bj][n] = *(const f32x4*)(bias + col0 + bj * HALF + 4 * n);
#pragma unroll
        for (int ai = 0; ai < 2; ++ai)
#pragma unroll
            for (int m = 0; m < 4; ++m) { bf16_t* rowp = O + (size_t)(row0 + ai * HALF + m * 16) * ldc + col0;
#pragma unroll
                for (int bj = 0; bj < 2; ++bj) { const f32x4 v0 = acc[ai][bj][m][0] + bv[bj][0], v1 = acc[ai][bj][m][1] + bv[bj][1];
                    u32x4 w; w.x = cvt_pk_bf16(v0[0], v0[1]); w.y = cvt_pk_bf16(v0[2], v0[3]); w.z = cvt_pk_bf16(v1[0], v1[1]); w.w = cvt_pk_bf16(v1[2], v1[3]);
                    *(u32x4*)(rowp + bj * HALF) = w; } }
    }
};
struct EpiRes {
    static constexpr bool PERM = false, AFTER_DRAIN = false;
    const float* base; float* out; int ldc; bf16_t* hb; const float* gain; float* ssq;
    __device__ __forceinline__ void operator()(const f32x4 (&acc)[2][2][4][2], const Unit& u, int wr, int wc, int fr, int fq) const {
        const int row0 = u.pm * BM + wr * 64 + fr, col0 = u.pn * BM + wc * 32 + 4 * fq;
        f32x4 gv[2][2];
#pragma unroll
        for (int bj = 0; bj < 2; ++bj)
#pragma unroll
            for (int n = 0; n < 2; ++n) gv[bj][n] = hb ? *(const f32x4*)(gain + col0 + bj * HALF + n * 16) : (f32x4){0.f, 0.f, 0.f, 0.f};
#pragma unroll
        for (int ai = 0; ai < 2; ++ai)
#pragma unroll
            for (int m = 0; m < 4; ++m) { const int row = row0 + ai * HALF + m * 16; const size_t off = (size_t)row * ldc + col0; float q = 0.f;
#pragma unroll
                for (int bj = 0; bj < 2; ++bj)
#pragma unroll
                    for (int n = 0; n < 2; ++n) { const f32x4 x1 = *(const f32x4*)(base + off + bj * HALF + n * 16) + acc[ai][bj][m][n];
                        *(f32x4*)(out + off + bj * HALF + n * 16) = x1; q += (x1[0] * x1[0] + x1[1] * x1[1]) + (x1[2] * x1[2] + x1[3] * x1[3]);
                        if (hb) { const f32x4 h = x1 * gv[bj][n]; u32x2 w; w.x = cvt_pk_bf16(h[0], h[1]); w.y = cvt_pk_bf16(h[2], h[3]); *(u32x2*)(hb + off + bj * HALF + n * 16) = w; } }
                q += __shfl_xor(q, 16); q += __shfl_xor(q, 32);
                if (fq == 0) atomicAdd(ssq + row, q); }
    }
};
struct EpiUpGate {
    static constexpr bool PERM = true, AFTER_DRAIN = false;
    bf16_t* act; const float* ssq; const float* cw; const float* cb; PG8_LAS float* xch; int T, F; float invD, eps;
    __device__ __forceinline__ void operator()(const f32x4 (&acc)[2][2][4][2], const Unit& u, int wr, int wc, int fr, int fq) const {
        const int lane = fr + 16 * fq, wid = wr * 4 + wc;
        const int trow0 = 254 * u.pm - 2, f0 = 128 * u.pn + wc * 32 + 8 * fq;
        f32x4 uu[2][4][2], gg[2][4][2];
#pragma unroll
        for (int ai = 0; ai < 2; ++ai)
#pragma unroll
            for (int m = 0; m < 4; ++m) { const int t = trow0 + ai * HALF + wr * 64 + m * 16 + fr; float s = 0.f;
                if (t >= 0 && t < T) s = __builtin_amdgcn_rsqf(ssq[t] * invD + eps);
#pragma unroll
                for (int n = 0; n < 2; ++n) { uu[ai][m][n] = acc[ai][0][m][n] * s; gg[ai][m][n] = acc[ai][1][m][n] * s; } }
        if (fr >= 14) {
#pragma unroll
            for (int ai = 0; ai < 2; ++ai)
#pragma unroll
                for (int n = 0; n < 2; ++n) *(PG8_LAS f32x4*)(xch + ((((wid * 2 + ai) * 2 + (fr - 14)) * 4 + fq) * 2 + n) * 4) = uu[ai][3][n];
        }
        asm volatile("s_waitcnt lgkmcnt(0)" ::: "memory"); __builtin_amdgcn_s_barrier(); asm volatile("" ::: "memory");
        f32x4 pg[2][2];
#pragma unroll
        for (int ai = 0; ai < 2; ++ai)
#pragma unroll
            for (int n = 0; n < 2; ++n) { pg[ai][n] = (f32x4){0.f, 0.f, 0.f, 0.f};
                const int swid = wr ? wid - 4 : wid + 4, sai = wr ? ai : ai - 1;
                if (fr >= 14 && sai >= 0) pg[ai][n] = *(const PG8_LAS f32x4*)(xch + ((((swid * 2 + sai) * 2 + (fr - 14)) * 4 + fq) * 2 + n) * 4); }
        f32x4 w0[2], w1[2], w2[2], bb[2];
#pragma unroll
        for (int n = 0; n < 2; ++n) { w0[n] = *(const f32x4*)(cw + f0 + 4 * n); w1[n] = *(const f32x4*)(cw + F + f0 + 4 * n); w2[n] = *(const f32x4*)(cw + 2 * F + f0 + 4 * n); bb[n] = *(const f32x4*)(cb + f0 + 4 * n); }
        const int src1 = (lane & ~15) | ((lane - 1) & 15), src2 = (lane & ~15) | ((lane - 2) & 15);
#pragma unroll
        for (int ai = 0; ai < 2; ++ai)
#pragma unroll
            for (int m = 0; m < 4; ++m) { const int r = ai * HALF + wr * 64 + m * 16 + fr, t = trow0 + r; f32x4 o[2];
#pragma unroll
                for (int n = 0; n < 2; ++n) { const f32x4 U = uu[ai][m][n], PG = (m == 0) ? pg[ai][n] : uu[ai][m == 0 ? 0 : m - 1][n];
#pragma unroll
                    for (int c = 0; c < 4; ++c) { const float s1 = (fr == 15) ? PG[c] : U[c], s2 = (fr >= 14) ? PG[c] : U[c];
                        const float p1 = __shfl(s1, src1), p2 = __shfl(s2, src2);
                        const float cv = bb[n][c] + w2[n][c] * U[c] + w1[n][c] * p1 + w0[n][c] * p2;
                        const float sg = cv * __builtin_amdgcn_rcpf(1.0f + __expf(-cv));
                        o[n][c] = sg * gg[ai][m][n][c]; } }
                if (r >= 2 && t < T) { u32x4 w; w.x = cvt_pk_bf16(o[0][0], o[0][1]); w.y = cvt_pk_bf16(o[0][2], o[0][3]); w.z = cvt_pk_bf16(o[1][0], o[1][1]); w.w = cvt_pk_bf16(o[1][2], o[1][3]);
                    *(u32x4*)(act + (size_t)t * F + f0) = w; } }
    }
};
template <class Epi, class Sched, bool ALIGN_EPI = false, bool SP2 = false>
__device__ __forceinline__ void gemm_phase(PG8_LAS unsigned char* lds, const Gemm g, const Sched& S, const Epi& E) {
    const int tid = threadIdx.x, wid = __builtin_amdgcn_readfirstlane(tid >> 6), lane = tid & 63, wr = wid >> 2, wc = wid & 3, fr = lane & 15, fq = lane >> 4;
    const int K = g.K, nt = K / BK;
    unsigned voffA[2], voffB[2];
#pragma unroll
    for (int i = 0; i < 2; ++i) { int R, C; stage_rc(tid * 16 + i * 8192, R, C); const int Rb = Epi::PERM ? ((R & ~31) + perm32(R & 31)) : R;
        voffA[i] = (unsigned)(R * K + C) * 2u; voffB[i] = (unsigned)(Rb * K + C) * 2u; }
    const size_t kstep = (size_t)(BK * 2);
    const size_t hstep = (size_t)HALF * K * 2;
    const size_t tstep = 2 * hstep;
    const unsigned ldsw = (unsigned)wid * 1024u;
    const int aoff = lds_byte(wr * 64 + fr, fq * 8), boff = lds_byte(wc * 32 + fr, fq * 8);
#define PG8_SA(b, h) (((b) * 2 + (h)) * HTB)
#define PG8_SB(b, h) ((4 + (b) * 2 + (h)) * HTB)
#define PG8_STAGE(bufoff, gbase, voff) do { _Pragma("unroll") for (int _i = 0; _i < 2; ++_i) \
        __builtin_amdgcn_global_load_lds((const unsigned*)((const char*)(gbase) + (voff)[_i]), (PG8_LAS unsigned*)(lds + (bufoff) + ldsw + _i * 8192), 16, 0, 0); } while (0)
#define PG8_LDA(dst, b, h) do { _Pragma("unroll") for (int m = 0; m < 4; ++m) _Pragma("unroll") for (int k = 0; k < 2; ++k) dst[m][k] = *(const PG8_LAS bf16x8*)(lds + PG8_SA(b, h) + aoff + m * 2048 + k * 1024); } while (0)
#define PG8_LDB(dst, b, h) do { _Pragma("unroll") for (int n = 0; n < 2; ++n) _Pragma("unroll") for (int k = 0; k < 2; ++k) dst[n][k] = *(const PG8_LAS bf16x8*)(lds + PG8_SB(b, h) + boff + n * 2048 + k * 1024); } while (0)
#define PG8_MMA(ai, bj, At, Bt) do { __builtin_amdgcn_s_setprio(1); _Pragma("unroll") for (int m = 0; m < 4; ++m) _Pragma("unroll") for (int n = 0; n < 2; ++n) _Pragma("unroll") for (int k = 0; k < 2; ++k) \
        acc[ai][bj][m][n] = __builtin_amdgcn_mfma_f32_16x16x32_bf16(Bt[n][k], At[m][k], acc[ai][bj][m][n], 0, 0, 0); __builtin_amdgcn_s_setprio(0); } while (0)
#define PG8_WAIT_V(n) asm volatile("s_waitcnt vmcnt(" #n ")" ::: "memory")
#define PG8_WAIT_L(n) asm volatile("s_waitcnt lgkmcnt(" #n ")" ::: "memory")
#define PG8_BAR __builtin_amdgcn_s_barrier()
#define PG8_SCHED __builtin_amdgcn_sched_barrier(0)
    Unit cur, nxt; int ui = 0;
    if (!S.next(0, cur)) return;
    f32x4 acc[2][2][4][2];
#pragma unroll
    for (int a = 0; a < 2; ++a)
#pragma unroll
        for (int b = 0; b < 2; ++b)
#pragma unroll
            for (int m = 0; m < 4; ++m)
#pragma unroll
                for (int n = 0; n < 2; ++n) acc[a][b][m][n] = (f32x4){0.f, 0.f, 0.f, 0.f};
    bf16x8 At[4][2], B0[2][2], B1[2][2];
    const char* cA = (const char*)g.A + g.a_off + (long)cur.pm * g.a_tstep; const char* cB = (const char*)g.Bt + (size_t)cur.pn * tstep;
    S.a_ready(cur);
    if constexpr (SP2) {
        PG8_STAGE(PG8_SB(0, 0), cB, voffB); PG8_STAGE(PG8_SB(0, 1), cB + hstep, voffB); PG8_STAGE(PG8_SA(0, 0), cA, voffA); PG8_STAGE(PG8_SA(0, 1), cA + hstep, voffA);
        if (wr == 1) PG8_BAR;
        PG8_WAIT_V(2); PG8_BAR;
        PG8_STAGE(PG8_SB(1, 0), cB + kstep, voffB); PG8_STAGE(PG8_SA(1, 0), cA + kstep, voffA); PG8_STAGE(PG8_SB(1, 1), cB + hstep + kstep, voffB);
        PG8_WAIT_V(6); PG8_BAR;
    } else {
        PG8_STAGE(PG8_SB(0, 0), cB, voffB); PG8_STAGE(PG8_SA(0, 0), cA, voffA); PG8_STAGE(PG8_SB(0, 1), cB + hstep, voffB); PG8_STAGE(PG8_SA(0, 1), cA + hstep, voffA);
        if (wr == 1) PG8_BAR;
        PG8_WAIT_V(4); PG8_BAR;
        PG8_STAGE(PG8_SB(1, 0), cB + kstep, voffB); PG8_STAGE(PG8_SA(1, 0), cA + kstep, voffA); PG8_STAGE(PG8_SB(1, 1), cB + hstep + kstep, voffB);
        PG8_WAIT_V(6); PG8_BAR;
    }
    for (;;) {
        const bool has_next = S.next(ui + 1, nxt);
        const char* nA = has_next ? (const char*)g.A + g.a_off + (long)nxt.pm * g.a_tstep : cA; const char* nB = has_next ? (const char*)g.Bt + (size_t)nxt.pn * tstep : cB;
        for (int t = 0; t < nt; t += 2) {
            const bool last = (t == nt - 2);
            const char* a1 = cA + (size_t)(t + 1) * kstep;
            const char* a2 = last ? nA : cA + (size_t)(t + 2) * kstep; const char* b2 = last ? nB : cB + (size_t)(t + 2) * kstep;
            const char* a3 = a2 + kstep; const char* b3 = b2 + kstep;
            if (last && has_next) S.a_ready(nxt);
            if constexpr (SP2) {
            PG8_LDB(B0, 0, 0); PG8_LDB(B1, 0, 1); PG8_SCHED; PG8_LDA(At, 0, 0); PG8_STAGE(PG8_SA(1, 1), a1 + hstep, voffA);
            PG8_WAIT_V(8); PG8_WAIT_L(0); PG8_BAR; PG8_MMA(0, 0, At, B0); PG8_MMA(0, 1, At, B1); PG8_BAR; PG8_SCHED;
            PG8_LDA(At, 0, 1); PG8_STAGE(PG8_SB(0, 0), b2, voffB); PG8_STAGE(PG8_SB(0, 1), b2 + hstep, voffB); PG8_STAGE(PG8_SA(0, 0), a2, voffA);
            PG8_WAIT_V(8); PG8_WAIT_L(0); PG8_BAR; PG8_MMA(1, 0, At, B0); PG8_MMA(1, 1, At, B1); PG8_BAR; PG8_SCHED;
            PG8_LDB(B0, 1, 0); PG8_LDB(B1, 1, 1); PG8_SCHED; PG8_LDA(At, 1, 0); PG8_STAGE(PG8_SA(0, 1), a2 + hstep, voffA);
            PG8_WAIT_V(8); PG8_WAIT_L(0); PG8_BAR; PG8_MMA(0, 0, At, B0); PG8_MMA(0, 1, At, B1); PG8_BAR; PG8_SCHED;
            PG8_LDA(At, 1, 1); PG8_STAGE(PG8_SB(1, 0), b3, voffB); PG8_STAGE(PG8_SB(1, 1), b3 + hstep, voffB); PG8_STAGE(PG8_SA(1, 0), a3, voffA);
            PG8_WAIT_V(8); PG8_WAIT_L(0); PG8_BAR; PG8_MMA(1, 0, At, B0); PG8_MMA(1, 1, At, B1); PG8_BAR; PG8_SCHED;
            } else {
            PG8_LDB(B0, 0, 0); PG8_SCHED; PG8_LDA(At, 0, 0); PG8_STAGE(PG8_SA(1, 1), a1 + hstep, voffA);
            PG8_WAIT_L(8); PG8_BAR; PG8_WAIT_L(0); PG8_MMA(0, 0, At, B0); PG8_BAR; PG8_SCHED;
            PG8_LDB(B1, 0, 1); PG8_STAGE(PG8_SB(0, 0), b2, voffB);
            PG8_BAR; PG8_WAIT_L(0); PG8_MMA(0, 1, At, B1); PG8_BAR;
            PG8_LDA(At, 0, 1); PG8_STAGE(PG8_SA(0, 0), a2, voffA);
            PG8_BAR; PG8_WAIT_L(0); PG8_MMA(1, 0, At, B0); PG8_BAR; PG8_SCHED;
            PG8_STAGE(PG8_SB(0, 1), b2 + hstep, voffB);
            PG8_WAIT_V(6); PG8_BAR; PG8_MMA(1, 1, At, B1); PG8_BAR;
            PG8_LDB(B0, 1, 0); PG8_SCHED; PG8_LDA(At, 1, 0); PG8_STAGE(PG8_SA(0, 1), a2 + hstep, voffA);
            PG8_WAIT_L(8); PG8_BAR; PG8_WAIT_L(0); PG8_MMA(0, 0, At, B0); PG8_BAR; PG8_SCHED;
            PG8_LDB(B1, 1, 1); PG8_STAGE(PG8_SB(1, 0), b3, voffB);
            PG8_BAR; PG8_WAIT_L(0); PG8_MMA(0, 1, At, B1); PG8_BAR;
            PG8_LDA(At, 1, 1); PG8_STAGE(PG8_SA(1, 0), a3, voffA);
            PG8_BAR; PG8_WAIT_L(0); PG8_MMA(1, 0, At, B0); PG8_BAR; PG8_SCHED;
            PG8_STAGE(PG8_SB(1, 1), b3 + hstep, voffB);
            PG8_WAIT_V(6); PG8_BAR; PG8_MMA(1, 1, At, B1); PG8_BAR;
            }
        }
        if constexpr (ALIGN_EPI) { if (wr == 0) PG8_BAR; }
        if constexpr (!Epi::AFTER_DRAIN) { E(acc, cur, wr, wc, fr, fq); S.done(cur); }
        if (!has_next) break;
#pragma unroll
        for (int a = 0; a < 2; ++a)
#pragma unroll
            for (int b = 0; b < 2; ++b)
#pragma unroll
                for (int m = 0; m < 4; ++m)
#pragma unroll
                    for (int n = 0; n < 2; ++n) acc[a][b][m][n] = (f32x4){0.f, 0.f, 0.f, 0.f};
        cur = nxt; cA = nA; cB = nB; ++ui;
        if constexpr (ALIGN_EPI) { if (wr == 1) PG8_BAR; }
    }
    PG8_WAIT_V(0);
    if constexpr (!ALIGN_EPI) { if (wr == 0) PG8_BAR; }
    PG8_BAR;
    if constexpr (Epi::AFTER_DRAIN) { E.fused(acc, cur, wr, wc, fr, fq, lds, wid, lane); S.done(cur); }
#undef PG8_SA
#undef PG8_SB
#undef PG8_STAGE
#undef PG8_LDA
#undef PG8_LDB
#undef PG8_MMA
#undef PG8_WAIT_V
#undef PG8_WAIT_L
#undef PG8_BAR
#undef PG8_SCHED
}
}
constexpr int NWAVES = 8;
#ifndef MK_N_LAUNCHES
#define MK_N_LAUNCHES 1
#endif
constexpr int T_ = 8192, D_ = 2048, INW = 4640, NIN = 4864, RW = 1024, NH = 16, HD = 64, DFF = 5632, NUG = 2 * DFF;
constexpr int COL_R = 0, COL_K = 1024, COL_V = 2048, COL_XW = 3072, COL_XA = 3136, COL_XG = 3200, COL_Q = 3360, COL_KA = 4384, COL_VA = 4512, RIN = 3360;
constexpr float NORM_EPS = 1e-5f, LNX_EPS = 64e-5f;
constexpr size_t MiB = 1u << 20;
constexpr size_t WS_CTL = 0, CTL_ZERO_BYTES = 1 * MiB;
constexpr size_t WS_WIN = 1 * MiB, WS_WOUT = 20 * MiB, WS_HN = 28 * MiB, WS_Z = 61 * MiB, WS_RWA = 137 * MiB, WS_MISC = 250 * MiB, WS_END = 256 * MiB;
constexpr size_t WS_WUG = 61 * MiB, WS_WDN = 105 * MiB, WS_ACT = 127 * MiB, WS_H2 = 216 * MiB;
constexpr size_t RWA_STRIDE = 16 * MiB;
constexpr size_t MISC_BIAS = 0, MISC_ROPE = 64 * 1024, MISC_BON = 1 * MiB;
constexpr int CW_BAR = 4096;
constexpr int CW_SSQA = 65536, CW_SSQ2 = CW_SSQA + T_, CW_SSQ3 = CW_SSQ2 + T_;
static_assert((CW_SSQ3 + T_) * 4 <= (int)CTL_ZERO_BYTES, "ctl");
constexpr int RING_BYTES = 131072, XCH_OFF = RING_BYTES, LDSCTL_OFF = RING_BYTES + 4096, MISC_OFF = LDSCTL_OFF + 320, LDS_BYTES = 147456;

#define GAS __attribute__((address_space(1)))
#define LAS __attribute__((address_space(3)))
typedef unsigned short bf16;
typedef unsigned v4u __attribute__((ext_vector_type(4)));
typedef float f32x4 __attribute__((ext_vector_type(4)));
typedef GAS unsigned gu32;
#define RLX_AGENT __ATOMIC_RELAXED, __HIP_MEMORY_SCOPE_AGENT
#define LDS_WAIT() asm volatile("s_waitcnt lgkmcnt(0)" ::: "memory")
__device__ __forceinline__ unsigned f2bf(float f) { unsigned u = __builtin_bit_cast(unsigned, f); return (u + 0x7fffu + ((u >> 16) & 1u)) >> 16; }
__device__ __forceinline__ unsigned pk2(float lo, float hi) { return f2bf(lo) | (f2bf(hi) << 16); }
__device__ __forceinline__ float bf2f(unsigned h) { return __builtin_bit_cast(float, h << 16); }
__device__ __forceinline__ float wave_sum(float v) {
#pragma unroll
    for (int o = 1; o < 64; o <<= 1) v += __shfl_xor(v, o);
    return v;
}
#define XB_TMO      128
#define XB_XCNT(j)  (256  + 64 * (j))
#define XB_XSUB(j)  (1280 + 64 * (j))
#define XB_XGEN(j)  (2304 + 64 * (j))
#define XB_TOP      3328
#define XB_TOPGEN   3392
#define XCD_BAR_WORDS 3456
#define XB_SPIN_CAP (1u << 18)

__device__ __forceinline__ unsigned xb_ld(unsigned* p)              { return __hip_atomic_load(p, __ATOMIC_RELAXED, __HIP_MEMORY_SCOPE_AGENT); }
__device__ __forceinline__ unsigned xb_add(unsigned* p, unsigned v) { return __hip_atomic_fetch_add(p, v, __ATOMIC_RELAXED, __HIP_MEMORY_SCOPE_AGENT); }
__device__ __forceinline__ unsigned xb_xcc_id() { return (unsigned)__builtin_amdgcn_s_getreg((3 << 11) | 20) & 0xFu; }
#define XB_SPIN(cond, bar) do { unsigned _sp = 0; while (cond) { __builtin_amdgcn_s_sleep(1); \
    if ((++_sp & 255u) == 0u) { if (xb_ld(&(bar)[XB_TMO])) break; if (_sp > XB_SPIN_CAP) { atomicAdd(&(bar)[XB_TMO], 1u); break; } } } } while (0)

struct XcdBarrier {
    unsigned* bar; unsigned x;
    volatile LAS unsigned* st;
};

__device__ __forceinline__ XcdBarrier xcd_barrier_post(unsigned* bar, volatile LAS unsigned* st) {
    XcdBarrier b; b.bar = bar; b.x = xb_xcc_id(); b.st = st;
    if (threadIdx.x == 0) (void)xb_add(&bar[XB_XCNT(b.x)], 1u);
    return b;
}
__device__ __forceinline__ void xcd_barrier_complete(unsigned* bar, unsigned x, unsigned& nloc, unsigned& nx) {
    const unsigned G = gridDim.x * gridDim.y * gridDim.z;
    unsigned sum, cnt, mine, sp = 0u;
    for (;;) {
        sum = 0u; cnt = 0u; mine = 0u;
#pragma unroll
        for (unsigned j = 0; j < 16; ++j) { const unsigned c = xb_ld(&bar[XB_XCNT(j)]); sum += c; cnt += (c > 0u) ? 1u : 0u; mine = (j == x) ? c : mine; }
        if (sum == G) break;
        __builtin_amdgcn_s_sleep(1);
        if ((++sp & 255u) == 0u) { if (xb_ld(&bar[XB_TMO])) break; if (sp > XB_SPIN_CAP) { atomicAdd(&bar[XB_TMO], 1u); break; } }
    }
    nloc = mine > 0u ? mine : 1u; nx = cnt > 0u ? cnt : 1u;
}

__device__ __forceinline__ void xcd_barrier(const XcdBarrier& b) {
    asm volatile("s_waitcnt vmcnt(0)" ::: "memory");
    __syncthreads();
    if (threadIdx.x == 0) {
        unsigned* bar = b.bar;
        __builtin_amdgcn_s_waitcnt(0);
        unsigned nloc = b.st[0], nx = b.st[1];
        if (nloc == 0u) { xcd_barrier_complete(bar, b.x, nloc, nx); b.st[0] = nloc; b.st[1] = nx; }
        const unsigned old = xb_add(&bar[XB_XSUB(b.x)], 1u);
        const unsigned gen = old / nloc;
        if (old + 1u == (gen + 1u) * nloc) {
            __builtin_amdgcn_fence(__ATOMIC_RELEASE, "agent");
            asm volatile("s_waitcnt vmcnt(0)" ::: "memory");
            const unsigned og = xb_add(&bar[XB_TOP], 1u);
            const unsigned tg = og / nx;
            if (og + 1u == (tg + 1u) * nx) xb_add(&bar[XB_TOPGEN], 1u);
            else XB_SPIN(xb_ld(&bar[XB_TOPGEN]) == tg, bar);
            __builtin_amdgcn_fence(__ATOMIC_ACQUIRE, "agent");
            xb_add(&bar[XB_XGEN(b.x)], 1u);
            asm volatile("s_waitcnt vmcnt(0)" ::: "memory");
        } else {
            XB_SPIN(xb_ld(&bar[XB_XGEN(b.x)]) == gen, bar);
            __builtin_amdgcn_fence(__ATOMIC_ACQUIRE, "agent");
            asm volatile("s_waitcnt vmcnt(0)" ::: "memory");
        }
    }
    __syncthreads();
}
struct Ctx {
    LAS unsigned char* lds; int tid, lane, wave, vcu, G;
    const float* in[25]; float* out; unsigned char* ws;
};
#define IN_X 0
#define IN_LN_MIX_G 1
#define IN_W_IN 2
#define IN_B_ATTN 3
#define IN_MU 4
#define IN_W0 5
#define IN_W2 6
#define IN_A0 7
#define IN_A2 8
#define IN_G2 9
#define IN_K_K 10
#define IN_K_A 11
#define IN_R_K 12
#define IN_LNX_G 13
#define IN_LNX_B 14
#define IN_SINKS 15
#define IN_ATTN_G 16
#define IN_W_OUT 17
#define IN_LN_FFN_G 18
#define IN_W_UP 19
#define IN_W_GATE 20
#define IN_CONV_W 21
#define IN_CONV_B 22
#define IN_W_DOWN 23
#define IN_LN_FINAL_G 24

__device__ __forceinline__ void transpose_item(const float* W, int K, int N, bf16* WT, int drow0, LAS float* scr, int k0, int n0, int lane) {
#pragma unroll 8
    for (int i = 0; i < 32; ++i) { const int kk = 2 * i + (lane >> 5); scr[kk * 33 + (lane & 31)] = W[(size_t)(k0 + kk) * N + n0 + (lane & 31)]; }
    LDS_WAIT(); asm volatile("" ::: "memory");
    const int c = lane & 7;
#pragma unroll
    for (int j = 0; j < 4; ++j) { const int n = (lane >> 3) + 8 * j; const LAS float* s = scr + (8 * c) * 33 + n;
        v4u o; o.x = pk2(s[0 * 33], s[1 * 33]); o.y = pk2(s[2 * 33], s[3 * 33]); o.z = pk2(s[4 * 33], s[5 * 33]); o.w = pk2(s[6 * 33], s[7 * 33]);
        *(GAS v4u*)(WT + (size_t)(drow0 + n) * K + k0 + 8 * c) = o; }
    LDS_WAIT(); asm volatile("" ::: "memory");
}
__device__ __forceinline__ void rms_row_to_bf16(const float* xrow, const float* g, bf16* orow, int lane) {
    const GAS f32x4* xr = (const GAS f32x4*)xrow + lane; const GAS f32x4* gr = (const GAS f32x4*)g + lane;
    f32x4 v[8]; float s = 0.f;
#pragma unroll
    for (int j = 0; j < 8; ++j) { v[j] = xr[64 * j]; s += (v[j].x * v[j].x + v[j].y * v[j].y) + (v[j].z * v[j].z + v[j].w * v[j].w); }
    const float rs = 1.0f / sqrtf(wave_sum(s) * (1.f / D_) + NORM_EPS);
    GAS unsigned long long* o8 = (GAS unsigned long long*)orow + lane;
#pragma unroll
    for (int j = 0; j < 8; ++j) { const f32x4 gg = gr[64 * j]; o8[64 * j] = (unsigned long long)pk2(v[j].x * rs * gg.x, v[j].y * rs * gg.y) | ((unsigned long long)pk2(v[j].z * rs * gg.z, v[j].w * rs * gg.w) << 32); }
}

__device__ __forceinline__ void ph_prologue(Ctx& F) {
    LAS float* scr = (LAS float*)(F.lds + F.wave * 16384);
    const int gw = F.vcu * NWAVES + F.wave, NGW = F.G * NWAVES, gt = gw * 64 + F.lane, NGT = NGW * 64;
    bf16* WIN = (bf16*)(F.ws + WS_WIN); bf16* WOUT = (bf16*)(F.ws + WS_WOUT); bf16* HN = (bf16*)(F.ws + WS_HN);
    constexpr int I_IN = (D_ / 64) * (INW / 32), I_OUT = (D_ / 64) * (D_ / 32);
    for (int it = gw; it < I_IN + I_OUT; it += NGW) {
        if (it < I_IN) { const int nblk = INW / 32, kb = it / nblk, nb = it % nblk; transpose_item(F.in[IN_W_IN], D_, INW, WIN, 32 * nb, scr, 64 * kb, 32 * nb, F.lane); }
        else { const int r = it - I_IN, nblk = D_ / 32, kb = r / nblk, nb = r % nblk; transpose_item(F.in[IN_W_OUT], D_, D_, WOUT, 32 * nb, scr, 64 * kb, 32 * nb, F.lane); }
    }
    { GAS v4u* p = (GAS v4u*)(WIN + (size_t)INW * D_); const int n16 = (NIN - INW) * D_ * 2 / 16; for (int i = gt; i < n16; i += NGT) p[i] = (v4u){0u, 0u, 0u, 0u}; }
    { float* b = (float*)(F.ws + WS_MISC + MISC_BIAS); for (int i = gt; i < NIN; i += NGT) b[i] = (i >= RIN && i < INW) ? F.in[IN_B_ATTN][i - RIN] : 0.f; }
    { float* rt = (float*)(F.ws + WS_MISC + MISC_ROPE);
      for (int i = gt; i < T_ * 8; i += NGT) { const int t = i >> 3, k = i & 7;
          const float invf = k == 0 ? 1.0f : k == 1 ? 0x1.8d275ep-3f : k == 2 ? 0x1.341190p-5f : k == 3 ? 0x1.ddee9cp-8f : k == 4 ? 0x1.72ba44p-10f : k == 5 ? 0x1.1f91f0p-12f : k == 6 ? 0x1.be2188p-15f : 0x1.5a0f4ep-17f;
          const float ang = (float)t * invf;
          const double a = (double)ang, kq = rint(a * 0.15915494309189535), rr = fma(-kq, 6.283185307179586, a); const float rf = (float)rr;
          rt[t * 16 + k] = cosf(rf); rt[t * 16 + 8 + k] = sinf(rf); } }
    for (int m = gw; m < T_; m += NGW) rms_row_to_bf16(F.in[IN_X] + (size_t)m * D_, F.in[IN_LN_MIX_G], HN + (size_t)m * D_, F.lane);
}
__device__ __forceinline__ void ph_ffn_weights(Ctx& F, int gw, int NGW, int part) {
    LAS float* scr = (LAS float*)(F.lds + F.wave * 16384);
    bf16* WUG = (bf16*)(F.ws + WS_WUG); bf16* WDN = (bf16*)(F.ws + WS_WDN);
    constexpr int I_UP = (D_ / 64) * (DFF / 32), I_DN = (DFF / 64) * (D_ / 32);
    const int it_lo = (part == 1) ? 2 * I_UP : 0, it_hi = (part == 0) ? 2 * I_UP : 2 * I_UP + I_DN;
    for (int it = it_lo + gw; it < it_hi; it += NGW) {
        if (it < 2 * I_UP) { const int gate = it >= I_UP, r = gate ? it - I_UP : it, nblk = DFF / 32, kb = r / nblk, nb = r % nblk, n0 = 32 * nb;
            transpose_item(F.in[gate ? IN_W_GATE : IN_W_UP], D_, DFF, WUG, 256 * (n0 >> 7) + (n0 & 127) + (gate ? 128 : 0), scr, 64 * kb, n0, F.lane); }
        else { const int r = it - 2 * I_UP, nblk = D_ / 32, kb = r / nblk, nb = r % nblk; transpose_item(F.in[IN_W_DOWN], DFF, D_, WDN, 32 * nb, scr, 64 * kb, 32 * nb, F.lane); }
    }
}
__device__ __forceinline__ void ph_attention_naive(Ctx& F) {
    const bf16* Z = (const bf16*)(F.ws + WS_Z); bf16* YC = (bf16*)(F.ws + WS_HN); const float* rope = (const float*)(F.ws + WS_MISC + MISC_ROPE);
    float* ssqA = (float*)(F.ws + WS_CTL) + CW_SSQA;
    for (int it = F.vcu; it < 64 * NH; it += F.G) {
        const int nb = it >> 4, h = it & 15, kvh = h >> 3, q = F.tid >> 2, p = F.tid & 3, t = 128 * nb + q;
        float qv[64];
        { const bf16* qp = Z + (size_t)t * NIN + COL_Q + h * 64;
#pragma unroll
          for (int d = 0; d < 64; d += 8) { const v4u w = *(const GAS v4u*)(qp + d); const unsigned ww[4] = {w.x, w.y, w.z, w.w};
#pragma unroll
              for (int e = 0; e < 4; ++e) { qv[d + 2 * e] = bf2f(ww[e] & 0xffffu); qv[d + 2 * e + 1] = bf2f(ww[e] >> 16); } }
#pragma unroll
          for (int i = 0; i < 8; ++i) { const float c = rope[t * 16 + i], s = rope[t * 16 + 8 + i], x1 = qv[i], x2 = qv[8 + i]; qv[i] = x1 * c - x2 * s; qv[8 + i] = x2 * c + x1 * s; } }
        float m = -INFINITY, l = 0.f, o[64];
#pragma unroll
        for (int d = 0; d < 64; ++d) o[d] = 0.f;
        for (int i = 0; i < 32; ++i) {
            const int kp = t - 127 + 32 * p + i;
            if (kp >= 0) {
                const bf16* kr = Z + (size_t)kp * NIN + COL_KA + kvh * 64; const bf16* vr = Z + (size_t)kp * NIN + COL_VA + kvh * 64;
                float kv[16];
                { const v4u w0 = *(const GAS v4u*)(kr), w1 = *(const GAS v4u*)(kr + 8); const unsigned ww[8] = {w0.x, w0.y, w0.z, w0.w, w1.x, w1.y, w1.z, w1.w};
#pragma unroll
                  for (int e = 0; e < 8; ++e) { kv[2 * e] = bf2f(ww[e] & 0xffffu); kv[2 * e + 1] = bf2f(ww[e] >> 16); } }
                float s = 0.f;
#pragma unroll
                for (int j = 0; j < 8; ++j) { const float c = rope[kp * 16 + j], sn = rope[kp * 16 + 8 + j], x1 = kv[j], x2 = kv[8 + j]; s += qv[j] * (x1 * c - x2 * sn) + qv[8 + j] * (x2 * c + x1 * sn); }
#pragma unroll
                for (int d = 16; d < 64; d += 8) { const v4u w = *(const GAS v4u*)(kr + d); const unsigned ww[4] = {w.x, w.y, w.z, w.w};
#pragma unroll
                    for (int e = 0; e < 4; ++e) s += qv[d + 2 * e] * bf2f(ww[e] & 0xffffu) + qv[d + 2 * e + 1] * bf2f(ww[e] >> 16); }
                s *= 0.125f;
                const float mn = fmaxf(m, s), al = __expf(m - mn), pe = __expf(s - mn);
                l = l * al + pe; m = mn;
#pragma unroll
                for (int d = 0; d < 64; d += 8) { const v4u w = *(const GAS v4u*)(vr + d); const unsigned ww[4] = {w.x, w.y, w.z, w.w};
#pragma unroll
                    for (int e = 0; e < 4; ++e) { o[d + 2 * e] = o[d + 2 * e] * al + pe * bf2f(ww[e] & 0xffffu); o[d + 2 * e + 1] = o[d + 2 * e + 1] * al + pe * bf2f(ww[e] >> 16); } }
            }
        }
        float M = fmaxf(m, __shfl_xor(m, 1)); M = fmaxf(M, __shfl_xor(M, 2));
        const float sc = (m == -INFINITY) ? 0.f : __expf(m - M);
        l *= sc; l += __shfl_xor(l, 1); l += __shfl_xor(l, 2);
        const float den = 1.0f / (l + __expf(F.in[IN_SINKS][h] - M));
        float sq = 0.f;
#pragma unroll
        for (int d = 0; d < 64; ++d) { float v = o[d] * sc; v += __shfl_xor(v, 1); v += __shfl_xor(v, 2); o[d] = v * den; sq += o[d] * o[d]; }
        if (p == 0) { bf16* op = YC + (size_t)t * D_ + RW + h * 64;
#pragma unroll
            for (int d = 0; d < 64; d += 8) { v4u w; w.x = pk2(o[d], o[d + 1]); w.y = pk2(o[d + 2], o[d + 3]); w.z = pk2(o[d + 4], o[d + 5]); w.w = pk2(o[d + 6], o[d + 7]); *(GAS v4u*)(op + d) = w; }
            atomicAdd(ssqA + t, sq); }
    }
}
__device__ __forceinline__ float zshift(const bf16* Z, const float* mu, int t, int col) {
    const float zc = bf2f(Z[(size_t)t * NIN + col]); const float zp = t > 0 ? bf2f(Z[(size_t)(t - 1) * NIN + col]) : 0.f; return zc + mu[col] * (zp - zc);
}
__device__ __forceinline__ void ph_rwkv_prep_naive(Ctx& F) {
    const bf16* Z = (const bf16*)(F.ws + WS_Z); const float* mu = F.in[IN_MU];
    bf16* KK = (bf16*)(F.ws + WS_RWA); bf16* BB = KK + RWA_STRIDE / 2; bf16* KM = BB + RWA_STRIDE / 2; bf16* RS = KM + RWA_STRIDE / 2; bf16* VS = RS + RWA_STRIDE / 2; bf16* GG = VS + RWA_STRIDE / 2;
    float* LW = F.out; float* BON = (float*)(F.ws + WS_MISC + MISC_BON);
    LAS float* aw = (LAS float*)F.lds; LAS float* aa = aw + 8 * 64; LAS float* ag = aa + 8 * 64;
    for (int grp = F.vcu; grp < T_ / 8; grp += F.G) {
        const int t0 = grp * 8;
        __syncthreads();
        for (int e = F.tid; e < 8 * 288; e += 512) { const int tok = e / 288, j = e % 288; const float v = zshift(Z, mu, t0 + tok, COL_XW + j);
            if (j < 64) aw[tok * 64 + j] = tanhf(v); else if (j < 128) aa[tok * 64 + j - 64] = v; else ag[tok * 160 + j - 128] = 1.0f / (1.0f + __expf(-v)); }
        __syncthreads();
#pragma unroll 1
        for (int cc = 0; cc < 2; ++cc) {
            const int c = F.tid + 512 * cc;
            float wl[8], al[8], gl[8];
#pragma unroll
            for (int k = 0; k < 8; ++k) { wl[k] = 0.f; al[k] = 0.f; gl[k] = 0.f; }
            for (int j = 0; j < 64; ++j) { const float w2v = F.in[IN_W2][j * RW + c], a2v = F.in[IN_A2][j * RW + c];
#pragma unroll
                for (int k = 0; k < 8; ++k) { wl[k] += aw[k * 64 + j] * w2v; al[k] += aa[k * 64 + j] * a2v; } }
            for (int j = 0; j < 160; ++j) { const float g2v = F.in[IN_G2][j * RW + c];
#pragma unroll
                for (int k = 0; k < 8; ++k) gl[k] += ag[k * 160 + j] * g2v; }
            const float w0 = F.in[IN_W0][c], a0 = F.in[IN_A0][c], kkc = F.in[IN_K_K][c], kac = F.in[IN_K_A][c];
#pragma unroll
            for (int k = 0; k < 8; ++k) { const int t = t0 + k; const size_t o = (size_t)t * RW + c;
                const float x = w0 + wl[k];
                const float sp = (x < -20.f) ? -x : log1pf(__expf(-x));
                LW[o] = -__expf(-sp - 0.5f);
                const float a = 1.0f / (1.0f + __expf(-(a0 + al[k])));
                const float kraw = zshift(Z, mu, t, COL_K + c), kkv = kraw * kkc;
                const float nrm = fmaxf(sqrtf(wave_sum(kkv * kkv)), 1e-12f); const float kn = kkv / nrm;
                KK[o] = (bf16)f2bf(kn); BB[o] = (bf16)f2bf(kn * a); KM[o] = (bf16)f2bf(kraw * (1.0f + (a - 1.0f) * kac));
                const float rsh = zshift(Z, mu, t, COL_R + c), kmd = kraw * (1.0f + (a - 1.0f) * kac);
                const float bon = wave_sum(rsh * kmd * F.in[IN_R_K][c]); if (F.lane == 0) BON[t * 16 + (c >> 6)] = bon;
                RS[o] = (bf16)f2bf(rsh); VS[o] = (bf16)f2bf(zshift(Z, mu, t, COL_V + c)); GG[o] = (bf16)f2bf(gl[k]); }
        }
    }
}
__device__ __forceinline__ void ph_rwkv_scan_naive(Ctx& F) {
    if (F.vcu >= NH || F.wave != 0) return;
    const int h = F.vcu, l = F.lane;
    const bf16* KK = (const bf16*)(F.ws + WS_RWA); const bf16* BB = KK + RWA_STRIDE / 2; const bf16* KM = BB + RWA_STRIDE / 2; const bf16* RS = KM + RWA_STRIDE / 2; const bf16* VS = RS + RWA_STRIDE / 2;
    const float* LW = F.out; float* Y = F.out + (size_t)T_ * RW;
    float S[64];
#pragma unroll
    for (int j = 0; j < 64; ++j) S[j] = 0.f;
    size_t o = (size_t)h * 64 + l;
    float n_lw = LW[o]; unsigned n_kk = KK[o], n_bb = BB[o], n_km = KM[o], n_rs = RS[o], n_vs = VS[o];
    for (int t = 0; t < T_; ++t) {
        const float w = __expf(n_lw), kk = bf2f(n_kk), bb = bf2f(n_bb), km = bf2f(n_km), r = bf2f(n_rs), v = bf2f(n_vs);
        if (t + 1 < T_) { const size_t o2 = (size_t)(t + 1) * RW + h * 64 + l; n_lw = LW[o2]; n_kk = KK[o2]; n_bb = BB[o2]; n_km = KM[o2]; n_rs = RS[o2]; n_vs = VS[o2]; }
        float sa = 0.f;
#pragma unroll
        for (int j = 0; j < 64; ++j) sa += S[j] * __builtin_bit_cast(float, __builtin_amdgcn_readlane(__builtin_bit_cast(int, kk), j));
        sa = -sa;
        float y = 0.f;
#pragma unroll
        for (int j = 0; j < 64; ++j) {
            const float wj = __builtin_bit_cast(float, __builtin_amdgcn_readlane(__builtin_bit_cast(int, w), j)), bj = __builtin_bit_cast(float, __builtin_amdgcn_readlane(__builtin_bit_cast(int, bb), j));
            const float kj = __builtin_bit_cast(float, __builtin_amdgcn_readlane(__builtin_bit_cast(int, km), j)), rj = __builtin_bit_cast(float, __builtin_amdgcn_readlane(__builtin_bit_cast(int, r), j));
            S[j] = S[j] * wj + (sa * bj + v * kj); y += S[j] * rj; }
        Y[(size_t)t * RW + h * 64 + l] = y;
    }
}
__device__ __forceinline__ void ph_post(Ctx& F) {
    const bf16* KM = (const bf16*)(F.ws + WS_RWA) + 2 * (RWA_STRIDE / 2); const bf16* RS = KM + RWA_STRIDE / 2; const bf16* VS = RS + RWA_STRIDE / 2; const bf16* GG = VS + RWA_STRIDE / 2;
    const float* Y = F.out + (size_t)T_ * RW; bf16* YC = (bf16*)(F.ws + WS_HN); const float* ssqA = (const float*)(F.ws + WS_CTL) + CW_SSQA;
    const int gw = F.vcu * NWAVES + F.wave, NGW = F.G * NWAVES, l = F.lane;
    for (int it = gw; it < T_ * NH; it += NGW) {
        const int t = it >> 4, h = it & 15, c = h * 64 + l; const size_t o = (size_t)t * RW + c;
        const float y = Y[o]; const float mu = wave_sum(y) * (1.f / 64.f); const float d = y - mu; const float var = wave_sum(d * d) * (1.f / 64.f);
        const float yn = d * (1.0f / sqrtf(var + LNX_EPS)) * F.in[IN_LNX_G][c] + F.in[IN_LNX_B][c];
        const float r = bf2f(RS[o]), k = bf2f(KM[o]), v = bf2f(VS[o]), g = bf2f(GG[o]);
        const float bonus = wave_sum(r * k * F.in[IN_R_K][c]) * v;
        YC[(size_t)t * D_ + c] = (bf16)f2bf((yn + bonus) * g);
    }
    for (int t = gw; t < T_; t += NGW) {
        const float sc = 1.0f / sqrtf(ssqA[t] * (1.f / RW) + NORM_EPS);
        bf16* p = YC + (size_t)t * D_ + RW;
#pragma unroll
        for (int j = 0; j < 16; ++j) { const int c = j * 64 + l; p[c] = (bf16)f2bf(bf2f(p[c]) * sc * F.in[IN_ATTN_G][c]); }
    }
}
__device__ __forceinline__ void ph_final(Ctx& F) {
    const float* ssq3 = (const float*)(F.ws + WS_CTL) + CW_SSQ3; const int gw = F.vcu * NWAVES + F.wave, NGW = F.G * NWAVES;
    for (int t = gw; t < T_; t += NGW) {
        const float sc = 1.0f / sqrtf(ssq3[t] * (1.f / D_) + NORM_EPS);
        GAS f32x4* xr = (GAS f32x4*)(F.out + (size_t)t * D_) + F.lane; const GAS f32x4* gr = (const GAS f32x4*)F.in[IN_LN_FINAL_G] + F.lane;
#pragma unroll
        for (int j = 0; j < 8; ++j) { const f32x4 v = xr[64 * j], g = gr[64 * j]; xr[64 * j] = v * sc * g; }
    }
}
typedef short bf16x8 __attribute__((ext_vector_type(8)));
typedef unsigned u32x2v __attribute__((ext_vector_type(2)));
constexpr int RS_ = 144;
constexpr int MATB = 64 * RS_;
constexpr int L_RMA = 0, L_RMR = MATB, L_RMB = 2 * MATB, L_RMK = 3 * MATB;
constexpr int L_XTA = L_RMB, L_XTV = L_RMK;
constexpr int L_CMA = 4 * MATB, L_CMBH = 5 * MATB, L_CMKH = 6 * MATB, L_CMV = 7 * MATB;
constexpr int L_LAB = 8 * MATB, L_LAK = 9 * MATB, L_LRB = 10 * MATB, L_LRK = 11 * MATB;
constexpr int L_LD = 12 * MATB, L_TI = L_LD + 4096, L_TOT = L_TI + 2048, L_R1END = L_TOT + 2048;
static_assert(L_R1END <= RING_BYTES, "R1 LDS");
constexpr size_t WS_SC = 1 * MiB, WS_WC = 17 * MiB, WS_H = 105 * MiB, WS_YB = 233 * MiB;
constexpr size_t OUT_GP = 32 * MiB, OUT_RB = 48 * MiB, OUT_LW = 0;


__device__ __forceinline__ f32x4 mfma16(bf16x8 a, bf16x8 b, f32x4 c) { return __builtin_amdgcn_mfma_f32_16x16x32_bf16(a, b, c, 0, 0, 0); }
__device__ __forceinline__ bf16x8 ld128(const LAS unsigned char* p) { return *(const LAS bf16x8*)p; }
__device__ __forceinline__ u32x2v ld64(const LAS unsigned char* p) { return *(const LAS u32x2v*)p; }
__device__ __forceinline__ u32x2v pack4(f32x4 v) { u32x2v r; r.x = pk2(v[0], v[1]); r.y = pk2(v[2], v[3]); return r; }
__device__ __forceinline__ f32x4 unpack4(u32x2v w) { return (f32x4){bf2f(w.x & 0xffffu), bf2f(w.x >> 16), bf2f(w.y & 0xffffu), bf2f(w.y >> 16)}; }
__device__ __forceinline__ bf16x8 cat8(u32x2v lo, u32x2v hi) { v4u t; t.x = lo.x; t.y = lo.y; t.z = hi.x; t.w = hi.y; return __builtin_bit_cast(bf16x8, t); }

__device__ __forceinline__ void ph_rwkv_chunk(Ctx& F) {
    const bf16* KK = (const bf16*)(F.ws + WS_RWA); const bf16* BB = KK + RWA_STRIDE / 2; const bf16* KM = BB + RWA_STRIDE / 2; const bf16* RSg = KM + RWA_STRIDE / 2; const bf16* VSg = RSg + RWA_STRIDE / 2;
    const float* LWg = (const float*)((const unsigned char*)F.out + OUT_LW);
    unsigned char* GPg = (unsigned char*)F.out + OUT_GP; unsigned char* RBg = (unsigned char*)F.out + OUT_RB;
    float* WCg = (float*)(F.ws + WS_WC); float* Hg = (float*)(F.ws + WS_H); unsigned char* YBg = F.ws + WS_YB;
    LAS unsigned char* lds = F.lds;
    const int w = F.wave, l = F.lane, r = l & 15, q = l >> 4;
    const u32x2v zero2 = (u32x2v){0u, 0u};
    for (int it = F.vcu; it < 128 * NH; it += F.G) {
        const int c = it >> 4, h = it & 15;
        __syncthreads();
        {
            float lwv[8], kkv[8], bbv[8], kmv[8], rsv[8], vsv[8];
#pragma unroll
            for (int i = 0; i < 8; ++i) { const size_t idx = (size_t)(64 * c + 8 * w + i) * RW + h * 64 + l;
                lwv[i] = LWg[idx]; kkv[i] = bf2f(KK[idx]); bbv[i] = bf2f(BB[idx]); kmv[i] = bf2f(KM[idx]); rsv[i] = bf2f(RSg[idx]); vsv[i] = bf2f(VSg[idx]); }
            float cs[8]; cs[0] = lwv[0];
#pragma unroll
            for (int i = 1; i < 8; ++i) cs[i] = cs[i - 1] + lwv[i];
            LAS float* tot = (LAS float*)(lds + L_TOT);
            tot[w * 64 + l] = cs[7];
            __syncthreads();
            float pre = 0.f, total = 0.f;
#pragma unroll
            for (int ww = 0; ww < 8; ++ww) { const float tv = tot[ww * 64 + l]; total += tv; if (ww < w) pre += tv; }
            if (w == 0) WCg[(h * 128 + c) * 64 + l] = __expf(total);
            unsigned pa[4], pbh[4], pkh[4], pv[4];
#pragma unroll
            for (int i = 0; i < 8; ++i) { const float LWt = pre + cs[i], LWm = LWt - lwv[i];
                const float eA = __expf(LWm), eR = __expf(LWt), eN = __expf(-LWt), eH = __expf(total - LWt);
                const unsigned vA = f2bf(-kkv[i] * eA), vR = f2bf(rsv[i] * eR), vB = f2bf(bbv[i] * eN), vK = f2bf(kmv[i] * eN), vBh = f2bf(bbv[i] * eH), vKh = f2bf(kmv[i] * eH), vV = f2bf(vsv[i]);
                const int t = 8 * w + i;
                *(LAS unsigned short*)(lds + L_RMA + t * RS_ + l * 2) = (unsigned short)vA; *(LAS unsigned short*)(lds + L_RMR + t * RS_ + l * 2) = (unsigned short)vR;
                *(LAS unsigned short*)(lds + L_RMB + t * RS_ + l * 2) = (unsigned short)vB; *(LAS unsigned short*)(lds + L_RMK + t * RS_ + l * 2) = (unsigned short)vK;
                if (i & 1) { pa[i >> 1] |= vA << 16; pbh[i >> 1] |= vBh << 16; pkh[i >> 1] |= vKh << 16; pv[i >> 1] |= vV << 16; }
                else { pa[i >> 1] = vA; pbh[i >> 1] = vBh; pkh[i >> 1] = vKh; pv[i >> 1] = vV; } }
            *(LAS v4u*)(lds + L_CMA + l * RS_ + w * 16) = (v4u){pa[0], pa[1], pa[2], pa[3]}; *(LAS v4u*)(lds + L_CMBH + l * RS_ + w * 16) = (v4u){pbh[0], pbh[1], pbh[2], pbh[3]};
            *(LAS v4u*)(lds + L_CMKH + l * RS_ + w * 16) = (v4u){pkh[0], pkh[1], pkh[2], pkh[3]}; *(LAS v4u*)(lds + L_CMV + l * RS_ + w * 16) = (v4u){pv[0], pv[1], pv[2], pv[3]};
        }
        __syncthreads();
        {
            const int p = w >> 1, half = w & 1; const int Arm = (p & 1) ? L_RMK : L_RMB, Brm = (p >> 1) ? L_RMR : L_RMA, Lout = L_LAB + p * MATB; const bool strict = p < 2;
            bf16x8 Bf[2][2];
#pragma unroll
            for (int tbi = 0; tbi < 2; ++tbi)
#pragma unroll
                for (int ks = 0; ks < 2; ++ks) Bf[tbi][ks] = ld128(lds + Brm + (16 * (2 * half + tbi) + r) * RS_ + (32 * ks + 8 * q) * 2);
#pragma unroll
            for (int sb = 0; sb < 4; ++sb) {
                const bf16x8 A0 = ld128(lds + Arm + (16 * sb + r) * RS_ + (8 * q) * 2), A1 = ld128(lds + Arm + (16 * sb + r) * RS_ + (32 + 8 * q) * 2);
#pragma unroll
                for (int tbi = 0; tbi < 2; ++tbi) { const int tb = 2 * half + tbi;
                    f32x4 acc = (f32x4){0.f, 0.f, 0.f, 0.f}; acc = mfma16(A0, Bf[tbi][0], acc); acc = mfma16(A1, Bf[tbi][1], acc);
                    const int t = 16 * tb + r, s0 = 16 * sb + 4 * q;
#pragma unroll
                    for (int e = 0; e < 4; ++e) { const bool keep = strict ? (s0 + e < t) : (s0 + e <= t); acc[e] = keep ? acc[e] : 0.f; }
                    *(LAS u32x2v*)(lds + Lout + t * RS_ + s0 * 2) = pack4(acc);
                    if (p == 0 && sb == tb) *(LAS f32x4*)(lds + L_LD + ((sb * 16 + r) * 16 + 4 * q) * 4) = acc; }
            }
        }
        __syncthreads();
        f32x4 acc[4];
        if (w >= 4) {
            const int nbv = w - 4;
            const bf16x8 V0 = ld128(lds + L_CMV + (16 * nbv + r) * RS_ + (8 * q) * 2), V1 = ld128(lds + L_CMV + (16 * nbv + r) * RS_ + (32 + 8 * q) * 2);
#pragma unroll
            for (int I = 0; I < 4; ++I) { acc[I] = (f32x4){0.f, 0.f, 0.f, 0.f};
                acc[I] = mfma16(ld128(lds + L_LAK + (16 * I + r) * RS_ + (8 * q) * 2), V0, acc[I]); acc[I] = mfma16(ld128(lds + L_LAK + (16 * I + r) * RS_ + (32 + 8 * q) * 2), V1, acc[I]); }
        } else {
#pragma unroll
            for (int I = 0; I < 4; ++I) acc[I] = unpack4(ld64(lds + L_CMA + (16 * w + r) * RS_ + (16 * I + 4 * q) * 2));
            if (w == 3) {
                const int b = q, cc = r; float x[16];
#pragma unroll
                for (int t = 0; t < 16; ++t) { float a = (t == cc) ? 1.f : 0.f;
#pragma unroll
                    for (int s4 = 0; s4 * 4 < t; ++s4) { const f32x4 lv = *(const LAS f32x4*)(lds + L_LD + ((b * 16 + t) * 16 + 4 * s4) * 4);
#pragma unroll
                        for (int e = 0; e < 4; ++e) if (4 * s4 + e < t) a += lv[e] * x[4 * s4 + e]; }
                    x[t] = a; *(LAS unsigned short*)(lds + L_TI + ((b * 16 + t) * 16 + cc) * 2) = (unsigned short)f2bf(a); }
            }
        }
        __syncthreads();
        {
            const f32x4 z4 = (f32x4){0.f, 0.f, 0.f, 0.f};
#define TIF(I) cat8(ld64(lds + L_TI + (((I) * 16 + r) * 16 + 4 * q) * 2), zero2)
#define LF1(I, K1) cat8(ld64(lds + L_LAB + (16 * (I) + r) * RS_ + (16 * (K1) + 4 * q) * 2), zero2)
#define LF2(I, K1, K2) cat8(ld64(lds + L_LAB + (16 * (I) + r) * RS_ + (16 * (K1) + 4 * q) * 2), ld64(lds + L_LAB + (16 * (I) + r) * RS_ + (16 * (K2) + 4 * q) * 2))
            const f32x4 X0 = mfma16(TIF(0), cat8(pack4(acc[0]), zero2), z4);
            const f32x4 Q1 = mfma16(LF1(1, 0), cat8(pack4(X0), zero2), acc[1]);
            const f32x4 X1 = mfma16(TIF(1), cat8(pack4(Q1), zero2), z4);
            const bf16x8 B01 = cat8(pack4(X0), pack4(X1));
            const f32x4 Q2 = mfma16(LF2(2, 0, 1), B01, acc[2]);
            const f32x4 X2 = mfma16(TIF(2), cat8(pack4(Q2), zero2), z4);
            f32x4 Q3 = mfma16(LF2(3, 0, 1), B01, acc[3]); Q3 = mfma16(LF1(3, 2), cat8(pack4(X2), zero2), Q3);
            const f32x4 X3 = mfma16(TIF(3), cat8(pack4(Q3), zero2), z4);
#undef TIF
#undef LF1
#undef LF2
            const int xo = (w < 4 ? L_XTA : L_XTV) + (16 * (w & 3) + r) * RS_ + (4 * q) * 2;
            *(LAS u32x2v*)(lds + xo) = pack4(X0); *(LAS u32x2v*)(lds + xo + 32) = pack4(X1); *(LAS u32x2v*)(lds + xo + 64) = pack4(X2); *(LAS u32x2v*)(lds + xo + 96) = pack4(X3);
        }
        __syncthreads();
        {
            const int lo4 = w & 3, hi2 = w >> 2; const f32x4 z4 = (f32x4){0.f, 0.f, 0.f, 0.f};
#define FR(base, row0, ks) ld128(lds + (base) + ((row0) + r) * RS_ + (32 * (ks) + 8 * q) * 2)
            {
                const bf16x8 B0 = FR(L_CMBH, 16 * lo4, 0), B1 = FR(L_CMBH, 16 * lo4, 1); u32x2v o[2];
#pragma unroll
                for (int hf = 0; hf < 2; ++hf) { const int jb = 2 * hi2 + hf; f32x4 a = mfma16(FR(L_XTA, 16 * jb, 0), B0, z4); a = mfma16(FR(L_XTA, 16 * jb, 1), B1, a); o[hf] = pack4(a); }
                *(GAS v4u*)(GPg + (size_t)(h * 128 + c) * 8192 + ((lo4 * 2 + hi2) * 64 + l) * 16) = (v4u){o[0].x, o[0].y, o[1].x, o[1].y};
            }
            {
                const bf16x8 B0 = FR(L_LRB, 16 * lo4, 0), B1 = FR(L_LRB, 16 * lo4, 1); const int t = 16 * lo4 + r;
#pragma unroll
                for (int hf = 0; hf < 2; ++hf) { const int jb = 2 * hi2 + hf; f32x4 a = unpack4(ld64(lds + L_RMR + t * RS_ + (16 * jb + 4 * q) * 2));
                    a = mfma16(FR(L_XTA, 16 * jb, 0), B0, a); a = mfma16(FR(L_XTA, 16 * jb, 1), B1, a);
                    *(GAS u32x2v*)(RBg + (size_t)it * 8192 + t * 128 + (16 * jb + 4 * q) * 2) = pack4(a); }
            }
            {
                const bf16x8 XV0 = FR(L_XTV, 16 * lo4, 0), XV1 = FR(L_XTV, 16 * lo4, 1), V0 = FR(L_CMV, 16 * lo4, 0), V1 = FR(L_CMV, 16 * lo4, 1);
#pragma unroll
                for (int hf = 0; hf < 2; ++hf) { const int ib = 2 * hi2 + hf;
                    f32x4 a = mfma16(FR(L_CMBH, 16 * ib, 0), XV0, z4); a = mfma16(FR(L_CMBH, 16 * ib, 1), XV1, a); a = mfma16(FR(L_CMKH, 16 * ib, 0), V0, a); a = mfma16(FR(L_CMKH, 16 * ib, 1), V1, a);
                    *(GAS f32x4*)(Hg + ((size_t)((h * 4 + lo4) * 128 + c) * 4 + ib) * 256 + l * 4) = a;
                    f32x4 y = mfma16(FR(L_LRB, 16 * ib, 0), XV0, z4); y = mfma16(FR(L_LRB, 16 * ib, 1), XV1, y); y = mfma16(FR(L_LRK, 16 * ib, 0), V0, y); y = mfma16(FR(L_LRK, 16 * ib, 1), V1, y);
                    *(GAS u32x2v*)(YBg + (size_t)it * 8192 + ((lo4 * 4 + ib) * 64 + l) * 8) = pack4(y); }
            }
#undef FR
        }
    }
}
constexpr int CH_SS = 4;
constexpr int CH_STEP_BYTES = 8192 + 4096 + 256;
constexpr int CH_BUF_BYTES = CH_SS * CH_STEP_BYTES;
static_assert(2 * CH_BUF_BYTES <= RING_BYTES, "chain LDS");
__device__ __forceinline__ void chain_stage(Ctx& F, int h, int cb, int ss, int bufoff) {
    const unsigned char* GPg = (const unsigned char*)F.out + OUT_GP; const unsigned char* Hg = (const unsigned char*)(F.ws + WS_H); const unsigned char* WCg = (const unsigned char*)(F.ws + WS_WC);
#pragma unroll
    for (int st = 0; st < CH_SS; ++st) { const int c = ss * CH_SS + st; const size_t ih = (size_t)h * 128 + c; const int sb = bufoff + st * CH_STEP_BYTES;
#pragma unroll
        for (int p = 0; p < 13; ++p) { if (((st * 13 + p) & 7) != F.wave) continue;
            if (p < 8) __builtin_amdgcn_global_load_lds((const unsigned*)(GPg + ih * 8192 + p * 1024 + F.lane * 16), (LAS unsigned*)(F.lds + sb + p * 1024), 16, 0, 0);
            else if (p < 12) __builtin_amdgcn_global_load_lds((const unsigned*)(Hg + (((size_t)(h * 4 + cb) * 128 + c) * 4 + (p - 8)) * 1024 + F.lane * 16), (LAS unsigned*)(F.lds + sb + 8192 + (p - 8) * 1024), 16, 0, 0);
            else __builtin_amdgcn_global_load_lds((const unsigned*)(WCg + ih * 256 + F.lane * 4), (LAS unsigned*)(F.lds + sb + 12288), 4, 0, 0); } }
}
__device__ __forceinline__ void ph_rwkv_chain(Ctx& F, int cid) {
    const int h = cid >> 2, cb = cid & 3, l = F.lane, cc = l & 15, q = l >> 4;
    unsigned char* SCg = F.ws + WS_SC;
    f32x4 S[4];
#pragma unroll
    for (int m = 0; m < 4; ++m) S[m] = (f32x4){0.f, 0.f, 0.f, 0.f};
    chain_stage(F, h, cb, 0, 0);
    for (int ss = 0; ss < 128 / CH_SS; ++ss) {
        const int bo = (ss & 1) * CH_BUF_BYTES;
        asm volatile("s_waitcnt vmcnt(0)" ::: "memory");
        __syncthreads();
        if (ss + 1 < 128 / CH_SS) chain_stage(F, h, cb, ss + 1, ((ss + 1) & 1) * CH_BUF_BYTES);
        if (F.wave == 0) {
#pragma unroll
            for (int st = 0; st < CH_SS; ++st) { const int c = ss * CH_SS + st; const size_t it = (size_t)c * 16 + h; const LAS unsigned char* sb = F.lds + bo + st * CH_STEP_BYTES;
                u32x2v ps[4];
#pragma unroll
                for (int m = 0; m < 4; ++m) { ps[m] = pack4(S[m]); *(GAS u32x2v*)(SCg + it * 8192 + (16 * cb + cc) * 128 + (16 * m + 4 * q) * 2) = ps[m]; }
                const bf16x8 b0 = cat8(ps[0], ps[1]), b1 = cat8(ps[2], ps[3]);
#pragma unroll
                for (int m = 0; m < 4; ++m) { const f32x4 wc = *(const LAS f32x4*)(sb + 12288 + (16 * m + 4 * q) * 4), hh = *(const LAS f32x4*)(sb + 8192 + (m * 64 + l) * 16);
                    f32x4 a = wc * S[m] + hh;
                    a = mfma16(ld128(sb + ((m * 2 + 0) * 64 + l) * 16), b0, a); a = mfma16(ld128(sb + ((m * 2 + 1) * 64 + l) * 16), b1, a);
                    S[m] = a; }
            }
        }
    }
    asm volatile("s_waitcnt vmcnt(0)" ::: "memory"); __syncthreads();
}
__device__ __forceinline__ void ph_post_b(Ctx& F) {
    const bf16* VSg = (const bf16*)(F.ws + WS_RWA) + 4 * (RWA_STRIDE / 2); const bf16* GGg = VSg + RWA_STRIDE / 2;
    const unsigned char* SCg = F.ws + WS_SC; const unsigned char* RBg = (const unsigned char*)F.out + OUT_RB; const unsigned char* YBg = F.ws + WS_YB;
    const float* BON = (const float*)(F.ws + WS_MISC + MISC_BON);
    bf16* YC = (bf16*)(F.ws + WS_HN); const float* ssqA = (const float*)(F.ws + WS_CTL) + CW_SSQA;
    const int l = F.lane, cc = l & 15, q = l >> 4, tb = F.wave & 3;
    for (int it = F.vcu * 2 + (F.wave >> 2); it < 128 * NH; it += 2 * F.G) {
        const int c = it >> 4, h = it & 15;
        const bf16x8 A0 = *(const GAS bf16x8*)(RBg + (size_t)it * 8192 + (16 * tb + cc) * 128 + (8 * q) * 2), A1 = *(const GAS bf16x8*)(RBg + (size_t)it * 8192 + (16 * tb + cc) * 128 + (32 + 8 * q) * 2);
        f32x4 y[4];
#pragma unroll
        for (int nb = 0; nb < 4; ++nb) {
            const bf16x8 B0 = *(const GAS bf16x8*)(SCg + (size_t)it * 8192 + (16 * nb + cc) * 128 + (8 * q) * 2), B1 = *(const GAS bf16x8*)(SCg + (size_t)it * 8192 + (16 * nb + cc) * 128 + (32 + 8 * q) * 2);
            y[nb] = unpack4(*(const GAS u32x2v*)(YBg + (size_t)it * 8192 + ((nb * 4 + tb) * 64 + l) * 8));
            y[nb] = mfma16(A0, B0, y[nb]); y[nb] = mfma16(A1, B1, y[nb]); }
        float lg[4], lb[4];
#pragma unroll
        for (int nb = 0; nb < 4; ++nb) { lg[nb] = F.in[IN_LNX_G][h * 64 + 16 * nb + cc]; lb[nb] = F.in[IN_LNX_B][h * 64 + 16 * nb + cc]; }
#pragma unroll
        for (int e = 0; e < 4; ++e) {
            const int t = 64 * c + 16 * tb + 4 * q + e;
            float s = (y[0][e] + y[1][e]) + (y[2][e] + y[3][e]);
            s += __shfl_xor(s, 1); s += __shfl_xor(s, 2); s += __shfl_xor(s, 4); s += __shfl_xor(s, 8);
            const float mu = s * (1.f / 64.f);
            float d[4], v2 = 0.f;
#pragma unroll
            for (int nb = 0; nb < 4; ++nb) { d[nb] = y[nb][e] - mu; v2 += d[nb] * d[nb]; }
            v2 += __shfl_xor(v2, 1); v2 += __shfl_xor(v2, 2); v2 += __shfl_xor(v2, 4); v2 += __shfl_xor(v2, 8);
            const float rstd = 1.0f / sqrtf(v2 * (1.f / 64.f) + LNX_EPS), bon = BON[t * 16 + h];
#pragma unroll
            for (int nb = 0; nb < 4; ++nb) { const size_t o = (size_t)t * RW + h * 64 + 16 * nb + cc;
                const float val = (d[nb] * rstd * lg[nb] + lb[nb] + bon * bf2f(VSg[o])) * bf2f(GGg[o]);
                YC[(size_t)t * D_ + h * 64 + 16 * nb + cc] = (bf16)f2bf(val); }
        }
    }
    const int gw = F.vcu * NWAVES + F.wave, NGW = F.G * NWAVES;
    for (int t = gw; t < T_; t += NGW) {
        const float sc = 1.0f / sqrtf(ssqA[t] * (1.f / RW) + NORM_EPS);
        bf16* p = YC + (size_t)t * D_ + RW;
#pragma unroll
        for (int j = 0; j < 16; ++j) { const int c2 = j * 64 + l; p[c2] = (bf16)f2bf(bf2f(p[c2]) * sc * F.in[IN_ATTN_G][c2]); }
    }
}
constexpr int N_PHASES = 11;
#ifndef MK_FILLER_IN_CHAIN
#define MK_FILLER_IN_CHAIN 1
#endif
#ifndef MK_REPEAT_MASK
#define MK_REPEAT_MASK 0
#endif
constexpr int N_LAUNCHES = MK_N_LAUNCHES;
struct Args { const float* in[25]; float* out; unsigned char* ws; int ph_lo, ph_hi, li, pad; };
__global__ void __launch_bounds__(NWAVES * 64, 2) mk_fwd(Args args) {
    extern __shared__ __attribute__((aligned(16))) unsigned char lds[];
    Ctx F;
    F.lds = (LAS unsigned char*)lds;
    F.tid = threadIdx.x; F.lane = F.tid & 63; F.wave = __builtin_amdgcn_readfirstlane(F.tid >> 6);
    F.G = gridDim.x; { const int bx = blockIdx.x; F.vcu = (F.G % 8 == 0) ? (bx % 8) * (F.G / 8) + bx / 8 : bx; }
#pragma unroll
    for (int i = 0; i < 25; ++i) F.in[i] = args.in[i];
    F.out = args.out; F.ws = args.ws;
    volatile LAS unsigned* MISC = (volatile LAS unsigned*)(F.lds + MISC_OFF);
    for (int u = F.tid; u < (LDS_BYTES - LDSCTL_OFF) / 4; u += NWAVES * 64) ((LAS unsigned*)(F.lds + LDSCTL_OFF))[u] = 0u;
    __syncthreads();
    gu32* ctl = (gu32*)(F.ws + WS_CTL);
    XcdBarrier bar; bar.bar = (unsigned*)(ctl + CW_BAR); bar.x = 0; bar.st = nullptr;
    const int lo = args.ph_lo, hi = args.ph_hi;
    if (hi - lo > 1) bar = xcd_barrier_post((unsigned*)(ctl + CW_BAR), MISC + 8);
#define IN(k) (lo <= (k) && (k) < hi)
#define REPS(k) (1 + ((MK_REPEAT_MASK >> (k)) & 1))
#define SEAM(k) do { if (IN(k) && IN((k) + 1)) xcd_barrier(bar); } while (0)
    float* ssq = (float*)(F.ws + WS_CTL);
    bf16* HN = (bf16*)(F.ws + WS_HN); bf16* Z = (bf16*)(F.ws + WS_Z); bf16* H2 = (bf16*)(F.ws + WS_H2); bf16* ACT = (bf16*)(F.ws + WS_ACT);

    if (IN(0)) for (int rep = 0; rep < REPS(0); ++rep) { ph_prologue(F); } SEAM(0);
#define PH1() do {        pg8::Gemm g{HN, (const bf16*)(F.ws + WS_WIN), T_, NIN, D_, 0L, 256L * D_ * 2}; pg8::StaticOrder S; S.init(T_, NIN, F.G, (int)blockIdx.x); \
        pg8::EpiZ E{Z, NIN, (const float*)(F.ws + WS_MISC + MISC_BIAS)}; \
        pg8::gemm_phase<pg8::EpiZ, pg8::StaticOrder, true, true>(F.lds, g, S, E); \
} while (0)
    if (IN(1)) { PH1(); if (REPS(1) > 1) PH1(); } SEAM(1);
    if (IN(2)) { ph_attention_naive(F); } SEAM(2);
    if (IN(3)) for (int rep = 0; rep < REPS(3); ++rep) { ph_rwkv_prep_naive(F); } SEAM(3);
    if (IN(4)) for (int rep = 0; rep < REPS(4); ++rep) { ph_rwkv_chunk(F); } SEAM(4);
    if (IN(5)) for (int rep = 0; rep < REPS(5); ++rep) {
        if ((int)blockIdx.x < 64) ph_rwkv_chain(F, (int)blockIdx.x); else if (MK_FILLER_IN_CHAIN) ph_ffn_weights(F, ((int)blockIdx.x - 64) * NWAVES + F.wave, (F.G - 64) * NWAVES, 0);
    } SEAM(5);
    if (IN(6)) { ph_post_b(F); ph_ffn_weights(F, F.vcu * NWAVES + F.wave, F.G * NWAVES, MK_FILLER_IN_CHAIN ? 1 : 2); } SEAM(6);
    if (IN(7)) {
        pg8::Gemm g{HN, (const bf16*)(F.ws + WS_WOUT), T_, D_, D_, 0L, 256L * D_ * 2}; pg8::StaticOrder S; S.init(T_, D_, F.G, (int)blockIdx.x);
        pg8::EpiRes E{F.in[IN_X], F.out, D_, H2, F.in[IN_LN_FFN_G], ssq + CW_SSQ2};
        pg8::gemm_phase<pg8::EpiRes, pg8::StaticOrder, true, true>(F.lds, g, S, E);
    } SEAM(7);
#define PH8() do {        pg8::Gemm g{H2, (const bf16*)(F.ws + WS_WUG), T_, NUG, D_, -2L * D_ * 2, 254L * D_ * 2}; pg8::StaticOrder S; S.initT(33, NUG / 256, F.G, (int)blockIdx.x); \
        pg8::EpiUpGate E{ACT, ssq + CW_SSQ2, F.in[IN_CONV_W], F.in[IN_CONV_B], (LAS float*)(F.lds + XCH_OFF), T_, DFF, 1.0f / D_, NORM_EPS}; \
        pg8::gemm_phase<pg8::EpiUpGate, pg8::StaticOrder, true, true>(F.lds, g, S, E); \
} while (0)
    if (IN(8)) { PH8(); if (REPS(8) > 1) PH8(); } SEAM(8);
    if (IN(9)) {
        pg8::Gemm g{ACT, (const bf16*)(F.ws + WS_WDN), T_, D_, DFF, 0L, 256L * DFF * 2}; pg8::StaticOrder S; S.init(T_, D_, F.G, (int)blockIdx.x);
        pg8::EpiRes E{F.out, F.out, D_, nullptr, nullptr, ssq + CW_SSQ3};
        pg8::gemm_phase<pg8::EpiRes, pg8::StaticOrder, true, true>(F.lds, g, S, E);
    } SEAM(9);
    if (IN(10)) { ph_final(F); }
#undef IN
#undef SEAM
}

extern "C" void kernel_launch(void* const* d_in, const int* in_sizes, int n_in, void* d_out, int out_size, void* d_ws, size_t ws_size, hipStream_t stream) {
    static int grid = 0;
    if (grid == 0) {
        if (n_in != 25 || in_sizes[0] != T_ * D_ || out_size != T_ * D_ || ws_size < WS_END) { fprintf(stderr, "kernel_launch: unexpected shapes (n_in %d, in0 %d, out %d, ws %zu)\n", n_in, n_in > 0 ? in_sizes[0] : -1, out_size, ws_size); grid = -1; return; }
        int dev = 0, cus = 0;
        if (hipGetDevice(&dev) != hipSuccess || hipDeviceGetAttribute(&cus, hipDeviceAttributeMultiprocessorCount, dev) != hipSuccess) { grid = -1; return; }
        if (hipFuncSetAttribute((const void*)mk_fwd, hipFuncAttributeMaxDynamicSharedMemorySize, LDS_BYTES) != hipSuccess) { fprintf(stderr, "kernel_launch: hipFuncSetAttribute failed\n"); grid = -1; return; }
        (void)hipGetLastError();
        grid = cus;
    }
    if (grid < 0) return;
    if (hipMemsetAsync((char*)d_ws + WS_CTL, 0, CTL_ZERO_BYTES, stream) != hipSuccess) return;
    Args a{};
    for (int i = 0; i < 25; ++i) a.in[i] = (const float*)d_in[i];
    a.out = (float*)d_out; a.ws = (unsigned char*)d_ws;
    if (N_LAUNCHES == 1) { a.ph_lo = 0; a.ph_hi = N_PHASES; a.li = 0; hipLaunchKernelGGL(mk_fwd, dim3(grid), dim3(NWAVES * 64), LDS_BYTES, stream, a); }
    else for (int ph = 0; ph < N_PHASES; ++ph) { a.ph_lo = ph; a.ph_hi = ph + 1; a.li = 0; hipLaunchKernelGGL(mk_fwd, dim3(grid), dim3(NWAVES * 64), LDS_BYTES, stream, a); }
}
```

```cpp
#include <hip/hip_runtime.h>
#include <cstdio>
#include <cstdint>
#define MK_N_LAUNCHES 1
#define MK_REPEAT_MASK 0
#define MK_FILLER_IN_CHAIN 1
#define MK_TS 0
namespace pg8 {
#define PG8_LAS __attribute__((address_space(3)))
typedef unsigned short bf16_t;
typedef short bf16x8 __attribute__((ext_vector_type(8)));
typedef float f32x4 __attribute__((ext_vector_type(4)));
typedef unsigned u32x4 __attribute__((ext_vector_type(4)));
constexpr int BM = 256, BK = 64, HALF = 128, HTB = HALF * BK * 2  , STAGE_BYTES = 8 * HTB, NXCD = 8, WGM = 8;

__host__ __device__ __forceinline__ int lds_byte(int r, int c) { const int st = (r >> 4) * 2 + (c >> 5), rr = r & 15, cc = c & 31, ob = rr * 64 + cc * 2; return st * 1024 + (ob ^ (((ob >> 9) & 1) << 5)); }
__host__ __device__ __forceinline__ void stage_rc(int b, int& R, int& C) { const int st = b / 1024, sb = b % 1024, swz = sb ^ (((sb >> 9) & 1) << 5); R = (st >> 1) * 16 + swz / 64; C = (st & 1) * 32 + (swz % 64) / 2; }
__host__ __device__ __forceinline__ int perm32(int rho) { const int n = rho >> 4, i = rho & 15; return 8 * (i >> 2) + 4 * n + (i & 3); }

struct Unit { int pm, pn; };
struct Gemm { const bf16_t* A; const bf16_t* Bt; int M, N, K; long a_off, a_tstep; };

struct StaticOrder {
    int nM, nN, nwg, G, c;
    __host__ __device__ void init(int M, int N, int G_, int c_) { nM = M / BM; nN = N / BM; nwg = nM * nN; G = G_; c = c_; }
    __host__ __device__ void initT(int nM_, int nN_, int G_, int c_) { nM = nM_; nN = nN_; nwg = nM * nN; G = G_; c = c_; }
    __host__ __device__ bool next(int i, Unit& u) const {
        const long L = (long)i * G + c; if (L >= nwg) return false;
        int wgid = (int)L; { const int q = nwg / NXCD, r = nwg % NXCD, xcd = wgid % NXCD, off = wgid / NXCD; wgid = (xcd < r ? xcd * (q + 1) : r * (q + 1) + (xcd - r) * q) + off; }
        const int nig = WGM * nN, gid = wgid / nig, fm = gid * WGM, gsz = (nM - fm) < WGM ? (nM - fm) : WGM;
        u.pm = fm + ((wgid % nig) % gsz); u.pn = (wgid % nig) / gsz; return true;
    }
    __device__ __forceinline__ void a_ready(const Unit&) const {}
    __device__ __forceinline__ void done(const Unit&) const {}
};

__device__ __forceinline__ unsigned cvt_pk_bf16(float lo, float hi) { unsigned r; asm volatile("v_cvt_pk_bf16_f32 %0, %1, %2" : "=v"(r) : "v"(lo), "v"(hi)); return r; }
typedef unsigned u32x2 __attribute__((ext_vector_type(2)));

struct EpiZ {
    static constexpr bool PERM = true, AFTER_DRAIN = false;
    bf16_t* O; int ldc; const float* bias;
    __device__ __forceinline__ void operator()(const f32x4 (&acc)[2][2][4][2], const Unit& u, int wr, int wc, int fr, int fq) const {
        const int row0 = u.pm * BM + wr * 64 + fr; const int col0 = u.pn * BM + wc * 32 + 8 * fq;
        f32x4 bv[2][2];
#pragma unroll
        for (int bj = 0; bj < 2; ++bj)
#pragma unroll
            for (int n = 0; n < 2; ++n) bv[bj][n] = *(const f32x4*)(bias + col0 + bj * HALF + 4 * n);
#pragma unroll
        for (int ai = 0; ai < 2; ++ai)
#pragma unroll
            for (int m = 0; m < 4; ++m) { bf16_t* rowp = O + (size_t)(row0 + ai * HALF + m * 16) * ldc + col0;
#pragma unroll
                for (int bj = 0; bj < 2; ++bj) { const f32x4 v0 = acc[ai][bj][m][0] + bv[bj][0], v1 = acc[ai][bj][m][1] + bv[bj][1];
                    u32x4 w; w.x = cvt_pk_bf16(v0[0], v0[1]); w.y = cvt_pk_bf16(v0[2], v0[3]); w.z = cvt_pk_bf16(v1[0], v1[1]); w.w = cvt_pk_bf16(v1[2], v1[3]);
                    *(u32x4*)(rowp + bj * HALF) = w; } }
    }
};
struct EpiRes {
    static constexpr bool PERM = false, AFTER_DRAIN = false;
    const float* base; float* out; int ldc; bf16_t* hb; const float* gain; float* ssq;
    __device__ __forceinline__ void operator()(const f32x4 (&acc)[2][2][4][2], const Unit& u, int wr, int wc, int fr, int fq) const {
        const int row0 = u.pm * BM + wr * 64 + fr, col0 = u.pn * BM + wc * 32 + 4 * fq;
        f32x4 gv[2][2];
#pragma unroll
        for (int bj = 0; bj < 2; ++bj)
#pragma unroll
            for (int n = 0; n < 2; ++n) gv[bj][n] = hb ? *(const f32x4*)(gain + col0 + bj * HALF + n * 16) : (f32x4){0.f, 0.f, 0.f, 0.f};
#pragma unroll
        for (int ai = 0; ai < 2; ++ai)
#pragma unroll
            for (int m = 0; m < 4; ++m) { const int row = row0 + ai * HALF + m * 16; const size_t off = (size_t)row * ldc + col0; float q = 0.f;
#pragma unroll
                for (int bj = 0; bj < 2; ++bj)
#pragma unroll
                    for (int n = 0; n < 2; ++n) { const f32x4 x1 = *(const f32x4*)(base + off + bj * HALF + n * 16) + acc[ai][bj][m][n];
                        *(f32x4*)(out + off + bj * HALF + n * 16) = x1; q += (x1[0] * x1[0] + x1[1] * x1[1]) + (x1[2] * x1[2] + x1[3] * x1[3]);
                        if (hb) { const f32x4 h = x1 * gv[bj][n]; u32x2 w; w.x = cvt_pk_bf16(h[0], h[1]); w.y = cvt_pk_bf16(h[2], h[3]); *(u32x2*)(hb + off + bj * HALF + n * 16) = w; } }
                q += __shfl_xor(q, 16); q += __shfl_xor(q, 32);
                if (fq == 0) atomicAdd(ssq + row, q); }
    }
};
struct EpiUpGate {
    static constexpr bool PERM = true, AFTER_DRAIN = false;
    bf16_t* act; const float* ssq; const float* cw; const float* cb; PG8_LAS float* xch; int T, F; float invD, eps;
    __device__ __forceinline__ void operator()(const f32x4 (&acc)[2][2][4][2], const Unit& u, int wr, int wc, int fr, int fq) const {
        const int lane = fr + 16 * fq, wid = wr * 4 + wc;
        const int trow0 = 254 * u.pm - 2, f0 = 128 * u.pn + wc * 32 + 8 * fq;
        f32x4 uu[2][4][2], gg[2][4][2];
#pragma unroll
        for (int ai = 0; ai < 2; ++ai)
#pragma unroll
            for (int m = 0; m < 4; ++m) { const int t = trow0 + ai * HALF + wr * 64 + m * 16 + fr; float s = 0.f;
                if (t >= 0 && t < T) s = __builtin_amdgcn_rsqf(ssq[t] * invD + eps);
#pragma unroll
                for (int n = 0; n < 2; ++n) { uu[ai][m][n] = acc[ai][0][m][n] * s; gg[ai][m][n] = acc[ai][1][m][n] * s; } }
        if (fr >= 14) {
#pragma unroll
            for (int ai = 0; ai < 2; ++ai)
#pragma unroll
                for (int n = 0; n < 2; ++n) *(PG8_LAS f32x4*)(xch + ((((wid * 2 + ai) * 2 + (fr - 14)) * 4 + fq) * 2 + n) * 4) = uu[ai][3][n];
        }
        asm volatile("s_waitcnt lgkmcnt(0)" ::: "memory"); __builtin_amdgcn_s_barrier(); asm volatile("" ::: "memory");
        f32x4 pg[2][2];
#pragma unroll
        for (int ai = 0; ai < 2; ++ai)
#pragma unroll
            for (int n = 0; n < 2; ++n) { pg[ai][n] = (f32x4){0.f, 0.f, 0.f, 0.f};
                const int swid = wr ? wid - 4 : wid + 4, sai = wr ? ai : ai - 1;
                if (fr >= 14 && sai >= 0) pg[ai][n] = *(const PG8_LAS f32x4*)(xch + ((((swid * 2 + sai) * 2 + (fr - 14)) * 4 + fq) * 2 + n) * 4); }
        f32x4 w0[2], w1[2], w2[2], bb[2];
#pragma unroll
        for (int n = 0; n < 2; ++n) { w0[n] = *(const f32x4*)(cw + f0 + 4 * n); w1[n] = *(const f32x4*)(cw + F + f0 + 4 * n); w2[n] = *(const f32x4*)(cw + 2 * F + f0 + 4 * n); bb[n] = *(const f32x4*)(cb + f0 + 4 * n); }
        const int src1 = (lane & ~15) | ((lane - 1) & 15), src2 = (lane & ~15) | ((lane - 2) & 15);
#pragma unroll
        for (int ai = 0; ai < 2; ++ai)
#pragma unroll
            for (int m = 0; m < 4; ++m) { const int r = ai * HALF + wr * 64 + m * 16 + fr, t = trow0 + r; f32x4 o[2];
#pragma unroll
                for (int n = 0; n < 2; ++n) { const f32x4 U = uu[ai][m][n], PG = (m == 0) ? pg[ai][n] : uu[ai][m == 0 ? 0 : m - 1][n];
#pragma unroll
                    for (int c = 0; c < 4; ++c) { const float s1 = (fr == 15) ? PG[c] : U[c], s2 = (fr >= 14) ? PG[c] : U[c];
                        const float p1 = __shfl(s1, src1), p2 = __shfl(s2, src2);
                        const float cv = bb[n][c] + w2[n][c] * U[c] + w1[n][c] * p1 + w0[n][c] * p2;
                        const float sg = cv * __builtin_amdgcn_rcpf(1.0f + __expf(-cv));
                        o[n][c] = sg * gg[ai][m][n][c]; } }
                if (r >= 2 && t < T) { u32x4 w; w.x = cvt_pk_bf16(o[0][0], o[0][1]); w.y = cvt_pk_bf16(o[0][2], o[0][3]); w.z = cvt_pk_bf16(o[1][0], o[1][1]); w.w = cvt_pk_bf16(o[1][2], o[1][3]);
                    *(u32x4*)(act + (size_t)t * F + f0) = w; } }
    }
};
template <class Epi, class Sched, bool ALIGN_EPI = false, bool SP2 = false>
__device__ __forceinline__ void gemm_phase(PG8_LAS unsigned char* lds, const Gemm g, const Sched& S, const Epi& E, const int wid) {
    int lane; asm volatile("v_mbcnt_lo_u32_b32 %0, -1, 0\n\tv_mbcnt_hi_u32_b32 %0, -1, %0" : "=v"(lane)); const int tid = wid * 64 + lane, wr = wid >> 2, wc = wid & 3, fr = lane & 15, fq = lane >> 4;
    const int K = g.K, nt = K / BK;
    unsigned voffA[2], voffB[2];
#pragma unroll
    for (int i = 0; i < 2; ++i) { int R, C; stage_rc(tid * 16 + i * 8192, R, C); const int Rb = Epi::PERM ? ((R & ~31) + perm32(R & 31)) : R;
        voffA[i] = (unsigned)(R * K + C) * 2u; voffB[i] = (unsigned)(Rb * K + C) * 2u; }
    const size_t kstep = (size_t)(BK * 2);
    const size_t hstep = (size_t)HALF * K * 2;
    const size_t tstep = 2 * hstep;
    const unsigned ldsw = (unsigned)wid * 1024u;
    const int aoff = lds_byte(wr * 64 + fr, fq * 8), boff = lds_byte(wc * 32 + fr, fq * 8);
#define PG8_SA(b, h) (((b) * 2 + (h)) * HTB)
#define PG8_SB(b, h) ((4 + (b) * 2 + (h)) * HTB)
#define PG8_STAGE(bufoff, gbase, voff) do { _Pragma("unroll") for (int _i = 0; _i < 2; ++_i) \
        __builtin_amdgcn_global_load_lds((const unsigned*)((const char*)(gbase) + (voff)[_i]), (PG8_LAS unsigned*)(lds + (bufoff) + ldsw + _i * 8192), 16, 0, 0); } while (0)
#define PG8_LDA(dst, b, h) do { _Pragma("unroll") for (int m = 0; m < 4; ++m) _Pragma("unroll") for (int k = 0; k < 2; ++k) dst[m][k] = *(const PG8_LAS bf16x8*)(lds + PG8_SA(b, h) + aoff + m * 2048 + k * 1024); } while (0)
#define PG8_LDB(dst, b, h) do { _Pragma("unroll") for (int n = 0; n < 2; ++n) _Pragma("unroll") for (int k = 0; k < 2; ++k) dst[n][k] = *(const PG8_LAS bf16x8*)(lds + PG8_SB(b, h) + boff + n * 2048 + k * 1024); } while (0)
#define PG8_MMA(ai, bj, At, Bt) do { __builtin_amdgcn_s_setprio(1); _Pragma("unroll") for (int m = 0; m < 4; ++m) _Pragma("unroll") for (int n = 0; n < 2; ++n) _Pragma("unroll") for (int k = 0; k < 2; ++k) \
        acc[ai][bj][m][n] = __builtin_amdgcn_mfma_f32_16x16x32_bf16(Bt[n][k], At[m][k], acc[ai][bj][m][n], 0, 0, 0); __builtin_amdgcn_s_setprio(0); } while (0)
#define PG8_WAIT_V(n) asm volatile("s_waitcnt vmcnt(" #n ")" ::: "memory")
#define PG8_WAIT_L(n) asm volatile("s_waitcnt lgkmcnt(" #n ")" ::: "memory")
#define PG8_BAR __builtin_amdgcn_s_barrier()
#define PG8_SCHED __builtin_amdgcn_sched_barrier(0)
    Unit cur, nxt; int ui = 0;
    if (!S.next(0, cur)) return;
    f32x4 acc[2][2][4][2];
#pragma unroll
    for (int a = 0; a < 2; ++a)
#pragma unroll
        for (int b = 0; b < 2; ++b)
#pragma unroll
            for (int m = 0; m < 4; ++m)
#pragma unroll
                for (int n = 0; n < 2; ++n) acc[a][b][m][n] = (f32x4){0.f, 0.f, 0.f, 0.f};
    bf16x8 At[4][2], B0[2][2], B1[2][2];
    const char* cA = (const char*)g.A + g.a_off + (long)cur.pm * g.a_tstep; const char* cB = (const char*)g.Bt + (size_t)cur.pn * tstep;
    S.a_ready(cur);
    if constexpr (SP2) {
        PG8_STAGE(PG8_SB(0, 0), cB, voffB); PG8_STAGE(PG8_SB(0, 1), cB + hstep, voffB); PG8_STAGE(PG8_SA(0, 0), cA, voffA); PG8_STAGE(PG8_SA(0, 1), cA + hstep, voffA);
        if (wr == 1) PG8_BAR;
        PG8_WAIT_V(2); PG8_BAR;
        PG8_STAGE(PG8_SB(1, 0), cB + kstep, voffB); PG8_STAGE(PG8_SA(1, 0), cA + kstep, voffA); PG8_STAGE(PG8_SB(1, 1), cB + hstep + kstep, voffB);
        PG8_WAIT_V(6); PG8_BAR;
    } else {
        PG8_STAGE(PG8_SB(0, 0), cB, voffB); PG8_STAGE(PG8_SA(0, 0), cA, voffA); PG8_STAGE(PG8_SB(0, 1), cB + hstep, voffB); PG8_STAGE(PG8_SA(0, 1), cA + hstep, voffA);
        if (wr == 1) PG8_BAR;
        PG8_WAIT_V(4); PG8_BAR;
        PG8_STAGE(PG8_SB(1, 0), cB + kstep, voffB); PG8_STAGE(PG8_SA(1, 0), cA + kstep, voffA); PG8_STAGE(PG8_SB(1, 1), cB + hstep + kstep, voffB);
        PG8_WAIT_V(6); PG8_BAR;
    }
    for (;;) {
        const bool has_next = S.next(ui + 1, nxt);
        const char* nA = has_next ? (const char*)g.A + g.a_off + (long)nxt.pm * g.a_tstep : cA; const char* nB = has_next ? (const char*)g.Bt + (size_t)nxt.pn * tstep : cB;
        for (int t = 0; t < nt; t += 2) {
            const bool last = (t == nt - 2);
            const char* a1 = cA + (size_t)(t + 1) * kstep;
            const char* a2 = last ? nA : cA + (size_t)(t + 2) * kstep; const char* b2 = last ? nB : cB + (size_t)(t + 2) * kstep;
            const char* a3 = a2 + kstep; const char* b3 = b2 + kstep;
            if (last && has_next) S.a_ready(nxt);
            if constexpr (SP2) {
            PG8_LDB(B0, 0, 0); PG8_LDB(B1, 0, 1); PG8_SCHED; PG8_LDA(At, 0, 0); PG8_STAGE(PG8_SA(1, 1), a1 + hstep, voffA);
            PG8_WAIT_V(8); PG8_WAIT_L(0); PG8_BAR; PG8_MMA(0, 0, At, B0); PG8_MMA(0, 1, At, B1); PG8_BAR; PG8_SCHED;
            PG8_LDA(At, 0, 1); PG8_STAGE(PG8_SB(0, 0), b2, voffB); PG8_STAGE(PG8_SB(0, 1), b2 + hstep, voffB); PG8_STAGE(PG8_SA(0, 0), a2, voffA);
            PG8_WAIT_V(8); PG8_WAIT_L(0); PG8_BAR; PG8_MMA(1, 0, At, B0); PG8_MMA(1, 1, At, B1); PG8_BAR; PG8_SCHED;
            PG8_LDB(B0, 1, 0); PG8_LDB(B1, 1, 1); PG8_SCHED; PG8_LDA(At, 1, 0); PG8_STAGE(PG8_SA(0, 1), a2 + hstep, voffA);
            PG8_WAIT_V(8); PG8_WAIT_L(0); PG8_BAR; PG8_MMA(0, 0, At, B0); PG8_MMA(0, 1, At, B1); PG8_BAR; PG8_SCHED;
            PG8_LDA(At, 1, 1); PG8_STAGE(PG8_SB(1, 0), b3, voffB); PG8_STAGE(PG8_SB(1, 1), b3 + hstep, voffB); PG8_STAGE(PG8_SA(1, 0), a3, voffA);
            PG8_WAIT_V(8); PG8_WAIT_L(0); PG8_BAR; PG8_MMA(1, 0, At, B0); PG8_MMA(1, 1, At, B1); PG8_BAR; PG8_SCHED;
            } else {
            PG8_LDB(B0, 0, 0); PG8_SCHED; PG8_LDA(At, 0, 0); PG8_STAGE(PG8_SA(1, 1), a1 + hstep, voffA);
            PG8_WAIT_L(8); PG8_BAR; PG8_WAIT_L(0); PG8_MMA(0, 0, At, B0); PG8_BAR; PG8_SCHED;
            PG8_LDB(B1, 0, 1); PG8_STAGE(PG8_SB(0, 0), b2, voffB);
            PG8_BAR; PG8_WAIT_L(0); PG8_MMA(0, 1, At, B1); PG8_BAR;
            PG8_LDA(At, 0, 1); PG8_STAGE(PG8_SA(0, 0), a2, voffA);
            PG8_BAR; PG8_WAIT_L(0); PG8_MMA(1, 0, At, B0); PG8_BAR; PG8_SCHED;
            PG8_STAGE(PG8_SB(0, 1), b2 + hstep, voffB);
            PG8_WAIT_V(6); PG8_BAR; PG8_MMA(1, 1, At, B1); PG8_BAR;
            PG8_LDB(B0, 1, 0); PG8_SCHED; PG8_LDA(At, 1, 0); PG8_STAGE(PG8_SA(0, 1), a2 + hstep, voffA);
            PG8_WAIT_L(8); PG8_BAR; PG8_WAIT_L(0); PG8_MMA(0, 0, At, B0); PG8_BAR; PG8_SCHED;
            PG8_LDB(B1, 1, 1); PG8_STAGE(PG8_SB(1, 0), b3, voffB);
            PG8_BAR; PG8_WAIT_L(0); PG8_MMA(0, 1, At, B1); PG8_BAR;
            PG8_LDA(At, 1, 1); PG8_STAGE(PG8_SA(1, 0), a3, voffA);
            PG8_BAR; PG8_WAIT_L(0); PG8_MMA(1, 0, At, B0); PG8_BAR; PG8_SCHED;
            PG8_STAGE(PG8_SB(1, 1), b3 + hstep, voffB);
            PG8_WAIT_V(6); PG8_BAR; PG8_MMA(1, 1, At, B1); PG8_BAR;
            }
        }
        if constexpr (ALIGN_EPI) { if (wr == 0) PG8_BAR; }
        if constexpr (!Epi::AFTER_DRAIN) { E(acc, cur, wr, wc, fr, fq); S.done(cur); }
        if (!has_next) break;
#pragma unroll
        for (int a = 0; a < 2; ++a)
#pragma unroll
            for (int b = 0; b < 2; ++b)
#pragma unroll
                for (int m = 0; m < 4; ++m)
#pragma unroll
                    for (int n = 0; n < 2; ++n) acc[a][b][m][n] = (f32x4){0.f, 0.f, 0.f, 0.f};
        cur = nxt; cA = nA; cB = nB; ++ui;
        if constexpr (ALIGN_EPI) { if (wr == 1) PG8_BAR; }
    }
    PG8_WAIT_V(0);
    if constexpr (!ALIGN_EPI) { if (wr == 0) PG8_BAR; }
    PG8_BAR;
    if constexpr (Epi::AFTER_DRAIN) { E.fused(acc, cur, wr, wc, fr, fq, lds, wid, lane); S.done(cur); }
#undef PG8_SA
#undef PG8_SB
#undef PG8_STAGE
#undef PG8_LDA
#undef PG8_LDB
#undef PG8_MMA
#undef PG8_WAIT_V
#undef PG8_WAIT_L
#undef PG8_BAR
#undef PG8_SCHED
}
}
constexpr int NWAVES = 8;
#ifndef MK_TS
#define MK_TS 0
#endif
#ifndef MK_N_LAUNCHES
#define MK_N_LAUNCHES 1
#endif
constexpr int T_ = 8192, D_ = 2048, INW = 4640, NIN = 4864, RW = 1024, NH = 16, HD = 64, DFF = 5632, NUG = 2 * DFF;
constexpr int COL_R = 0, COL_K = 1024, COL_V = 2048, COL_XW = 3072, COL_XA = 3136, COL_XG = 3200, COL_Q = 3360, COL_KA = 4384, COL_VA = 4512, RIN = 3360;
constexpr float NORM_EPS = 1e-5f, LNX_EPS = 64e-5f;
constexpr size_t MiB = 1u << 20;
constexpr size_t WS_CTL = 0, CTL_ZERO_BYTES = 1 * MiB;
constexpr size_t WS_WIN = 1 * MiB, WS_WOUT = 20 * MiB, WS_HN = 28 * MiB, WS_Z = 61 * MiB, WS_GG = 169 * MiB, WS_MISC = 253 * MiB, WS_END = 256 * MiB;
constexpr size_t WS_WUG = 185 * MiB, WS_WDN = 229 * MiB, WS_ACT = 96 * MiB, WS_H2 = 62 * MiB;
constexpr size_t MISC_BIAS = 0, MISC_ROPE = 64 * 1024, MISC_BON = 1 * MiB;
constexpr int CW_BAR = 4096;
constexpr int CW_SSQA = 65536, CW_SSQ2 = CW_SSQA + T_, CW_SSQ3 = CW_SSQ2 + T_;
static_assert((CW_SSQ3 + T_) * 4 <= (int)CTL_ZERO_BYTES, "ctl");
constexpr int RING_BYTES = 131072, XCH_OFF = RING_BYTES, LDSCTL_OFF = RING_BYTES + 4096, MISC_OFF = LDSCTL_OFF + 320, LDS_BYTES = 147456;

#define GAS __attribute__((address_space(1)))
#define LAS __attribute__((address_space(3)))
typedef unsigned short bf16;
typedef unsigned v4u __attribute__((ext_vector_type(4)));
typedef float f32x4 __attribute__((ext_vector_type(4)));
typedef GAS unsigned gu32;
#define RLX_AGENT __ATOMIC_RELAXED, __HIP_MEMORY_SCOPE_AGENT
#define LDS_WAIT() asm volatile("s_waitcnt lgkmcnt(0)" ::: "memory")
__device__ __forceinline__ unsigned f2bf(float f) { unsigned u = __builtin_bit_cast(unsigned, f); return (u + 0x7fffu + ((u >> 16) & 1u)) >> 16; }
typedef float f32x2_t __attribute__((ext_vector_type(2))); typedef __bf16 bf16x2_t __attribute__((ext_vector_type(2)));
__device__ __forceinline__ unsigned pk2(float lo, float hi) { f32x2_t v = {lo, hi}; bf16x2_t b = __builtin_convertvector(v, bf16x2_t); return __builtin_bit_cast(unsigned, b); }
__device__ __forceinline__ float bf2f(unsigned h) { return __builtin_bit_cast(float, h << 16); }
__device__ __forceinline__ int lane_v() { int l; asm volatile("v_mbcnt_lo_u32_b32 %0, -1, 0\n\tv_mbcnt_hi_u32_b32 %0, -1, %0" : "=v"(l)); return l; }
__device__ __forceinline__ float wave_sum(float v) {
#pragma unroll
    for (int o = 1; o < 64; o <<= 1) v += __shfl_xor(v, o);
    return v;
}
struct Args { const float* in[25]; float* out; unsigned char* ws; int ph_lo, ph_hi, li, pad; };
#define XB_TMO      128
#define XB_XCNT(j)  (256  + 64 * (j))
#define XB_XSUB(j)  (1280 + 64 * (j))
#define XB_XGEN(j)  (2304 + 64 * (j))
#define XB_TOP      3328
#define XB_TOPGEN   3392
#define XCD_BAR_WORDS 3456
#define XB_SPIN_CAP (1u << 18)

__device__ __forceinline__ unsigned xb_ld(unsigned* p)              { return __hip_atomic_load(p, __ATOMIC_RELAXED, __HIP_MEMORY_SCOPE_AGENT); }
__device__ __forceinline__ unsigned xb_add(unsigned* p, unsigned v) { return __hip_atomic_fetch_add(p, v, __ATOMIC_RELAXED, __HIP_MEMORY_SCOPE_AGENT); }
__device__ __forceinline__ unsigned xb_xcc_id() { return (unsigned)__builtin_amdgcn_s_getreg((3 << 11) | 20) & 0xFu; }
#define XB_SPIN(cond, bar) do { unsigned _sp = 0; while (cond) { __builtin_amdgcn_s_sleep(1); \
    if ((++_sp & 255u) == 0u) { if (xb_ld(&(bar)[XB_TMO])) break; if (_sp > XB_SPIN_CAP) { atomicAdd(&(bar)[XB_TMO], 1u); break; } } } } while (0)

struct XcdBarrier {
    unsigned* bar; unsigned x;
    volatile LAS unsigned* st;
};

__device__ __forceinline__ XcdBarrier xcd_barrier_post(unsigned* bar, volatile LAS unsigned* st, bool leader) {
    XcdBarrier b; b.bar = bar; b.x = xb_xcc_id(); b.st = st;
    if (leader) (void)xb_add(&bar[XB_XCNT(b.x)], 1u);
    return b;
}
__device__ __forceinline__ void xcd_barrier_complete(unsigned* bar, unsigned x, unsigned& nloc, unsigned& nx) {
    const unsigned G = gridDim.x * gridDim.y * gridDim.z;
    unsigned sum, cnt, mine, sp = 0u;
    for (;;) {
        sum = 0u; cnt = 0u; mine = 0u;
#pragma unroll
        for (unsigned j = 0; j < 16; ++j) { const unsigned c = xb_ld(&bar[XB_XCNT(j)]); sum += c; cnt += (c > 0u) ? 1u : 0u; mine = (j == x) ? c : mine; }
        if (sum == G) break;
        __builtin_amdgcn_s_sleep(1);
        if ((++sp & 255u) == 0u) { if (xb_ld(&bar[XB_TMO])) break; if (sp > XB_SPIN_CAP) { atomicAdd(&bar[XB_TMO], 1u); break; } }
    }
    nloc = mine > 0u ? mine : 1u; nx = cnt > 0u ? cnt : 1u;
}

__device__ __forceinline__ void xcd_barrier(const XcdBarrier& b, bool leader) {
    asm volatile("s_waitcnt vmcnt(0)" ::: "memory");
    __syncthreads();
    if (leader) {
        unsigned* bar = b.bar;
        __builtin_amdgcn_s_waitcnt(0);
        unsigned nloc = b.st[0], nx = b.st[1];
        if (nloc == 0u) { xcd_barrier_complete(bar, b.x, nloc, nx); b.st[0] = nloc; b.st[1] = nx; }
        const unsigned old = xb_add(&bar[XB_XSUB(b.x)], 1u);
        const unsigned gen = old / nloc;
        if (old + 1u == (gen + 1u) * nloc) {
            __builtin_amdgcn_fence(__ATOMIC_RELEASE, "agent");
            asm volatile("s_waitcnt vmcnt(0)" ::: "memory");
            const unsigned og = xb_add(&bar[XB_TOP], 1u);
            const unsigned tg = og / nx;
            if (og + 1u == (tg + 1u) * nx) xb_add(&bar[XB_TOPGEN], 1u);
            else XB_SPIN(xb_ld(&bar[XB_TOPGEN]) == tg, bar);
            __builtin_amdgcn_fence(__ATOMIC_ACQUIRE, "agent");
            xb_add(&bar[XB_XGEN(b.x)], 1u);
            asm volatile("s_waitcnt vmcnt(0)" ::: "memory");
        } else {
            XB_SPIN(xb_ld(&bar[XB_XGEN(b.x)]) == gen, bar);
            __builtin_amdgcn_fence(__ATOMIC_ACQUIRE, "agent");
            asm volatile("s_waitcnt vmcnt(0)" ::: "memory");
        }
    }
    __syncthreads();
}
typedef short bf16x8 __attribute__((ext_vector_type(8)));
typedef unsigned u32x2v __attribute__((ext_vector_type(2)));
__device__ __forceinline__ f32x4 mfma16(bf16x8 a, bf16x8 b, f32x4 c) { return __builtin_amdgcn_mfma_f32_16x16x32_bf16(a, b, c, 0, 0, 0); }
__device__ __forceinline__ bf16x8 ld128(const LAS unsigned char* p) { return *(const LAS bf16x8*)p; }
__device__ __forceinline__ u32x2v ld64(const LAS unsigned char* p) { return *(const LAS u32x2v*)p; }
__device__ __forceinline__ u32x2v pack4(f32x4 v) { u32x2v r; r.x = pk2(v[0], v[1]); r.y = pk2(v[2], v[3]); return r; }
__device__ __forceinline__ f32x4 unpack4(u32x2v w) { return (f32x4){bf2f(w.x & 0xffffu), bf2f(w.x >> 16), bf2f(w.y & 0xffffu), bf2f(w.y >> 16)}; }
__device__ __forceinline__ bf16x8 cat8(u32x2v lo, u32x2v hi) { v4u t; t.x = lo.x; t.y = lo.y; t.z = hi.x; t.w = hi.y; return __builtin_bit_cast(bf16x8, t); }

struct Ctx {
    LAS unsigned char* lds; int wave, vcu, G;
    float* out; unsigned char* ws;
};
#define IN_X 0
#define IN_LN_MIX_G 1
#define IN_W_IN 2
#define IN_B_ATTN 3
#define IN_MU 4
#define IN_W0 5
#define IN_W2 6
#define IN_A0 7
#define IN_A2 8
#define IN_G2 9
#define IN_K_K 10
#define IN_K_A 11
#define IN_R_K 12
#define IN_LNX_G 13
#define IN_LNX_B 14
#define IN_SINKS 15
#define IN_ATTN_G 16
#define IN_W_OUT 17
#define IN_LN_FFN_G 18
#define IN_W_UP 19
#define IN_W_GATE 20
#define IN_CONV_W 21
#define IN_CONV_B 22
#define IN_W_DOWN 23
#define IN_LN_FINAL_G 24

__device__ __forceinline__ void transpose_item(const float* W, int K, int N, bf16* WT, int drow0, LAS float* scr, int k0, int n0, int lane) {
#pragma unroll 8
    for (int i = 0; i < 32; ++i) { const int kk = 2 * i + (lane >> 5); scr[kk * 33 + (lane & 31)] = W[(size_t)(k0 + kk) * N + n0 + (lane & 31)]; }
    LDS_WAIT(); asm volatile("" ::: "memory");
    const int c = lane & 7;
#pragma unroll
    for (int j = 0; j < 4; ++j) { const int n = (lane >> 3) + 8 * j; const LAS float* s = scr + (8 * c) * 33 + n;
        v4u o; o.x = pk2(s[0 * 33], s[1 * 33]); o.y = pk2(s[2 * 33], s[3 * 33]); o.z = pk2(s[4 * 33], s[5 * 33]); o.w = pk2(s[6 * 33], s[7 * 33]);
        *(GAS v4u*)(WT + (size_t)(drow0 + n) * K + k0 + 8 * c) = o; }
    LDS_WAIT(); asm volatile("" ::: "memory");
}
__device__ __forceinline__ void rms_row_to_bf16(const float* xrow, const float* g, bf16* orow, int lane) {
    const GAS f32x4* xr = (const GAS f32x4*)xrow + lane; const GAS f32x4* gr = (const GAS f32x4*)g + lane;
    f32x4 v[8]; float s = 0.f;
#pragma unroll
    for (int j = 0; j < 8; ++j) { v[j] = xr[64 * j]; s += (v[j].x * v[j].x + v[j].y * v[j].y) + (v[j].z * v[j].z + v[j].w * v[j].w); }
    const float rs = 1.0f / sqrtf(wave_sum(s) * (1.f / D_) + NORM_EPS);
    GAS unsigned long long* o8 = (GAS unsigned long long*)orow + lane;
#pragma unroll
    for (int j = 0; j < 8; ++j) { const f32x4 gg = gr[64 * j]; o8[64 * j] = (unsigned long long)pk2(v[j].x * rs * gg.x, v[j].y * rs * gg.y) | ((unsigned long long)pk2(v[j].z * rs * gg.z, v[j].w * rs * gg.w) << 32); }
}

__device__ __forceinline__ void ph_prologue(Ctx& F, const Args& A) {
    const int F_lane = lane_v(), F_tid = F.wave * 64 + F_lane; (void)F_tid;
    LAS float* scr = (LAS float*)(F.lds + F.wave * 16384);
    const int gw = F.vcu * NWAVES + F.wave, NGW = F.G * NWAVES, gt = gw * 64 + F_lane, NGT = NGW * 64;
    bf16* WIN = (bf16*)(F.ws + WS_WIN); bf16* WOUT = (bf16*)(F.ws + WS_WOUT); bf16* HN = (bf16*)(F.ws + WS_HN);
    constexpr int I_IN = (D_ / 64) * (INW / 32), I_OUT = (D_ / 64) * (D_ / 32);
    for (int it = gw; it < I_IN + I_OUT; it += NGW) {
        if (it < I_IN) { const int nblk = INW / 32, kb = it / nblk, nb = it % nblk; transpose_item(A.in[IN_W_IN], D_, INW, WIN, 32 * nb, scr, 64 * kb, 32 * nb, F_lane); }
        else { const int r = it - I_IN, nblk = D_ / 32, kb = r / nblk, nb = r % nblk; transpose_item(A.in[IN_W_OUT], D_, D_, WOUT, 32 * nb, scr, 64 * kb, 32 * nb, F_lane); }
    }
    { GAS v4u* p = (GAS v4u*)(WIN + (size_t)INW * D_); const int n16 = (NIN - INW) * D_ * 2 / 16; for (int i = gt; i < n16; i += NGT) p[i] = (v4u){0u, 0u, 0u, 0u}; }
    { float* b = (float*)(F.ws + WS_MISC + MISC_BIAS); for (int i = gt; i < NIN; i += NGT) b[i] = (i >= RIN && i < INW) ? A.in[IN_B_ATTN][i - RIN] : 0.f; }
    { float* rt = (float*)(F.ws + WS_MISC + MISC_ROPE);
      for (int i = gt; i < T_ * 8; i += NGT) { const int t = i >> 3, k = i & 7;
          const float invf = k == 0 ? 1.0f : k == 1 ? 0x1.8d275ep-3f : k == 2 ? 0x1.341190p-5f : k == 3 ? 0x1.ddee9cp-8f : k == 4 ? 0x1.72ba44p-10f : k == 5 ? 0x1.1f91f0p-12f : k == 6 ? 0x1.be2188p-15f : 0x1.5a0f4ep-17f;
          const float ang = (float)t * invf;
          const double a = (double)ang, kq = rint(a * 0.15915494309189535), rr = fma(-kq, 6.283185307179586, a); const float rf = (float)rr;
          rt[t * 16 + k] = cosf(rf); rt[t * 16 + 8 + k] = sinf(rf); } }
    for (int m = gw; m < T_; m += NGW) rms_row_to_bf16(A.in[IN_X] + (size_t)m * D_, A.in[IN_LN_MIX_G], HN + (size_t)m * D_, F_lane);
}
__device__ __forceinline__ void ph_ffn_weights(Ctx& F, const Args& A, int gw, int NGW, int part) {
    const int F_lane = lane_v(), F_tid = F.wave * 64 + F_lane; (void)F_tid;
    LAS float* scr = (LAS float*)(F.lds + F.wave * 16384);
    bf16* WUG = (bf16*)(F.ws + WS_WUG); bf16* WDN = (bf16*)(F.ws + WS_WDN);
    constexpr int I_UP = (D_ / 64) * (DFF / 32), I_DN = (DFF / 64) * (D_ / 32);
    const int it_lo = (part == 1) ? 2 * I_UP : 0, it_hi = (part == 0) ? 2 * I_UP : 2 * I_UP + I_DN;
    for (int it = it_lo + gw; it < it_hi; it += NGW) {
        if (it < 2 * I_UP) { const int gate = it >= I_UP, r = gate ? it - I_UP : it, nblk = DFF / 32, kb = r / nblk, nb = r % nblk, n0 = 32 * nb;
            transpose_item(A.in[gate ? IN_W_GATE : IN_W_UP], D_, DFF, WUG, 256 * (n0 >> 7) + (n0 & 127) + (gate ? 128 : 0), scr, 64 * kb, n0, F_lane); }
        else { const int r = it - 2 * I_UP, nblk = D_ / 32, kb = r / nblk, nb = r % nblk; transpose_item(A.in[IN_W_DOWN], DFF, D_, WDN, 32 * nb, scr, 64 * kb, 32 * nb, F_lane); }
    }
}
__device__ __forceinline__ void ph_final(Ctx& F, const Args& A) {
    const int F_lane = lane_v(), F_tid = F.wave * 64 + F_lane; (void)F_tid;
    const float* ssq3 = (const float*)(F.ws + WS_CTL) + CW_SSQ3; const int gw = F.vcu * NWAVES + F.wave, NGW = F.G * NWAVES;
    for (int t = gw; t < T_; t += NGW) {
        const float sc = 1.0f / sqrtf(ssq3[t] * (1.f / D_) + NORM_EPS);
        GAS f32x4* xr = (GAS f32x4*)(F.out + (size_t)t * D_) + F_lane; const GAS f32x4* gr = (const GAS f32x4*)A.in[IN_LN_FINAL_G] + F_lane;
#pragma unroll
        for (int j = 0; j < 8; ++j) { const f32x4 v = xr[64 * j], g = gr[64 * j]; xr[64 * j] = v * sc * g; }
    }
}
constexpr size_t MISC_WLT = 2 * MiB;
constexpr int PR_AS = 592;
__device__ __forceinline__ void ph_prologue_lora(Ctx& F, const Args& A) {
    const int F_lane = lane_v(), F_tid = F.wave * 64 + F_lane; (void)F_tid;
    bf16* WLT = (bf16*)(F.ws + WS_MISC + MISC_WLT);
    const int gt = (F.vcu * NWAVES + F.wave) * 64 + F_lane, NGT = F.G * NWAVES * 64;
    for (int i = gt; i < 288 * RW; i += NGT) { const int j = i / RW, c = i % RW;
        const float v = j < 64 ? A.in[IN_W2][j * RW + c] : j < 128 ? A.in[IN_A2][(j - 64) * RW + c] : A.in[IN_G2][(j - 128) * RW + c];
        WLT[(size_t)c * 288 + j] = (bf16)f2bf(v); }
}
__device__ __forceinline__ f32x4 zshift4(const bf16* Z, const float* mu, int t, int col) {
    const f32x4 zc = unpack4(*(const GAS u32x2v*)(Z + (size_t)t * NIN + col)); f32x4 zp = (f32x4){0.f, 0.f, 0.f, 0.f};
    if (t > 0) zp = unpack4(*(const GAS u32x2v*)(Z + (size_t)(t - 1) * NIN + col));
    const f32x4 m = *(const GAS f32x4*)(mu + col); return zc + m * (zp - zc);
}
constexpr int RS_ = 144;
constexpr int MATB = 64 * RS_;
constexpr int L_RMA = 0, L_RMR = MATB, L_RMB = 2 * MATB, L_RMK = 3 * MATB;
constexpr int L_XTA = L_RMB, L_XTV = L_RMK;
constexpr int L_CMA = 4 * MATB, L_CMBH = 5 * MATB, L_CMKH = 6 * MATB, L_CMV = 7 * MATB;
constexpr int L_LAB = 8 * MATB, L_LAK = 9 * MATB, L_LRB = 10 * MATB, L_LRK = 11 * MATB;
constexpr int L_LD = 12 * MATB, L_TI = L_LD + 4096, L_TOT = L_TI + 2048, L_R1END = L_TOT + 2048;
constexpr int L_PAR = L_R1END;
static_assert(L_PAR + (8 * 64 + 288) * 4 <= RING_BYTES, "R1 params");
constexpr int L_RKV = 0, RKV_S = 784;
static_assert(64 * RKV_S <= L_LAB, "rkv overlay");
constexpr int L_ACT = L_LAB;
static_assert(64 * 592 <= L_TOT - L_LAB, "act overlay");
static_assert(L_R1END <= RING_BYTES, "R1 LDS");
constexpr size_t WS_SC = 1 * MiB, WS_WC = 17 * MiB, WS_H = 137 * MiB;
constexpr size_t OUT_GP = 32 * MiB, OUT_RB = 48 * MiB, OUT_YB = 0, OUT_VS = 16 * MiB;


__device__ __forceinline__ void ph_rwkv_chunk(Ctx& F, const Args& A) {
    const int F_lane = lane_v(), F_tid = F.wave * 64 + F_lane; (void)F_tid;
    const bf16* Z = (const bf16*)(F.ws + WS_Z); const float* mu = A.in[IN_MU]; const bf16* WLT = (const bf16*)(F.ws + WS_MISC + MISC_WLT);
    bf16* VSo = (bf16*)((unsigned char*)F.out + OUT_VS); bf16* GGo = (bf16*)(F.ws + WS_GG); float* BON = (float*)(F.ws + WS_MISC + MISC_BON);
    unsigned char* GPg = (unsigned char*)F.out + OUT_GP; unsigned char* RBg = (unsigned char*)F.out + OUT_RB;
    float* WCg = (float*)(F.ws + WS_WC); float* Hg = (float*)(F.ws + WS_H); unsigned char* YBg = (unsigned char*)F.out + OUT_YB;
    LAS unsigned char* lds = F.lds;
    const int w = F.wave;
    volatile LAS unsigned long long* TSL = (volatile LAS unsigned long long*)(F.lds + MISC_OFF + 256); unsigned long long tprev = 0;
#define R1STAMP(k) do { if (MK_TS >= 30 && blockIdx.x == 0 && F_tid == 0) { const unsigned long long tn = __builtin_amdgcn_s_memrealtime(); TSL[30 + (k)] += tn - tprev; tprev = tn; } } while (0)
    if (MK_TS >= 30 && blockIdx.x == 0 && F_tid == 0) { for (int i = 30; i < 40; ++i) TSL[i] = 0; }
    const u32x2v zero2 = (u32x2v){0u, 0u};
    u32x2v pa_c[15], pa_p[15];
#define R1_UOFF(ui, tid_) ((ui) < 2 ? (unsigned)((((tid_) + 512 * (ui)) >> 4) * NIN + COL_XW + 4 * (((tid_) + 512 * (ui)) & 15)) \
                      : (ui) < 4 ? (unsigned)((((tid_) + 512 * ((ui) - 2)) >> 4) * NIN + COL_XW + 64 + 4 * (((tid_) + 512 * ((ui) - 2)) & 15)) \
                      : (ui) < 9 ? (unsigned)((((tid_) + 512 * ((ui) - 4)) / 40) * NIN + COL_XW + 128 + 4 * (((tid_) + 512 * ((ui) - 4)) % 40)) \
                      : (unsigned)((((tid_) + 512 * ((ui) - 9)) / 48) * NIN + ((((tid_) + 512 * ((ui) - 9)) % 48) >> 4) * 1024 + 4 * (((tid_) + 512 * ((ui) - 9)) & 15)))
#define R1_PREFETCH(cn, hn, tid_) do { const bf16* zb_ = Z + (size_t)(64 * (cn)) * NIN; \
        _Pragma("unroll") for (int ui = 0; ui < 15; ++ui) { const unsigned zo_ = R1_UOFF(ui, tid_); const bf16* zc_ = zb_ + zo_ + (ui < 9 ? 0 : 64 * (hn)); const bool hp_ = (cn) > 0 || zo_ >= (unsigned)NIN; \
            pa_c[ui] = *(const GAS u32x2v*)zc_; const u32x2v zp_ = *(const GAS u32x2v*)(hp_ ? zc_ - NIN : zc_); pa_p[ui] = hp_ ? zp_ : (u32x2v){0u, 0u}; } } while (0)
#define R1_SHIFT(pc, pp, muv) (unpack4(pc) + (muv) * (unpack4(pp) - unpack4(pc)))
    int h_par = -1;
    if (F.vcu < 128 * NH) R1_PREFETCH(F.vcu >> 4, F.vcu & 15, F_tid);
    for (int it = F.vcu; it < 128 * NH; it += F.G) {
        const int c = it >> 4, h = it & 15;
        int l = F_lane; asm volatile("" : "+v"(l));
        const int r = l & 15, q = l >> 4;
        __syncthreads();
        if (h != h_par) {
            LAS float* par = (LAS float*)(lds + L_PAR);
            for (int i = F_tid; i < 8 * 64 + 288; i += 512) { float v;
                if (i < 512) { const int k = i >> 6, ch = 64 * h + (i & 63); v = k == 0 ? A.in[IN_W0][ch] : k == 1 ? A.in[IN_A0][ch] : k == 2 ? A.in[IN_K_K][ch] : k == 3 ? A.in[IN_K_A][ch] : k == 4 ? A.in[IN_R_K][ch] : k == 5 ? mu[COL_K + ch] : k == 6 ? mu[COL_R + ch] : mu[COL_V + ch]; }
                else v = mu[COL_XW + i - 512];
                par[i] = v; }
            h_par = h; __syncthreads(); }
        bf16x8 Wf[2][9];
        {
#pragma unroll
            for (int ui = 0; ui < 2; ++ui) { const int u = (w * 64 + l) + 512 * ui, tok = u >> 4, j = 4 * (u & 15); const f32x4 v = R1_SHIFT(pa_c[ui], pa_p[ui], *(const LAS f32x4*)(lds + L_PAR + (512 + j) * 4)); f32x4 a;
#pragma unroll
                for (int e = 0; e < 4; ++e) a[e] = 1.0f - 2.0f * __builtin_amdgcn_rcpf(1.0f + __expf(2.0f * v[e]));
                *(LAS u32x2v*)(lds + L_ACT + tok * PR_AS + j * 2) = pack4(a); }
#pragma unroll
            for (int ui = 0; ui < 2; ++ui) { const int u = (w * 64 + l) + 512 * ui, tok = u >> 4, j = 64 + 4 * (u & 15); const f32x4 v = R1_SHIFT(pa_c[2 + ui], pa_p[2 + ui], *(const LAS f32x4*)(lds + L_PAR + (512 + j) * 4));
                *(LAS u32x2v*)(lds + L_ACT + tok * PR_AS + j * 2) = pack4(v); }
#pragma unroll
            for (int ui = 0; ui < 5; ++ui) { const int u = (w * 64 + l) + 512 * ui, tok = u / 40, j = 128 + 4 * (u % 40); const f32x4 v = R1_SHIFT(pa_c[4 + ui], pa_p[4 + ui], *(const LAS f32x4*)(lds + L_PAR + (512 + j) * 4)); f32x4 a;
#pragma unroll
                for (int e = 0; e < 4; ++e) a[e] = __builtin_amdgcn_rcpf(1.0f + __expf(-v[e]));
                *(LAS u32x2v*)(lds + L_ACT + tok * PR_AS + j * 2) = pack4(a); }
        }
#pragma unroll
        for (int ui = 0; ui < 6; ++ui) { const int u = (w * 64 + l) + 512 * ui, tok = u / 48, a3 = (u % 48) >> 4, j4 = u & 15;
            const f32x4 v = R1_SHIFT(pa_c[9 + ui], pa_p[9 + ui], *(const LAS f32x4*)(lds + L_PAR + ((a3 == 0 ? 6 : a3 == 1 ? 5 : 7) * 64 + 4 * j4) * 4));
            *(LAS f32x4*)(lds + L_RKV + tok * RKV_S + (a3 * 64 + 4 * j4) * 4) = v;
            if (a3 == 2) *(GAS u32x2v*)(VSo + (size_t)(64 * c + tok) * RW + 64 * h + 4 * j4) = pack4(v); }
#pragma unroll
        for (int ci = 0; ci < 2; ++ci)
#pragma unroll
            for (int ks = 0; ks < 9; ++ks) Wf[ci][ks] = *(const GAS bf16x8*)(WLT + (size_t)(64 * h + 16 * (2 * (w >> 2) + ci) + r) * 288 + 8 * q + 32 * ks);
        if (MK_TS >= 30 && blockIdx.x == 0 && F_tid == 0) tprev = __builtin_amdgcn_s_memrealtime();
        __syncthreads(); R1STAMP(0);
        {
            const int tl = r, tt = w & 3, half = w >> 2, tloc = 16 * tt + tl, t = 64 * c + tloc;
            f32x4 lwv[2], kkv[2], alr[2], kmd[2], rsh[2], vsh[2];
            float n2 = 0.f, bon = 0.f;
#pragma unroll
            for (int ci = 0; ci < 2; ++ci) {
                const int ct = 2 * half + ci, c4 = 64 * h + 16 * ct + 4 * q;
                const LAS unsigned char* ap = lds + L_ACT + tloc * PR_AS + (8 * q) * 2; const int cl4 = 16 * ct + 4 * q;
                f32x4 wl = (f32x4){0.f, 0.f, 0.f, 0.f}, al = wl, gl = wl;
                wl = mfma16(Wf[ci][0], ld128(ap), wl); wl = mfma16(Wf[ci][1], ld128(ap + 64), wl);
                al = mfma16(Wf[ci][2], ld128(ap + 128), al); al = mfma16(Wf[ci][3], ld128(ap + 192), al);
#pragma unroll
                for (int ks = 4; ks < 9; ++ks) gl = mfma16(Wf[ci][ks], ld128(ap + 64 * ks), gl);
#define R1_PAR(k) (*(const LAS f32x4*)(lds + L_PAR + ((k) * 64 + cl4) * 4))
                const f32x4 w0 = R1_PAR(0), a0 = R1_PAR(1), kkc = R1_PAR(2), kac = R1_PAR(3), rkc = R1_PAR(4);
                const LAS unsigned char* rp = lds + L_RKV + tloc * RKV_S + cl4 * 4; const f32x4 kraw = *(const LAS f32x4*)(rp + 256); rsh[ci] = *(const LAS f32x4*)(rp); vsh[ci] = *(const LAS f32x4*)(rp + 512);
#undef R1_PAR
#pragma unroll
                for (int e = 0; e < 4; ++e) {
                    const float x = w0[e] + wl[e]; const float sp = (x < -20.f) ? -x : __logf(1.0f + __expf(-x));
                    lwv[ci][e] = -__expf(-sp - 0.5f);
                    const float a = __builtin_amdgcn_rcpf(1.0f + __expf(-(a0[e] + al[e]))); alr[ci][e] = a;
                    kkv[ci][e] = kraw[e] * kkc[e]; n2 += kkv[ci][e] * kkv[ci][e]; kmd[ci][e] = kraw[e] * (1.0f + (a - 1.0f) * kac[e]);
                    bon += rsh[ci][e] * kmd[ci][e] * rkc[e]; }
                const size_t o = (size_t)t * RW + c4;
                *(GAS u32x2v*)(GGo + o) = pack4(gl);
            }
            R1STAMP(7);
            if (it + F.G < 128 * NH) R1_PREFETCH((it + F.G) >> 4, (it + F.G) & 15, (w * 64 + l));
            R1STAMP(8);
            n2 += __shfl_xor(n2, 16); n2 += __shfl_xor(n2, 32); bon += __shfl_xor(bon, 16); bon += __shfl_xor(bon, 32);
            LAS float* tot = (LAS float*)(lds + L_TOT); LAS float* nrp = tot + 256; LAS float* bnp = tot + 384;
            if (q == 0) { nrp[half * 64 + tloc] = n2; bnp[half * 64 + tloc] = bon; }
            f32x4 cs[2];
#pragma unroll
            for (int ci = 0; ci < 2; ++ci)
#pragma unroll
                for (int e = 0; e < 4; ++e) { float v = lwv[ci][e];
#pragma unroll
                    for (int d = 1; d < 16; d <<= 1) { const float u = __shfl_up(v, d, 16); if (tl >= d) v += u; }
                    cs[ci][e] = v; }
            if (tl == 15) {
#pragma unroll
                for (int ci = 0; ci < 2; ++ci) *(LAS f32x4*)(tot + tt * 64 + 16 * (2 * half + ci) + 4 * q) = cs[ci]; }
            R1STAMP(9);
            __syncthreads(); R1STAMP(1);
            const float rn = 1.0f / fmaxf(sqrtf(nrp[tloc] + nrp[64 + tloc]), 1e-12f);
            if (half == 0 && q == 0) BON[t * 16 + h] = bnp[tloc] + bnp[64 + tloc];
#pragma unroll
            for (int ci = 0; ci < 2; ++ci) {
                const int ch0 = 16 * (2 * half + ci) + 4 * q;
                f32x4 pre = (f32x4){0.f, 0.f, 0.f, 0.f}, total = pre;
#pragma unroll
                for (int t2 = 0; t2 < 4; ++t2) { const f32x4 tv = *(const LAS f32x4*)(tot + t2 * 64 + ch0); total += tv; if (t2 < tt) pre += tv; }
                if (tt == 0 && tl == 0) { f32x4 wc;
#pragma unroll
                    for (int e = 0; e < 4; ++e) wc[e] = __expf(total[e]);
                    *(GAS f32x4*)(WCg + (h * 128 + c) * 64 + ch0) = wc; }
                f32x4 vA, vR, vB, vK, vBh, vKh;
#pragma unroll
                for (int e = 0; e < 4; ++e) { const float LWt = pre[e] + cs[ci][e], LWm = LWt - lwv[ci][e];
                    const float eA = __expf(LWm), eR = __expf(LWt), eN = __expf(-LWt), eH = __expf(total[e] - LWt);
                    const float kn = kkv[ci][e] * rn, bbv = kn * alr[ci][e];
                    vA[e] = -kn * eA; vR[e] = rsh[ci][e] * eR; vB[e] = bbv * eN; vK[e] = kmd[ci][e] * eN; vBh[e] = bbv * eH; vKh[e] = kmd[ci][e] * eH; }
                const u32x2v pA = pack4(vA), pR = pack4(vR), pB = pack4(vB), pK = pack4(vK), pBh = pack4(vBh), pKh = pack4(vKh), pV = pack4(vsh[ci]);
                *(LAS u32x2v*)(lds + L_RMA + tloc * RS_ + ch0 * 2) = pA; *(LAS u32x2v*)(lds + L_RMR + tloc * RS_ + ch0 * 2) = pR;
                *(LAS u32x2v*)(lds + L_RMB + tloc * RS_ + ch0 * 2) = pB; *(LAS u32x2v*)(lds + L_RMK + tloc * RS_ + ch0 * 2) = pK;
                const unsigned a4[4] = {pA.x & 0xffffu, pA.x >> 16, pA.y & 0xffffu, pA.y >> 16}, b4[4] = {pBh.x & 0xffffu, pBh.x >> 16, pBh.y & 0xffffu, pBh.y >> 16};
                const unsigned k4[4] = {pKh.x & 0xffffu, pKh.x >> 16, pKh.y & 0xffffu, pKh.y >> 16}, v4[4] = {pV.x & 0xffffu, pV.x >> 16, pV.y & 0xffffu, pV.y >> 16};
#pragma unroll
                for (int e = 0; e < 4; ++e) { const int ro = (ch0 + e) * RS_ + tloc * 2;
                    *(LAS unsigned short*)(lds + L_CMA + ro) = (unsigned short)a4[e]; *(LAS unsigned short*)(lds + L_CMBH + ro) = (unsigned short)b4[e];
                    *(LAS unsigned short*)(lds + L_CMKH + ro) = (unsigned short)k4[e]; *(LAS unsigned short*)(lds + L_CMV + ro) = (unsigned short)v4[e]; }
            }
        }
        __syncthreads(); R1STAMP(2);
        {
            const int p = w >> 1, half = w & 1; const int Arm = (p & 1) ? L_RMK : L_RMB, Brm = (p >> 1) ? L_RMR : L_RMA, Lout = L_LAB + p * MATB; const bool strict = p < 2;
            bf16x8 Bf[2][2];
#pragma unroll
            for (int tbi = 0; tbi < 2; ++tbi)
#pragma unroll
                for (int ks = 0; ks < 2; ++ks) Bf[tbi][ks] = ld128(lds + Brm + (16 * (2 * half + tbi) + r) * RS_ + (32 * ks + 8 * q) * 2);
#pragma unroll
            for (int sb = 0; sb < 4; ++sb) {
                const bf16x8 A0 = ld128(lds + Arm + (16 * sb + r) * RS_ + (8 * q) * 2), A1 = ld128(lds + Arm + (16 * sb + r) * RS_ + (32 + 8 * q) * 2);
#pragma unroll
                for (int tbi = 0; tbi < 2; ++tbi) { const int tb = 2 * half + tbi;
                    f32x4 acc = (f32x4){0.f, 0.f, 0.f, 0.f}; acc = mfma16(A0, Bf[tbi][0], acc); acc = mfma16(A1, Bf[tbi][1], acc);
                    const int t = 16 * tb + r, s0 = 16 * sb + 4 * q;
#pragma unroll
                    for (int e = 0; e < 4; ++e) { const bool keep = strict ? (s0 + e < t) : (s0 + e <= t); acc[e] = keep ? acc[e] : 0.f; }
                    *(LAS u32x2v*)(lds + Lout + t * RS_ + s0 * 2) = pack4(acc);
                    if (p == 0 && sb == tb) *(LAS f32x4*)(lds + L_LD + ((sb * 16 + r) * 16 + 4 * q) * 4) = acc; }
            }
        }
        __syncthreads(); R1STAMP(3);
        f32x4 acc[4];
        if (w >= 4) {
            const int nbv = w - 4;
            const bf16x8 V0 = ld128(lds + L_CMV + (16 * nbv + r) * RS_ + (8 * q) * 2), V1 = ld128(lds + L_CMV + (16 * nbv + r) * RS_ + (32 + 8 * q) * 2);
#pragma unroll
            for (int I = 0; I < 4; ++I) { acc[I] = (f32x4){0.f, 0.f, 0.f, 0.f};
                acc[I] = mfma16(ld128(lds + L_LAK + (16 * I + r) * RS_ + (8 * q) * 2), V0, acc[I]); acc[I] = mfma16(ld128(lds + L_LAK + (16 * I + r) * RS_ + (32 + 8 * q) * 2), V1, acc[I]); }
        } else {
#pragma unroll
            for (int I = 0; I < 4; ++I) acc[I] = unpack4(ld64(lds + L_CMA + (16 * w + r) * RS_ + (16 * I + 4 * q) * 2));
            if (w == 3) {
                const int b = q, cc = r; float x[16];
#pragma unroll
                for (int t = 0; t < 16; ++t) { float a = (t == cc) ? 1.f : 0.f;
#pragma unroll
                    for (int s4 = 0; s4 * 4 < t; ++s4) { const f32x4 lv = *(const LAS f32x4*)(lds + L_LD + ((b * 16 + t) * 16 + 4 * s4) * 4);
#pragma unroll
                        for (int e = 0; e < 4; ++e) if (4 * s4 + e < t) a += lv[e] * x[4 * s4 + e]; }
                    x[t] = a; *(LAS unsigned short*)(lds + L_TI + ((b * 16 + t) * 16 + cc) * 2) = (unsigned short)f2bf(a); }
            }
        }
        __syncthreads(); R1STAMP(4);
        {
            const f32x4 z4 = (f32x4){0.f, 0.f, 0.f, 0.f};
#define TIF(I) cat8(ld64(lds + L_TI + (((I) * 16 + r) * 16 + 4 * q) * 2), zero2)
#define LF1(I, K1) cat8(ld64(lds + L_LAB + (16 * (I) + r) * RS_ + (16 * (K1) + 4 * q) * 2), zero2)
#define LF2(I, K1, K2) cat8(ld64(lds + L_LAB + (16 * (I) + r) * RS_ + (16 * (K1) + 4 * q) * 2), ld64(lds + L_LAB + (16 * (I) + r) * RS_ + (16 * (K2) + 4 * q) * 2))
            const f32x4 X0 = mfma16(TIF(0), cat8(pack4(acc[0]), zero2), z4);
            const f32x4 Q1 = mfma16(LF1(1, 0), cat8(pack4(X0), zero2), acc[1]);
            const f32x4 X1 = mfma16(TIF(1), cat8(pack4(Q1), zero2), z4);
            const bf16x8 B01 = cat8(pack4(X0), pack4(X1));
            const f32x4 Q2 = mfma16(LF2(2, 0, 1), B01, acc[2]);
            const f32x4 X2 = mfma16(TIF(2), cat8(pack4(Q2), zero2), z4);
            f32x4 Q3 = mfma16(LF2(3, 0, 1), B01, acc[3]); Q3 = mfma16(LF1(3, 2), cat8(pack4(X2), zero2), Q3);
            const f32x4 X3 = mfma16(TIF(3), cat8(pack4(Q3), zero2), z4);
#undef TIF
#undef LF1
#undef LF2
            const int xo = (w < 4 ? L_XTA : L_XTV) + (16 * (w & 3) + r) * RS_ + (4 * q) * 2;
            *(LAS u32x2v*)(lds + xo) = pack4(X0); *(LAS u32x2v*)(lds + xo + 32) = pack4(X1); *(LAS u32x2v*)(lds + xo + 64) = pack4(X2); *(LAS u32x2v*)(lds + xo + 96) = pack4(X3);
        }
        __syncthreads(); R1STAMP(5);
        {
            const int lo4 = w & 3, hi2 = w >> 2; const f32x4 z4 = (f32x4){0.f, 0.f, 0.f, 0.f};
#define FR(base, row0, ks) ld128(lds + (base) + ((row0) + r) * RS_ + (32 * (ks) + 8 * q) * 2)
            {
                const bf16x8 B0 = FR(L_CMBH, 16 * lo4, 0), B1 = FR(L_CMBH, 16 * lo4, 1); u32x2v o[2];
#pragma unroll
                for (int hf = 0; hf < 2; ++hf) { const int jb = 2 * hi2 + hf; f32x4 a = mfma16(FR(L_XTA, 16 * jb, 0), B0, z4); a = mfma16(FR(L_XTA, 16 * jb, 1), B1, a); o[hf] = pack4(a); }
                *(GAS v4u*)(GPg + (size_t)(h * 128 + c) * 8192 + ((lo4 * 2 + hi2) * 64 + l) * 16) = (v4u){o[0].x, o[0].y, o[1].x, o[1].y};
            }
            {
                const bf16x8 B0 = FR(L_LRB, 16 * lo4, 0), B1 = FR(L_LRB, 16 * lo4, 1); const int t = 16 * lo4 + r;
#pragma unroll
                for (int hf = 0; hf < 2; ++hf) { const int jb = 2 * hi2 + hf; f32x4 a = unpack4(ld64(lds + L_RMR + t * RS_ + (16 * jb + 4 * q) * 2));
                    a = mfma16(FR(L_XTA, 16 * jb, 0), B0, a); a = mfma16(FR(L_XTA, 16 * jb, 1), B1, a);
                    *(GAS u32x2v*)(RBg + (size_t)it * 8192 + t * 128 + (16 * jb + 4 * q) * 2) = pack4(a); }
            }
            {
                const bf16x8 XV0 = FR(L_XTV, 16 * lo4, 0), XV1 = FR(L_XTV, 16 * lo4, 1), V0 = FR(L_CMV, 16 * lo4, 0), V1 = FR(L_CMV, 16 * lo4, 1);
#pragma unroll
                for (int hf = 0; hf < 2; ++hf) { const int ib = 2 * hi2 + hf;
                    f32x4 a = mfma16(FR(L_CMBH, 16 * ib, 0), XV0, z4); a = mfma16(FR(L_CMBH, 16 * ib, 1), XV1, a); a = mfma16(FR(L_CMKH, 16 * ib, 0), V0, a); a = mfma16(FR(L_CMKH, 16 * ib, 1), V1, a);
                    *(GAS f32x4*)(Hg + ((size_t)((h * 4 + lo4) * 128 + c) * 4 + ib) * 256 + l * 4) = a;
                    f32x4 y = mfma16(FR(L_LRB, 16 * ib, 0), XV0, z4); y = mfma16(FR(L_LRB, 16 * ib, 1), XV1, y); y = mfma16(FR(L_LRK, 16 * ib, 0), V0, y); y = mfma16(FR(L_LRK, 16 * ib, 1), V1, y);
                    *(GAS u32x2v*)(YBg + (size_t)it * 8192 + ((lo4 * 4 + ib) * 64 + l) * 8) = pack4(y); }
            }
#undef FR
        }
        R1STAMP(6);
    }
}
constexpr int CH_SS = 4;
constexpr int CH_STEP_BYTES = 8192 + 4096 + 256;
constexpr int CH_BUF_BYTES = CH_SS * CH_STEP_BYTES;
static_assert(2 * CH_BUF_BYTES <= RING_BYTES, "chain LDS");
__device__ __forceinline__ void chain_stage(Ctx& F, const Args& A, int h, int cb, int ss, int bufoff) {
    const int F_lane = lane_v(), F_tid = F.wave * 64 + F_lane; (void)F_tid;
    const unsigned char* GPg = (const unsigned char*)F.out + OUT_GP; const unsigned char* Hg = (const unsigned char*)(F.ws + WS_H); const unsigned char* WCg = (const unsigned char*)(F.ws + WS_WC);
#pragma unroll
    for (int st = 0; st < CH_SS; ++st) { const int c = ss * CH_SS + st; const size_t ih = (size_t)h * 128 + c; const int sb = bufoff + st * CH_STEP_BYTES;
#pragma unroll
        for (int p = 0; p < 13; ++p) { if (((st * 13 + p) & 7) != F.wave) continue;
            if (p < 8) __builtin_amdgcn_global_load_lds((const unsigned*)(GPg + ih * 8192 + p * 1024 + F_lane * 16), (LAS unsigned*)(F.lds + sb + p * 1024), 16, 0, 0);
            else if (p < 12) __builtin_amdgcn_global_load_lds((const unsigned*)(Hg + (((size_t)(h * 4 + cb) * 128 + c) * 4 + (p - 8)) * 1024 + F_lane * 16), (LAS unsigned*)(F.lds + sb + 8192 + (p - 8) * 1024), 16, 0, 0);
            else __builtin_amdgcn_global_load_lds((const unsigned*)(WCg + ih * 256 + F_lane * 4), (LAS unsigned*)(F.lds + sb + 12288), 4, 0, 0); } }
}
__device__ __forceinline__ void ph_rwkv_chain(Ctx& F, const Args& A, int cid) {
    const int F_lane = lane_v(), F_tid = F.wave * 64 + F_lane; (void)F_tid;
    const int h = cid >> 2, cb = cid & 3, l = F_lane, cc = l & 15, q = l >> 4;
    volatile LAS unsigned long long* TSL = (volatile LAS unsigned long long*)(F.lds + MISC_OFF + 256); if (MK_TS >= 20 && cid == 0 && F_tid == 0) { TSL[20] = 0; TSL[21] = 0; TSL[22] = 0; }
    unsigned char* SCg = F.ws + WS_SC;
    f32x4 S[4];
#pragma unroll
    for (int m = 0; m < 4; ++m) S[m] = (f32x4){0.f, 0.f, 0.f, 0.f};
    chain_stage(F, A, h, cb, 0, 0);
    for (int ss = 0; ss < 128 / CH_SS; ++ss) {
        const int bo = (ss & 1) * CH_BUF_BYTES;
        unsigned long long tw0 = 0; if (MK_TS >= 20 && cid == 0 && F_tid == 0) tw0 = __builtin_amdgcn_s_memrealtime();
        asm volatile("s_waitcnt vmcnt(0)" ::: "memory");
        if (MK_TS >= 20 && cid == 0 && F_tid == 0) { const unsigned long long t1 = __builtin_amdgcn_s_memrealtime(); TSL[20] += t1 - tw0; tw0 = t1; }
        __syncthreads();
        if (MK_TS >= 20 && cid == 0 && F_tid == 0) { const unsigned long long t1 = __builtin_amdgcn_s_memrealtime(); TSL[21] += t1 - tw0; tw0 = t1; }
        if (ss + 1 < 128 / CH_SS) chain_stage(F, A, h, cb, ss + 1, ((ss + 1) & 1) * CH_BUF_BYTES);
        if (F.wave == 0) {
#pragma unroll
            for (int st = 0; st < CH_SS; ++st) { const int c = ss * CH_SS + st; const size_t it = (size_t)c * 16 + h; const LAS unsigned char* sb = F.lds + bo + st * CH_STEP_BYTES;
                u32x2v ps[4];
#pragma unroll
                for (int m = 0; m < 4; ++m) { ps[m] = pack4(S[m]); *(GAS u32x2v*)(SCg + it * 8192 + (16 * cb + cc) * 128 + (16 * m + 4 * q) * 2) = ps[m]; }
                const bf16x8 b0 = cat8(ps[0], ps[1]), b1 = cat8(ps[2], ps[3]);
#pragma unroll
                for (int m = 0; m < 4; ++m) { const f32x4 wc = *(const LAS f32x4*)(sb + 12288 + (16 * m + 4 * q) * 4), hh = *(const LAS f32x4*)(sb + 8192 + (m * 64 + l) * 16);
                    f32x4 a = wc * S[m] + hh;
                    a = mfma16(ld128(sb + ((m * 2 + 0) * 64 + l) * 16), b0, a); a = mfma16(ld128(sb + ((m * 2 + 1) * 64 + l) * 16), b1, a);
                    S[m] = a; }
            }
        }
        if (MK_TS >= 20 && cid == 0 && F_tid == 0) { const unsigned long long t1 = __builtin_amdgcn_s_memrealtime(); TSL[22] += t1 - tw0; }
    }
    asm volatile("s_waitcnt vmcnt(0)" ::: "memory"); __syncthreads();
}
__device__ __forceinline__ void ph_post_b(Ctx& F, const Args& A) {
    const int F_lane = lane_v(), F_tid = F.wave * 64 + F_lane; (void)F_tid;
    const bf16* VSg = (const bf16*)((const unsigned char*)F.out + OUT_VS); const bf16* GGg = (const bf16*)(F.ws + WS_GG);
    const unsigned char* SCg = F.ws + WS_SC; const unsigned char* RBg = (const unsigned char*)F.out + OUT_RB; const unsigned char* YBg = (const unsigned char*)F.out + OUT_YB;
    const float* BON = (const float*)(F.ws + WS_MISC + MISC_BON);
    bf16* YC = (bf16*)(F.ws + WS_HN); const float* ssqA = (const float*)(F.ws + WS_CTL) + CW_SSQA;
    const int l = F_lane, cc = l & 15, q = l >> 4, tb = F.wave & 3;
    for (int it = F.vcu * 2 + (F.wave >> 2); it < 128 * NH; it += 2 * F.G) {
        const int c = it >> 4, h = it & 15;
        const bf16x8 A0 = *(const GAS bf16x8*)(RBg + (size_t)it * 8192 + (16 * tb + cc) * 128 + (8 * q) * 2), A1 = *(const GAS bf16x8*)(RBg + (size_t)it * 8192 + (16 * tb + cc) * 128 + (32 + 8 * q) * 2);
        f32x4 y[4];
#pragma unroll
        for (int nb = 0; nb < 4; ++nb) {
            const bf16x8 B0 = *(const GAS bf16x8*)(SCg + (size_t)it * 8192 + (16 * nb + cc) * 128 + (8 * q) * 2), B1 = *(const GAS bf16x8*)(SCg + (size_t)it * 8192 + (16 * nb + cc) * 128 + (32 + 8 * q) * 2);
            y[nb] = unpack4(*(const GAS u32x2v*)(YBg + (size_t)it * 8192 + ((nb * 4 + tb) * 64 + l) * 8));
            y[nb] = mfma16(A0, B0, y[nb]); y[nb] = mfma16(A1, B1, y[nb]); }
        float lg[4], lb[4];
#pragma unroll
        for (int nb = 0; nb < 4; ++nb) { lg[nb] = A.in[IN_LNX_G][h * 64 + 16 * nb + cc]; lb[nb] = A.in[IN_LNX_B][h * 64 + 16 * nb + cc]; }
#pragma unroll
        for (int e = 0; e < 4; ++e) {
            const int t = 64 * c + 16 * tb + 4 * q + e;
            float s = (y[0][e] + y[1][e]) + (y[2][e] + y[3][e]);
            s += __shfl_xor(s, 1); s += __shfl_xor(s, 2); s += __shfl_xor(s, 4); s += __shfl_xor(s, 8);
            const float mu = s * (1.f / 64.f);
            float d[4], v2 = 0.f;
#pragma unroll
            for (int nb = 0; nb < 4; ++nb) { d[nb] = y[nb][e] - mu; v2 += d[nb] * d[nb]; }
            v2 += __shfl_xor(v2, 1); v2 += __shfl_xor(v2, 2); v2 += __shfl_xor(v2, 4); v2 += __shfl_xor(v2, 8);
            const float rstd = 1.0f / sqrtf(v2 * (1.f / 64.f) + LNX_EPS), bon = BON[t * 16 + h];
#pragma unroll
            for (int nb = 0; nb < 4; ++nb) { const size_t o = (size_t)t * RW + h * 64 + 16 * nb + cc;
                const float val = (d[nb] * rstd * lg[nb] + lb[nb] + bon * bf2f(VSg[o])) * bf2f(GGg[o]);
                YC[(size_t)t * D_ + h * 64 + 16 * nb + cc] = (bf16)f2bf(val); }
        }
    }
    const int gw = F.vcu * NWAVES + F.wave, NGW = F.G * NWAVES;
    for (int t = gw; t < T_; t += NGW) {
        const float sc = 1.0f / sqrtf(ssqA[t] * (1.f / RW) + NORM_EPS);
        bf16* p = YC + (size_t)t * D_ + RW;
#pragma unroll
        for (int j = 0; j < 16; ++j) { const int c2 = j * 64 + l; p[c2] = (bf16)f2bf(bf2f(p[c2]) * sc * A.in[IN_ATTN_G][c2]); }
    }
}
constexpr int AT_KS = 144, AT_VS = 528;
constexpr int AT_K = 0, AT_V = 256 * AT_KS, AT_END = AT_V + 64 * AT_VS;
static_assert(AT_END <= RING_BYTES, "attention LDS");
__device__ __forceinline__ void ph_attention(Ctx& F, const Args& A, int bid, int nblk) {
    const int F_lane = lane_v(), F_tid = F.wave * 64 + F_lane; (void)F_tid;
    const bf16* Z = (const bf16*)(F.ws + WS_Z); bf16* YC = (bf16*)(F.ws + WS_HN); const float* rope = (const float*)(F.ws + WS_MISC + MISC_ROPE);
    float* ssqA = (float*)(F.ws + WS_CTL) + CW_SSQA;
    LAS unsigned char* lds = F.lds; const int l = F_lane, cc = l & 15, q = l >> 4;
    for (int it = bid; it < 256; it += nblk) {
        const int nb = it >> 2, kvh = (it >> 1) & 1, qh = it & 1;
        const int kpos0 = 128 * (nb - 1);
        __syncthreads();
        for (int u = F_tid; u < 1024; u += 512) {
            const int key = u >> 2, part = u & 3, pos = kpos0 + key;
            v4u k0 = (v4u){0u, 0u, 0u, 0u}, k1 = k0, v0 = k0, v1 = k0;
            if (pos >= 0) { const bf16* kr = Z + (size_t)pos * NIN + COL_KA + kvh * 64 + part * 16; const bf16* vr = Z + (size_t)pos * NIN + COL_VA + kvh * 64 + part * 16;
                k0 = *(const GAS v4u*)kr; k1 = *(const GAS v4u*)(kr + 8); v0 = *(const GAS v4u*)vr; v1 = *(const GAS v4u*)(vr + 8);
                if (part == 0) { const f32x4 c0 = *(const GAS f32x4*)(rope + pos * 16), c1 = *(const GAS f32x4*)(rope + pos * 16 + 4), s0 = *(const GAS f32x4*)(rope + pos * 16 + 8), s1 = *(const GAS f32x4*)(rope + pos * 16 + 12);
                    const float cs[8] = {c0[0], c0[1], c0[2], c0[3], c1[0], c1[1], c1[2], c1[3]}, sn[8] = {s0[0], s0[1], s0[2], s0[3], s1[0], s1[1], s1[2], s1[3]};
                    const unsigned a[4] = {k0.x, k0.y, k0.z, k0.w}, b[4] = {k1.x, k1.y, k1.z, k1.w}; unsigned oa[4], ob[4];
#pragma unroll
                    for (int e = 0; e < 4; ++e) { const float x1l = bf2f(a[e] & 0xffffu), x1h = bf2f(a[e] >> 16), x2l = bf2f(b[e] & 0xffffu), x2h = bf2f(b[e] >> 16);
                        oa[e] = pk2(x1l * cs[2 * e] - x2l * sn[2 * e], x1h * cs[2 * e + 1] - x2h * sn[2 * e + 1]); ob[e] = pk2(x2l * cs[2 * e] + x1l * sn[2 * e], x2h * cs[2 * e + 1] + x1h * sn[2 * e + 1]); }
                    k0 = (v4u){oa[0], oa[1], oa[2], oa[3]}; k1 = (v4u){ob[0], ob[1], ob[2], ob[3]}; } }
            *(LAS v4u*)(lds + AT_K + key * AT_KS + part * 32) = k0; *(LAS v4u*)(lds + AT_K + key * AT_KS + part * 32 + 16) = k1;
            const unsigned vv[8] = {v0.x, v0.y, v0.z, v0.w, v1.x, v1.y, v1.z, v1.w};
#pragma unroll
            for (int e = 0; e < 8; ++e) { *(LAS unsigned short*)(lds + AT_V + (part * 16 + 2 * e) * AT_VS + key * 2) = (unsigned short)(vv[e] & 0xffffu); *(LAS unsigned short*)(lds + AT_V + (part * 16 + 2 * e + 1) * AT_VS + key * 2) = (unsigned short)(vv[e] >> 16); }
        }
        __syncthreads();
        const int h = kvh * 8 + F.wave; const float sink = A.in[IN_SINKS][h];
#pragma unroll 1
        for (int qb = 0; qb < 4; ++qb) {
            const int p0 = 128 * nb + 64 * qh + 16 * qb, t = p0 + cc, kb = 64 * qh + 16 * qb;
            bf16x8 Q0, Q1;
            { const bf16* qp = Z + (size_t)t * NIN + COL_Q + h * 64; const v4u w0 = *(const GAS v4u*)(qp + 8 * q), w1 = *(const GAS v4u*)(qp + 32 + 8 * q);
              float x[8]; const unsigned ww[4] = {w0.x, w0.y, w0.z, w0.w};
#pragma unroll
              for (int e = 0; e < 4; ++e) { x[2 * e] = bf2f(ww[e] & 0xffffu); x[2 * e + 1] = bf2f(ww[e] >> 16); }
              float y[8];
#pragma unroll
              for (int j = 0; j < 8; ++j) { const float o = __shfl_xor(x[j], 16); const float c = rope[t * 16 + j], s = rope[t * 16 + 8 + j];
                  y[j] = (q == 0) ? (x[j] * c - o * s) : (q == 1) ? (x[j] * c + o * s) : x[j]; y[j] *= 0.125f; }
              v4u r0; r0.x = pk2(y[0], y[1]); r0.y = pk2(y[2], y[3]); r0.z = pk2(y[4], y[5]); r0.w = pk2(y[6], y[7]); Q0 = __builtin_bit_cast(bf16x8, r0);
              const unsigned w1a[4] = {w1.x, w1.y, w1.z, w1.w}; v4u r1; unsigned r1a[4];
#pragma unroll
              for (int e = 0; e < 4; ++e) r1a[e] = pk2(bf2f(w1a[e] & 0xffffu) * 0.125f, bf2f(w1a[e] >> 16) * 0.125f);
              r1 = (v4u){r1a[0], r1a[1], r1a[2], r1a[3]}; Q1 = __builtin_bit_cast(bf16x8, r1); }
            f32x4 s[9]; float mx = sink;
#pragma unroll
            for (int kt = 0; kt < 9; ++kt) {
                const LAS unsigned char* kp = lds + AT_K + (kb + 16 * kt + cc) * AT_KS + (8 * q) * 2;
                f32x4 a = mfma16(ld128(kp), Q0, (f32x4){0.f, 0.f, 0.f, 0.f}); a = mfma16(ld128(kp + 64), Q1, a);
#pragma unroll
                for (int e = 0; e < 4; ++e) { const int i = 4 * q + e; bool ok = (p0 - 128 + 16 * kt + i) >= 0;
                    if (kt == 0) ok = ok && (i >= cc + 1); if (kt == 8) ok = ok && (i <= cc);
                    a[e] = ok ? a[e] : -INFINITY; mx = fmaxf(mx, a[e]); }
                s[kt] = a; }
            mx = fmaxf(mx, __shfl_xor(mx, 16)); mx = fmaxf(mx, __shfl_xor(mx, 32));
            float lsum = 0.f; u32x2v pp[10];
#pragma unroll
            for (int kt = 0; kt < 9; ++kt) { f32x4 p;
#pragma unroll
                for (int e = 0; e < 4; ++e) { p[e] = __expf(s[kt][e] - mx); lsum += p[e]; }
                pp[kt] = pack4(p); }
            pp[9] = (u32x2v){0u, 0u};
            lsum += __shfl_xor(lsum, 16); lsum += __shfl_xor(lsum, 32);
            const float inv = 1.0f / (lsum + __expf(sink - mx));
            f32x4 o[4];
#pragma unroll
            for (int dt = 0; dt < 4; ++dt) { o[dt] = (f32x4){0.f, 0.f, 0.f, 0.f};
                const LAS unsigned char* vp = lds + AT_V + (16 * dt + cc) * AT_VS + (kb + 4 * q) * 2;
#pragma unroll
                for (int ks = 0; ks < 5; ++ks) { const u32x2v lo = ld64(vp + (32 * ks) * 2), hi = ld64(vp + (32 * ks + (ks < 4 ? 16 : 0)) * 2);
                    o[dt] = mfma16(cat8(lo, hi), cat8(pp[2 * ks], pp[2 * ks + 1]), o[dt]); } }
            float sq = 0.f;
#pragma unroll
            for (int dt = 0; dt < 4; ++dt) { o[dt] = o[dt] * inv; sq += (o[dt][0] * o[dt][0] + o[dt][1] * o[dt][1]) + (o[dt][2] * o[dt][2] + o[dt][3] * o[dt][3]);
                *(GAS u32x2v*)(YC + (size_t)t * D_ + RW + h * 64 + 16 * dt + 4 * q) = pack4(o[dt]); }
            sq += __shfl_xor(sq, 16); sq += __shfl_xor(sq, 32);
            if (q == 0) atomicAdd(ssqA + t, sq);
        }
    }
}
constexpr int N_PHASES = 9;
#ifndef MK_TS
#define MK_TS 0
#endif
#ifndef MK_FILLER_IN_CHAIN
#define MK_FILLER_IN_CHAIN 1
#endif
#ifndef MK_REPEAT_MASK
#define MK_REPEAT_MASK 0
#endif
constexpr int N_LAUNCHES = MK_N_LAUNCHES;
__global__ void __launch_bounds__(NWAVES * 64, 2) mk_fwd(Args args) {
    extern __shared__ __attribute__((aligned(16))) unsigned char lds[];
    Ctx F;
    F.lds = (LAS unsigned char*)lds;
    F.wave = __builtin_amdgcn_readfirstlane((int)threadIdx.x >> 6);
#define LEADER (F.wave == 0 && lane_v() == 0)
    F.G = gridDim.x; { const int bx = blockIdx.x; F.vcu = (F.G % 8 == 0) ? (bx % 8) * (F.G / 8) + bx / 8 : bx; }
    F.out = args.out; F.ws = args.ws;
    volatile LAS unsigned* MISC = (volatile LAS unsigned*)(F.lds + MISC_OFF);
    for (int u = (int)threadIdx.x; u < (LDS_BYTES - LDSCTL_OFF) / 4; u += NWAVES * 64) ((LAS unsigned*)(F.lds + LDSCTL_OFF))[u] = 0u;
    __syncthreads();
    gu32* ctl = (gu32*)(F.ws + WS_CTL);
    XcdBarrier bar; bar.bar = (unsigned*)(ctl + CW_BAR); bar.x = 0; bar.st = nullptr;
    const int lo = args.ph_lo, hi = args.ph_hi;
    if (hi - lo > 1) bar = xcd_barrier_post((unsigned*)(ctl + CW_BAR), MISC + 8, LEADER);
#define IN(k) (lo <= (k) && (k) < hi)
#define REPS(k) (1 + ((MK_REPEAT_MASK >> (k)) & 1))
#define SEAM(k) do { if (IN(k) && IN((k) + 1)) xcd_barrier(bar, LEADER); } while (0)
    float* ssq = (float*)(F.ws + WS_CTL);
    volatile LAS unsigned long long* TSL = (volatile LAS unsigned long long*)(F.lds + MISC_OFF + 256);
#define STAMP(i) do { if (MK_TS && blockIdx.x == 0 && LEADER) TSL[(i)] = __builtin_amdgcn_s_memrealtime(); } while (0)
    STAMP(0);
    bf16* HN = (bf16*)(F.ws + WS_HN); bf16* Z = (bf16*)(F.ws + WS_Z); bf16* H2 = (bf16*)(F.ws + WS_H2); bf16* ACT = (bf16*)(F.ws + WS_ACT);

    if (IN(0)) { ph_prologue(F, args); ph_prologue_lora(F, args); } SEAM(0); STAMP(1);
#define PH1() do {   \
        pg8::Gemm g{HN, (const bf16*)(F.ws + WS_WIN), T_, NIN, D_, 0L, 256L * D_ * 2}; pg8::StaticOrder S; S.init(T_, NIN, F.G, (int)blockIdx.x); \
        pg8::EpiZ E{Z, NIN, (const float*)(F.ws + WS_MISC + MISC_BIAS)}; \
        pg8::gemm_phase<pg8::EpiZ, pg8::StaticOrder, true, true>(F.lds, g, S, E, F.wave); } while (0)
    if (IN(1)) { PH1();
        if ((int)blockIdx.x >= 608 - 2 * F.G && F.G == 256) { __syncthreads(); ph_ffn_weights(F, args, ((int)blockIdx.x - 96) * NWAVES + F.wave, (F.G - 96) * NWAVES, 0); }
        else if (F.G != 256) ph_ffn_weights(F, args, F.vcu * NWAVES + F.wave, F.G * NWAVES, 0); } SEAM(1); STAMP(2);
    if (IN(2)) { ph_rwkv_chunk(F, args); } SEAM(2); STAMP(3);
    if (IN(3)) {
        if ((int)blockIdx.x < 64) ph_rwkv_chain(F, args, (int)blockIdx.x);
        else { ph_attention(F, args, (int)blockIdx.x - 64, F.G - 64); __syncthreads(); ph_ffn_weights(F, args, ((int)blockIdx.x - 64) * NWAVES + F.wave, (F.G - 64) * NWAVES, 1); }
    } SEAM(3); STAMP(4);
    if (IN(4)) { ph_post_b(F, args); } SEAM(4); STAMP(5);
    if (IN(5)) {
        pg8::Gemm g{HN, (const bf16*)(F.ws + WS_WOUT), T_, D_, D_, 0L, 256L * D_ * 2}; pg8::StaticOrder S; S.init(T_, D_, F.G, (int)blockIdx.x);
        pg8::EpiRes E{args.in[IN_X], F.out, D_, H2, args.in[IN_LN_FFN_G], ssq + CW_SSQ2};
        pg8::gemm_phase<pg8::EpiRes, pg8::StaticOrder, true, true>(F.lds, g, S, E, F.wave);
    } SEAM(5); STAMP(6);
    if (IN(6)) {
        pg8::Gemm g{H2, (const bf16*)(F.ws + WS_WUG), T_, NUG, D_, -2L * D_ * 2, 254L * D_ * 2}; pg8::StaticOrder S; S.initT(33, NUG / 256, F.G, (int)blockIdx.x);
        pg8::EpiUpGate E{ACT, ssq + CW_SSQ2, args.in[IN_CONV_W], args.in[IN_CONV_B], (LAS float*)(F.lds + XCH_OFF), T_, DFF, 1.0f / D_, NORM_EPS};
        pg8::gemm_phase<pg8::EpiUpGate, pg8::StaticOrder, true, true>(F.lds, g, S, E, F.wave);
    } SEAM(6); STAMP(7);
    if (IN(7)) {
        pg8::Gemm g{ACT, (const bf16*)(F.ws + WS_WDN), T_, D_, DFF, 0L, 256L * DFF * 2}; pg8::StaticOrder S; S.init(T_, D_, F.G, (int)blockIdx.x);
        pg8::EpiRes E{F.out, F.out, D_, nullptr, nullptr, ssq + CW_SSQ3};
        pg8::gemm_phase<pg8::EpiRes, pg8::StaticOrder, true, true>(F.lds, g, S, E, F.wave);
    } SEAM(7); STAMP(8);
    if (IN(8)) { ph_final(F, args); }
    STAMP(9);
    if (MK_TS && blockIdx.x == 0 && LEADER) {
        unsigned long long dt;
        if (MK_TS <= 9) dt = TSL[MK_TS] - TSL[MK_TS - 1]; else dt = TSL[MK_TS];
        asm volatile("s_waitcnt vmcnt(0)" ::: "memory");
        F.out[0] += (float)dt * 1e-4f;
    }
#undef IN
#undef SEAM
}

extern "C" void kernel_launch(void* const* d_in, const int* in_sizes, int n_in, void* d_out, int out_size, void* d_ws, size_t ws_size, hipStream_t stream) {
    static int grid = 0;
    if (grid == 0) {
        if (n_in != 25 || in_sizes[0] != T_ * D_ || out_size != T_ * D_ || ws_size < WS_END) { fprintf(stderr, "kernel_launch: unexpected shapes (n_in %d, in0 %d, out %d, ws %zu)\n", n_in, n_in > 0 ? in_sizes[0] : -1, out_size, ws_size); grid = -1; return; }
        int dev = 0, cus = 0;
        if (hipGetDevice(&dev) != hipSuccess || hipDeviceGetAttribute(&cus, hipDeviceAttributeMultiprocessorCount, dev) != hipSuccess) { grid = -1; return; }
        if (hipFuncSetAttribute((const void*)mk_fwd, hipFuncAttributeMaxDynamicSharedMemorySize, LDS_BYTES) != hipSuccess) { fprintf(stderr, "kernel_launch: hipFuncSetAttribute failed\n"); grid = -1; return; }
        (void)hipGetLastError();
        grid = cus;
    }
    if (grid < 0) return;
    if (hipMemsetAsync((char*)d_ws + WS_CTL, 0, CTL_ZERO_BYTES, stream) != hipSuccess) return;
    Args a{};
    for (int i = 0; i < 25; ++i) a.in[i] = (const float*)d_in[i];
    a.out = (float*)d_out; a.ws = (unsigned char*)d_ws;
    if (N_LAUNCHES == 1) { a.ph_lo = 0; a.ph_hi = N_PHASES; a.li = 0; hipLaunchKernelGGL(mk_fwd, dim3(grid), dim3(NWAVES * 64), LDS_BYTES, stream, a); }
    else for (int ph = 0; ph < N_PHASES; ++ph) { a.ph_lo = ph; a.ph_hi = ph + 1; a.li = 0; hipLaunchKernelGGL(mk_fwd, dim3(grid), dim3(NWAVES * 64), LDS_BYTES, stream, a); }
}
```

```cpp
#include <hip/hip_runtime.h>
#include <cstdio>
#include <cstdint>
#define MK_N_LAUNCHES 1
#define MK_REPEAT_MASK 0
#define MK_FILLER_IN_CHAIN 1
#define MK_TS 0
namespace pg8 {
#define PG8_LAS __attribute__((address_space(3)))
typedef unsigned short bf16_t;
typedef short bf16x8 __attribute__((ext_vector_type(8)));
typedef float f32x4 __attribute__((ext_vector_type(4)));
typedef unsigned u32x4 __attribute__((ext_vector_type(4)));
constexpr int BM = 256, BK = 64, HALF = 128, HTB = HALF * BK * 2  , STAGE_BYTES = 8 * HTB, NXCD = 8, WGM = 8;

__host__ __device__ __forceinline__ int lds_byte(int r, int c) { const int st = (r >> 4) * 2 + (c >> 5), rr = r & 15, cc = c & 31, ob = rr * 64 + cc * 2; return st * 1024 + (ob ^ (((ob >> 9) & 1) << 5)); }
__host__ __device__ __forceinline__ void stage_rc(int b, int& R, int& C) { const int st = b / 1024, sb = b % 1024, swz = sb ^ (((sb >> 9) & 1) << 5); R = (st >> 1) * 16 + swz / 64; C = (st & 1) * 32 + (swz % 64) / 2; }
__host__ __device__ __forceinline__ int perm32(int rho) { const int n = rho >> 4, i = rho & 15; return 8 * (i >> 2) + 4 * n + (i & 3); }

struct Unit { int pm, pn; };
struct Gemm { const bf16_t* A; const bf16_t* Bt; int M, N, K; long a_off, a_tstep; };

struct StaticOrder {
    int nM, nN, nwg, G, c;
    __host__ __device__ void init(int M, int N, int G_, int c_) { nM = M / BM; nN = N / BM; nwg = nM * nN; G = G_; c = c_; }
    __host__ __device__ void initT(int nM_, int nN_, int G_, int c_) { nM = nM_; nN = nN_; nwg = nM * nN; G = G_; c = c_; }
    __host__ __device__ bool next(int i, Unit& u) const {
        const long L = (long)i * G + c; if (L >= nwg) return false;
        int wgid = (int)L; { const int q = nwg / NXCD, r = nwg % NXCD, xcd = wgid % NXCD, off = wgid / NXCD; wgid = (xcd < r ? xcd * (q + 1) : r * (q + 1) + (xcd - r) * q) + off; }
        const int nig = WGM * nN, gid = wgid / nig, fm = gid * WGM, gsz = (nM - fm) < WGM ? (nM - fm) : WGM;
        u.pm = fm + ((wgid % nig) % gsz); u.pn = (wgid % nig) / gsz; return true;
    }
    __device__ __forceinline__ void a_ready(const Unit&) const {}
    __device__ __forceinline__ void done(const Unit&) const {}
};

__device__ __forceinline__ unsigned cvt_pk_bf16(float lo, float hi) { unsigned r; asm volatile("v_cvt_pk_bf16_f32 %0, %1, %2" : "=v"(r) : "v"(lo), "v"(hi)); return r; }
typedef unsigned u32x2 __attribute__((ext_vector_type(2)));

struct EpiZ {
    static constexpr bool PERM = true, AFTER_DRAIN = false;
    bf16_t* O; int ldc; const float* bias;
    __device__ __forceinline__ void init(f32x4 (&acc)[2][2][4][2], const Unit&, int, int, int, int) const {
#pragma unroll
        for (int a = 0; a < 2; ++a)
#pragma unroll
            for (int b = 0; b < 2; ++b)
#pragma unroll
                for (int m = 0; m < 4; ++m)
#pragma unroll
                    for (int n = 0; n < 2; ++n) acc[a][b][m][n] = (f32x4){0.f, 0.f, 0.f, 0.f}; }
    __device__ __forceinline__ void operator()(const f32x4 (&acc)[2][2][4][2], const Unit& u, int wr, int wc, int fr, int fq) const {
        const int row0 = u.pm * BM + wr * 64 + fr; const int col0 = u.pn * BM + wc * 32 + 8 * fq;
        f32x4 bv[2][2];
#pragma unroll
        for (int bj = 0; bj < 2; ++bj)
#pragma unroll
            for (int n = 0; n < 2; ++n) bv[bj][n] = *(const f32x4*)(bias + col0 + bj * HALF + 4 * n);
#pragma unroll
        for (int ai = 0; ai < 2; ++ai)
#pragma unroll
            for (int m = 0; m < 4; ++m) { bf16_t* rowp = O + (size_t)(row0 + ai * HALF + m * 16) * ldc + col0;
#pragma unroll
                for (int bj = 0; bj < 2; ++bj) { const f32x4 v0 = acc[ai][bj][m][0] + bv[bj][0], v1 = acc[ai][bj][m][1] + bv[bj][1];
                    u32x4 w; w.x = cvt_pk_bf16(v0[0], v0[1]); w.y = cvt_pk_bf16(v0[2], v0[3]); w.z = cvt_pk_bf16(v1[0], v1[1]); w.w = cvt_pk_bf16(v1[2], v1[3]);
                    *(u32x4*)(rowp + bj * HALF) = w; } }
    }
};
struct EpiRes {
    static constexpr bool PERM = false, AFTER_DRAIN = false;
    const float* base; float* out; int ldc; bf16_t* hb; const float* gain; float* ssq;
    __device__ __forceinline__ void init(f32x4 (&acc)[2][2][4][2], const Unit& u, int wr, int wc, int fr, int fq) const {
        const int row0 = u.pm * BM + wr * 64 + fr, col0 = u.pn * BM + wc * 32 + 4 * fq;
#pragma unroll
        for (int ai = 0; ai < 2; ++ai)
#pragma unroll
            for (int m = 0; m < 4; ++m) { const size_t off = (size_t)(row0 + ai * HALF + m * 16) * ldc + col0;
#pragma unroll
                for (int bj = 0; bj < 2; ++bj)
#pragma unroll
                    for (int n = 0; n < 2; ++n) acc[ai][bj][m][n] = *(const f32x4*)(base + off + bj * HALF + n * 16); } }
    __device__ __forceinline__ void operator()(const f32x4 (&acc)[2][2][4][2], const Unit& u, int wr, int wc, int fr, int fq) const {
        const int row0 = u.pm * BM + wr * 64 + fr, col0 = u.pn * BM + wc * 32 + 4 * fq;
        f32x4 gv[2][2];
#pragma unroll
        for (int bj = 0; bj < 2; ++bj)
#pragma unroll
            for (int n = 0; n < 2; ++n) gv[bj][n] = hb ? *(const f32x4*)(gain + col0 + bj * HALF + n * 16) : (f32x4){0.f, 0.f, 0.f, 0.f};
#pragma unroll
        for (int ai = 0; ai < 2; ++ai)
#pragma unroll
            for (int m = 0; m < 4; ++m) { const int row = row0 + ai * HALF + m * 16; const size_t off = (size_t)row * ldc + col0; float q = 0.f;
#pragma unroll
                for (int bj = 0; bj < 2; ++bj)
#pragma unroll
                    for (int n = 0; n < 2; ++n) { const f32x4 x1 = acc[ai][bj][m][n];
                        *(f32x4*)(out + off + bj * HALF + n * 16) = x1; q += (x1[0] * x1[0] + x1[1] * x1[1]) + (x1[2] * x1[2] + x1[3] * x1[3]);
                        if (hb) { const f32x4 h = x1 * gv[bj][n]; u32x2 w; w.x = cvt_pk_bf16(h[0], h[1]); w.y = cvt_pk_bf16(h[2], h[3]); *(u32x2*)(hb + off + bj * HALF + n * 16) = w; } }
                q += __shfl_xor(q, 16); q += __shfl_xor(q, 32);
                if (fq == 0) atomicAdd(ssq + row, q); }
    }
};
struct EpiUpGate {
    static constexpr bool PERM = true, AFTER_DRAIN = false;
    bf16_t* act; const float* ssq; const float* cw; const float* cb; PG8_LAS float* xch; int T, F; float invD, eps;
    __device__ __forceinline__ void init(f32x4 (&acc)[2][2][4][2], const Unit&, int, int, int, int) const {
#pragma unroll
        for (int a = 0; a < 2; ++a)
#pragma unroll
            for (int b = 0; b < 2; ++b)
#pragma unroll
                for (int m = 0; m < 4; ++m)
#pragma unroll
                    for (int n = 0; n < 2; ++n) acc[a][b][m][n] = (f32x4){0.f, 0.f, 0.f, 0.f}; }
    __device__ __forceinline__ void operator()(const f32x4 (&acc)[2][2][4][2], const Unit& u, int wr, int wc, int fr, int fq) const {
        const int lane = fr + 16 * fq, wid = wr * 4 + wc;
        const int trow0 = 254 * u.pm - 2, f0 = 128 * u.pn + wc * 32 + 8 * fq;
        f32x4 uu[2][4][2], gg[2][4][2];
#pragma unroll
        for (int ai = 0; ai < 2; ++ai)
#pragma unroll
            for (int m = 0; m < 4; ++m) { const int t = trow0 + ai * HALF + wr * 64 + m * 16 + fr; float s = 0.f;
                if (t >= 0 && t < T) s = __builtin_amdgcn_rsqf(ssq[t] * invD + eps);
#pragma unroll
                for (int n = 0; n < 2; ++n) { uu[ai][m][n] = acc[ai][0][m][n] * s; gg[ai][m][n] = acc[ai][1][m][n] * s; } }
        if (fr >= 14) {
#pragma unroll
            for (int ai = 0; ai < 2; ++ai)
#pragma unroll
                for (int n = 0; n < 2; ++n) *(PG8_LAS f32x4*)(xch + ((((wid * 2 + ai) * 2 + (fr - 14)) * 4 + fq) * 2 + n) * 4) = uu[ai][3][n];
        }
        asm volatile("s_waitcnt lgkmcnt(0)" ::: "memory"); __builtin_amdgcn_s_barrier(); asm volatile("" ::: "memory");
        f32x4 pg[2][2];
#pragma unroll
        for (int ai = 0; ai < 2; ++ai)
#pragma unroll
            for (int n = 0; n < 2; ++n) { pg[ai][n] = (f32x4){0.f, 0.f, 0.f, 0.f};
                const int swid = wr ? wid - 4 : wid + 4, sai = wr ? ai : ai - 1;
                if (fr >= 14 && sai >= 0) pg[ai][n] = *(const PG8_LAS f32x4*)(xch + ((((swid * 2 + sai) * 2 + (fr - 14)) * 4 + fq) * 2 + n) * 4); }
        f32x4 w0[2], w1[2], w2[2], bb[2];
#pragma unroll
        for (int n = 0; n < 2; ++n) { w0[n] = *(const f32x4*)(cw + f0 + 4 * n); w1[n] = *(const f32x4*)(cw + F + f0 + 4 * n); w2[n] = *(const f32x4*)(cw + 2 * F + f0 + 4 * n); bb[n] = *(const f32x4*)(cb + f0 + 4 * n); }
        const int src1 = (lane & ~15) | ((lane - 1) & 15), src2 = (lane & ~15) | ((lane - 2) & 15);
#pragma unroll
        for (int ai = 0; ai < 2; ++ai)
#pragma unroll
            for (int m = 0; m < 4; ++m) { const int r = ai * HALF + wr * 64 + m * 16 + fr, t = trow0 + r; f32x4 o[2];
#pragma unroll
                for (int n = 0; n < 2; ++n) { const f32x4 U = uu[ai][m][n], PG = (m == 0) ? pg[ai][n] : uu[ai][m == 0 ? 0 : m - 1][n];
#pragma unroll
                    for (int c = 0; c < 4; ++c) { const float s1 = (fr == 15) ? PG[c] : U[c], s2 = (fr >= 14) ? PG[c] : U[c];
                        const float p1 = __shfl(s1, src1), p2 = __shfl(s2, src2);
                        const float cv = bb[n][c] + w2[n][c] * U[c] + w1[n][c] * p1 + w0[n][c] * p2;
                        const float sg = cv * __builtin_amdgcn_rcpf(1.0f + __expf(-cv));
                        o[n][c] = sg * gg[ai][m][n][c]; } }
                if (r >= 2 && t < T) { u32x4 w; w.x = cvt_pk_bf16(o[0][0], o[0][1]); w.y = cvt_pk_bf16(o[0][2], o[0][3]); w.z = cvt_pk_bf16(o[1][0], o[1][1]); w.w = cvt_pk_bf16(o[1][2], o[1][3]);
                    *(u32x4*)(act + (size_t)t * F + f0) = w; } }
    }
};
template <class Epi, class Sched, bool ALIGN_EPI = false, bool SP2 = false>
__device__ __forceinline__ void gemm_phase(PG8_LAS unsigned char* lds, const Gemm g, const Sched& S, const Epi& E, const int wid) {
    int lane; asm volatile("v_mbcnt_lo_u32_b32 %0, -1, 0\n\tv_mbcnt_hi_u32_b32 %0, -1, %0" : "=v"(lane)); const int tid = wid * 64 + lane, wr = wid >> 2, wc = wid & 3, fr = lane & 15, fq = lane >> 4;
    const int K = g.K, nt = K / BK;
    unsigned voffA[2], voffB[2];
#pragma unroll
    for (int i = 0; i < 2; ++i) { int R, C; stage_rc(tid * 16 + i * 8192, R, C); const int Rb = Epi::PERM ? ((R & ~31) + perm32(R & 31)) : R;
        voffA[i] = (unsigned)(R * K + C) * 2u; voffB[i] = (unsigned)(Rb * K + C) * 2u; }
    const size_t kstep = (size_t)(BK * 2);
    const size_t hstep = (size_t)HALF * K * 2;
    const size_t tstep = 2 * hstep;
    const unsigned ldsw = (unsigned)wid * 1024u;
    const int aoff = lds_byte(wr * 64 + fr, fq * 8), boff = lds_byte(wc * 32 + fr, fq * 8);
#define PG8_SA(b, h) (((b) * 2 + (h)) * HTB)
#define PG8_SB(b, h) ((4 + (b) * 2 + (h)) * HTB)
#define PG8_STAGE(bufoff, gbase, voff) do { _Pragma("unroll") for (int _i = 0; _i < 2; ++_i) \
        __builtin_amdgcn_global_load_lds((const unsigned*)((const char*)(gbase) + (voff)[_i]), (PG8_LAS unsigned*)(lds + (bufoff) + ldsw + _i * 8192), 16, 0, 0); } while (0)
#define PG8_LDA(dst, b, h) do { _Pragma("unroll") for (int m = 0; m < 4; ++m) _Pragma("unroll") for (int k = 0; k < 2; ++k) dst[m][k] = *(const PG8_LAS bf16x8*)(lds + PG8_SA(b, h) + aoff + m * 2048 + k * 1024); } while (0)
#define PG8_LDB(dst, b, h) do { _Pragma("unroll") for (int n = 0; n < 2; ++n) _Pragma("unroll") for (int k = 0; k < 2; ++k) dst[n][k] = *(const PG8_LAS bf16x8*)(lds + PG8_SB(b, h) + boff + n * 2048 + k * 1024); } while (0)
#define PG8_MMA(ai, bj, At, Bt) do { __builtin_amdgcn_s_setprio(1); _Pragma("unroll") for (int m = 0; m < 4; ++m) _Pragma("unroll") for (int n = 0; n < 2; ++n) _Pragma("unroll") for (int k = 0; k < 2; ++k) \
        acc[ai][bj][m][n] = __builtin_amdgcn_mfma_f32_16x16x32_bf16(Bt[n][k], At[m][k], acc[ai][bj][m][n], 0, 0, 0); __builtin_amdgcn_s_setprio(0); } while (0)
#define PG8_WAIT_V(n) asm volatile("s_waitcnt vmcnt(" #n ")" ::: "memory")
#define PG8_WAIT_L(n) asm volatile("s_waitcnt lgkmcnt(" #n ")" ::: "memory")
#define PG8_BAR __builtin_amdgcn_s_barrier()
#define PG8_SCHED __builtin_amdgcn_sched_barrier(0)
    Unit cur, nxt; int ui = 0;
    if (!S.next(0, cur)) return;
    f32x4 acc[2][2][4][2];
    E.init(acc, cur, wr, wc, fr, fq);
    bf16x8 At[4][2], B0[2][2], B1[2][2];
    const char* cA = (const char*)g.A + g.a_off + (long)cur.pm * g.a_tstep; const char* cB = (const char*)g.Bt + (size_t)cur.pn * tstep;
    S.a_ready(cur);
    if constexpr (SP2) {
        PG8_STAGE(PG8_SB(0, 0), cB, voffB); PG8_STAGE(PG8_SB(0, 1), cB + hstep, voffB); PG8_STAGE(PG8_SA(0, 0), cA, voffA); PG8_STAGE(PG8_SA(0, 1), cA + hstep, voffA);
        if (wr == 1) PG8_BAR;
        PG8_WAIT_V(2); PG8_BAR;
        PG8_STAGE(PG8_SB(1, 0), cB + kstep, voffB); PG8_STAGE(PG8_SA(1, 0), cA + kstep, voffA); PG8_STAGE(PG8_SB(1, 1), cB + hstep + kstep, voffB);
        PG8_WAIT_V(6); PG8_BAR;
    } else {
        PG8_STAGE(PG8_SB(0, 0), cB, voffB); PG8_STAGE(PG8_SA(0, 0), cA, voffA); PG8_STAGE(PG8_SB(0, 1), cB + hstep, voffB); PG8_STAGE(PG8_SA(0, 1), cA + hstep, voffA);
        if (wr == 1) PG8_BAR;
        PG8_WAIT_V(4); PG8_BAR;
        PG8_STAGE(PG8_SB(1, 0), cB + kstep, voffB); PG8_STAGE(PG8_SA(1, 0), cA + kstep, voffA); PG8_STAGE(PG8_SB(1, 1), cB + hstep + kstep, voffB);
        PG8_WAIT_V(6); PG8_BAR;
    }
    for (;;) {
        const bool has_next = S.next(ui + 1, nxt);
        const char* nA = has_next ? (const char*)g.A + g.a_off + (long)nxt.pm * g.a_tstep : cA; const char* nB = has_next ? (const char*)g.Bt + (size_t)nxt.pn * tstep : cB;
        for (int t = 0; t < nt; t += 2) {
            const bool last = (t == nt - 2);
            const char* a1 = cA + (size_t)(t + 1) * kstep;
            const char* a2 = last ? nA : cA + (size_t)(t + 2) * kstep; const char* b2 = last ? nB : cB + (size_t)(t + 2) * kstep;
            const char* a3 = a2 + kstep; const char* b3 = b2 + kstep;
            if (last && has_next) S.a_ready(nxt);
            if constexpr (SP2) {
            PG8_LDB(B0, 0, 0); PG8_LDB(B1, 0, 1); PG8_SCHED; PG8_LDA(At, 0, 0); PG8_STAGE(PG8_SA(1, 1), a1 + hstep, voffA);
            PG8_WAIT_V(8); PG8_WAIT_L(0); PG8_BAR; PG8_MMA(0, 0, At, B0); PG8_MMA(0, 1, At, B1); PG8_BAR; PG8_SCHED;
            PG8_LDA(At, 0, 1); PG8_STAGE(PG8_SB(0, 0), b2, voffB); PG8_STAGE(PG8_SB(0, 1), b2 + hstep, voffB); PG8_STAGE(PG8_SA(0, 0), a2, voffA);
            PG8_WAIT_V(8); PG8_WAIT_L(0); PG8_BAR; PG8_MMA(1, 0, At, B0); PG8_MMA(1, 1, At, B1); PG8_BAR; PG8_SCHED;
            PG8_LDB(B0, 1, 0); PG8_LDB(B1, 1, 1); PG8_SCHED; PG8_LDA(At, 1, 0); PG8_STAGE(PG8_SA(0, 1), a2 + hstep, voffA);
            PG8_WAIT_V(8); PG8_WAIT_L(0); PG8_BAR; PG8_MMA(0, 0, At, B0); PG8_MMA(0, 1, At, B1); PG8_BAR; PG8_SCHED;
            PG8_LDA(At, 1, 1); PG8_STAGE(PG8_SB(1, 0), b3, voffB); PG8_STAGE(PG8_SB(1, 1), b3 + hstep, voffB); PG8_STAGE(PG8_SA(1, 0), a3, voffA);
            PG8_WAIT_V(8); PG8_WAIT_L(0); PG8_BAR; PG8_MMA(1, 0, At, B0); PG8_MMA(1, 1, At, B1); PG8_BAR; PG8_SCHED;
            } else {
            PG8_LDB(B0, 0, 0); PG8_SCHED; PG8_LDA(At, 0, 0); PG8_STAGE(PG8_SA(1, 1), a1 + hstep, voffA);
            PG8_WAIT_L(8); PG8_BAR; PG8_WAIT_L(0); PG8_MMA(0, 0, At, B0); PG8_BAR; PG8_SCHED;
            PG8_LDB(B1, 0, 1); PG8_STAGE(PG8_SB(0, 0), b2, voffB);
            PG8_BAR; PG8_WAIT_L(0); PG8_MMA(0, 1, At, B1); PG8_BAR;
            PG8_LDA(At, 0, 1); PG8_STAGE(PG8_SA(0, 0), a2, voffA);
            PG8_BAR; PG8_WAIT_L(0); PG8_MMA(1, 0, At, B0); PG8_BAR; PG8_SCHED;
            PG8_STAGE(PG8_SB(0, 1), b2 + hstep, voffB);
            PG8_WAIT_V(6); PG8_BAR; PG8_MMA(1, 1, At, B1); PG8_BAR;
            PG8_LDB(B0, 1, 0); PG8_SCHED; PG8_LDA(At, 1, 0); PG8_STAGE(PG8_SA(0, 1), a2 + hstep, voffA);
            PG8_WAIT_L(8); PG8_BAR; PG8_WAIT_L(0); PG8_MMA(0, 0, At, B0); PG8_BAR; PG8_SCHED;
            PG8_LDB(B1, 1, 1); PG8_STAGE(PG8_SB(1, 0), b3, voffB);
            PG8_BAR; PG8_WAIT_L(0); PG8_MMA(0, 1, At, B1); PG8_BAR;
            PG8_LDA(At, 1, 1); PG8_STAGE(PG8_SA(1, 0), a3, voffA);
            PG8_BAR; PG8_WAIT_L(0); PG8_MMA(1, 0, At, B0); PG8_BAR; PG8_SCHED;
            PG8_STAGE(PG8_SB(1, 1), b3 + hstep, voffB);
            PG8_WAIT_V(6); PG8_BAR; PG8_MMA(1, 1, At, B1); PG8_BAR;
            }
        }
        if constexpr (ALIGN_EPI) { if (wr == 0) PG8_BAR; }
        if constexpr (!Epi::AFTER_DRAIN) { E(acc, cur, wr, wc, fr, fq); S.done(cur); }
        if (!has_next) break;
        E.init(acc, nxt, wr, wc, fr, fq);
        cur = nxt; cA = nA; cB = nB; ++ui;
        if constexpr (ALIGN_EPI) { if (wr == 1) PG8_BAR; }
    }
    PG8_WAIT_V(0);
    if constexpr (!ALIGN_EPI) { if (wr == 0) PG8_BAR; }
    PG8_BAR;
    if constexpr (Epi::AFTER_DRAIN) { E.fused(acc, cur, wr, wc, fr, fq, lds, wid, lane); S.done(cur); }
#undef PG8_SA
#undef PG8_SB
#undef PG8_STAGE
#undef PG8_LDA
#undef PG8_LDB
#undef PG8_MMA
#undef PG8_WAIT_V
#undef PG8_WAIT_L
#undef PG8_BAR
#undef PG8_SCHED
}
}
constexpr int NWAVES = 8;
#ifndef MK_TS
#define MK_TS 0
#endif
#ifndef MK_N_LAUNCHES
#define MK_N_LAUNCHES 1
#endif
constexpr int T_ = 8192, D_ = 2048, INW = 4640, NIN = 4864, RW = 1024, NH = 16, HD = 64, DFF = 5632, NUG = 2 * DFF;
constexpr int COL_R = 0, COL_K = 1024, COL_V = 2048, COL_XW = 3072, COL_XA = 3136, COL_XG = 3200, COL_Q = 3360, COL_KA = 4384, COL_VA = 4512, RIN = 3360;
constexpr float NORM_EPS = 1e-5f, LNX_EPS = 64e-5f;
constexpr size_t MiB = 1u << 20;
constexpr size_t WS_CTL = 0, CTL_ZERO_BYTES = 1 * MiB;
constexpr size_t WS_WIN = 1 * MiB, WS_WOUT = 20 * MiB, WS_HN = 28 * MiB, WS_Z = 61 * MiB, WS_GG = 169 * MiB, WS_MISC = 253 * MiB, WS_END = 256 * MiB;
constexpr size_t WS_WUG = 185 * MiB, WS_WDN = 229 * MiB, WS_ACT = 96 * MiB, WS_H2 = 62 * MiB;
constexpr size_t MISC_BIAS = 0, MISC_ROPE = 64 * 1024, MISC_BON = 1 * MiB;
constexpr int CW_BAR = 4096;
constexpr int CW_SSQA = 65536, CW_SSQ2 = CW_SSQA + T_, CW_SSQ3 = CW_SSQ2 + T_;
static_assert((CW_SSQ3 + T_) * 4 <= (int)CTL_ZERO_BYTES, "ctl");
constexpr int RING_BYTES = 131072, XCH_OFF = RING_BYTES, LDSCTL_OFF = RING_BYTES + 4096, MISC_OFF = LDSCTL_OFF + 320, LDS_BYTES = 147456;

#define GAS __attribute__((address_space(1)))
#define LAS __attribute__((address_space(3)))
typedef unsigned short bf16;
typedef unsigned v4u __attribute__((ext_vector_type(4)));
typedef float f32x4 __attribute__((ext_vector_type(4)));
typedef GAS unsigned gu32;
#define RLX_AGENT __ATOMIC_RELAXED, __HIP_MEMORY_SCOPE_AGENT
#define LDS_WAIT() asm volatile("s_waitcnt lgkmcnt(0)" ::: "memory")
__device__ __forceinline__ unsigned f2bf(float f) { unsigned u = __builtin_bit_cast(unsigned, f); return (u + 0x7fffu + ((u >> 16) & 1u)) >> 16; }
typedef float f32x2_t __attribute__((ext_vector_type(2))); typedef __bf16 bf16x2_t __attribute__((ext_vector_type(2)));
__device__ __forceinline__ unsigned pk2(float lo, float hi) { f32x2_t v = {lo, hi}; bf16x2_t b = __builtin_convertvector(v, bf16x2_t); return __builtin_bit_cast(unsigned, b); }
__device__ __forceinline__ float bf2f(unsigned h) { return __builtin_bit_cast(float, h << 16); }
__device__ __forceinline__ int lane_v() { int l; asm volatile("v_mbcnt_lo_u32_b32 %0, -1, 0\n\tv_mbcnt_hi_u32_b32 %0, -1, %0" : "=v"(l)); return l; }
__device__ __forceinline__ float wave_sum(float v) {
#pragma unroll
    for (int o = 1; o < 64; o <<= 1) v += __shfl_xor(v, o);
    return v;
}
struct Args { const float* in[25]; float* out; unsigned char* ws; int ph_lo, ph_hi, li, pad; };
#define XB_TMO      128
#define XB_XCNT(j)  (256  + 64 * (j))
#define XB_XSUB(j)  (1280 + 64 * (j))
#define XB_XGEN(j)  (2304 + 64 * (j))
#define XB_TOP      3328
#define XB_TOPGEN   3392
#define XCD_BAR_WORDS 3456
#define XB_SPIN_CAP (1u << 18)

__device__ __forceinline__ unsigned xb_ld(unsigned* p)              { return __hip_atomic_load(p, __ATOMIC_RELAXED, __HIP_MEMORY_SCOPE_AGENT); }
__device__ __forceinline__ unsigned xb_add(unsigned* p, unsigned v) { return __hip_atomic_fetch_add(p, v, __ATOMIC_RELAXED, __HIP_MEMORY_SCOPE_AGENT); }
__device__ __forceinline__ unsigned xb_xcc_id() { return (unsigned)__builtin_amdgcn_s_getreg((3 << 11) | 20) & 0xFu; }
#define XB_SPIN(cond, bar) do { unsigned _sp = 0; while (cond) { __builtin_amdgcn_s_sleep(1); \
    if ((++_sp & 255u) == 0u) { if (xb_ld(&(bar)[XB_TMO])) break; if (_sp > XB_SPIN_CAP) { atomicAdd(&(bar)[XB_TMO], 1u); break; } } } } while (0)

struct XcdBarrier {
    unsigned* bar; unsigned x;
    volatile LAS unsigned* st;
};

__device__ __forceinline__ XcdBarrier xcd_barrier_post(unsigned* bar, volatile LAS unsigned* st, bool leader) {
    XcdBarrier b; b.bar = bar; b.x = xb_xcc_id(); b.st = st;
    if (leader) (void)xb_add(&bar[XB_XCNT(b.x)], 1u);
    return b;
}
__device__ __forceinline__ void xcd_barrier_complete(unsigned* bar, unsigned x, unsigned& nloc, unsigned& nx) {
    const unsigned G = gridDim.x * gridDim.y * gridDim.z;
    unsigned sum, cnt, mine, sp = 0u;
    for (;;) {
        sum = 0u; cnt = 0u; mine = 0u;
#pragma unroll
        for (unsigned j = 0; j < 16; ++j) { const unsigned c = xb_ld(&bar[XB_XCNT(j)]); sum += c; cnt += (c > 0u) ? 1u : 0u; mine = (j == x) ? c : mine; }
        if (sum == G) break;
        __builtin_amdgcn_s_sleep(1);
        if ((++sp & 255u) == 0u) { if (xb_ld(&bar[XB_TMO])) break; if (sp > XB_SPIN_CAP) { atomicAdd(&bar[XB_TMO], 1u); break; } }
    }
    nloc = mine > 0u ? mine : 1u; nx = cnt > 0u ? cnt : 1u;
}

__device__ __forceinline__ void xcd_barrier(const XcdBarrier& b, bool leader) {
    asm volatile("s_waitcnt vmcnt(0)" ::: "memory");
    __syncthreads();
    if (leader) {
        unsigned* bar = b.bar;
        __builtin_amdgcn_s_waitcnt(0);
        unsigned nloc = b.st[0], nx = b.st[1];
        if (nloc == 0u) { xcd_barrier_complete(bar, b.x, nloc, nx); b.st[0] = nloc; b.st[1] = nx; }
        const unsigned old = xb_add(&bar[XB_XSUB(b.x)], 1u);
        const unsigned gen = old / nloc;
        if (old + 1u == (gen + 1u) * nloc) {
            __builtin_amdgcn_fence(__ATOMIC_RELEASE, "agent");
            asm volatile("s_waitcnt vmcnt(0)" ::: "memory");
            const unsigned og = xb_add(&bar[XB_TOP], 1u);
            const unsigned tg = og / nx;
            if (og + 1u == (tg + 1u) * nx) xb_add(&bar[XB_TOPGEN], 1u);
            else XB_SPIN(xb_ld(&bar[XB_TOPGEN]) == tg, bar);
            __builtin_amdgcn_fence(__ATOMIC_ACQUIRE, "agent");
            xb_add(&bar[XB_XGEN(b.x)], 1u);
            asm volatile("s_waitcnt vmcnt(0)" ::: "memory");
        } else {
            XB_SPIN(xb_ld(&bar[XB_XGEN(b.x)]) == gen, bar);
            __builtin_amdgcn_fence(__ATOMIC_ACQUIRE, "agent");
            asm volatile("s_waitcnt vmcnt(0)" ::: "memory");
        }
    }
    __syncthreads();
}
typedef short bf16x8 __attribute__((ext_vector_type(8)));
typedef unsigned u32x2v __attribute__((ext_vector_type(2)));
__device__ __forceinline__ f32x4 mfma16(bf16x8 a, bf16x8 b, f32x4 c) { return __builtin_amdgcn_mfma_f32_16x16x32_bf16(a, b, c, 0, 0, 0); }
__device__ __forceinline__ bf16x8 ld128(const LAS unsigned char* p) { return *(const LAS bf16x8*)p; }
__device__ __forceinline__ u32x2v ld64(const LAS unsigned char* p) { return *(const LAS u32x2v*)p; }
__device__ __forceinline__ u32x2v pack4(f32x4 v) { u32x2v r; r.x = pk2(v[0], v[1]); r.y = pk2(v[2], v[3]); return r; }
__device__ __forceinline__ f32x4 unpack4(u32x2v w) { return (f32x4){bf2f(w.x & 0xffffu), bf2f(w.x >> 16), bf2f(w.y & 0xffffu), bf2f(w.y >> 16)}; }
__device__ __forceinline__ bf16x8 cat8(u32x2v lo, u32x2v hi) { v4u t; t.x = lo.x; t.y = lo.y; t.z = hi.x; t.w = hi.y; return __builtin_bit_cast(bf16x8, t); }

struct Ctx {
    LAS unsigned char* lds; int wave, vcu, G;
    float* out; unsigned char* ws;
};
#define IN_X 0
#define IN_LN_MIX_G 1
#define IN_W_IN 2
#define IN_B_ATTN 3
#define IN_MU 4
#define IN_W0 5
#define IN_W2 6
#define IN_A0 7
#define IN_A2 8
#define IN_G2 9
#define IN_K_K 10
#define IN_K_A 11
#define IN_R_K 12
#define IN_LNX_G 13
#define IN_LNX_B 14
#define IN_SINKS 15
#define IN_ATTN_G 16
#define IN_W_OUT 17
#define IN_LN_FFN_G 18
#define IN_W_UP 19
#define IN_W_GATE 20
#define IN_CONV_W 21
#define IN_CONV_B 22
#define IN_W_DOWN 23
#define IN_LN_FINAL_G 24

__device__ __forceinline__ void transpose_item(const float* W, int K, int N, bf16* WT, int drow0, LAS float* scr, int k0, int n0, int lane) {
#pragma unroll 8
    for (int i = 0; i < 32; ++i) { const int kk = 2 * i + (lane >> 5); scr[kk * 33 + (lane & 31)] = W[(size_t)(k0 + kk) * N + n0 + (lane & 31)]; }
    LDS_WAIT(); asm volatile("" ::: "memory");
    const int c = lane & 7;
#pragma unroll
    for (int j = 0; j < 4; ++j) { const int n = (lane >> 3) + 8 * j; const LAS float* s = scr + (8 * c) * 33 + n;
        v4u o; o.x = pk2(s[0 * 33], s[1 * 33]); o.y = pk2(s[2 * 33], s[3 * 33]); o.z = pk2(s[4 * 33], s[5 * 33]); o.w = pk2(s[6 * 33], s[7 * 33]);
        *(GAS v4u*)(WT + (size_t)(drow0 + n) * K + k0 + 8 * c) = o; }
    LDS_WAIT(); asm volatile("" ::: "memory");
}
__device__ __forceinline__ void rms_row_to_bf16(const float* xrow, const float* g, bf16* orow, int lane) {
    const GAS f32x4* xr = (const GAS f32x4*)xrow + lane; const GAS f32x4* gr = (const GAS f32x4*)g + lane;
    f32x4 v[8]; float s = 0.f;
#pragma unroll
    for (int j = 0; j < 8; ++j) { v[j] = xr[64 * j]; s += (v[j].x * v[j].x + v[j].y * v[j].y) + (v[j].z * v[j].z + v[j].w * v[j].w); }
    const float rs = 1.0f / sqrtf(wave_sum(s) * (1.f / D_) + NORM_EPS);
    GAS unsigned long long* o8 = (GAS unsigned long long*)orow + lane;
#pragma unroll
    for (int j = 0; j < 8; ++j) { const f32x4 gg = gr[64 * j]; o8[64 * j] = (unsigned long long)pk2(v[j].x * rs * gg.x, v[j].y * rs * gg.y) | ((unsigned long long)pk2(v[j].z * rs * gg.z, v[j].w * rs * gg.w) << 32); }
}

__device__ __forceinline__ void ph_prologue(Ctx& F, const Args& A) {
    const int F_lane = lane_v(), F_tid = F.wave * 64 + F_lane; (void)F_tid;
    LAS float* scr = (LAS float*)(F.lds + F.wave * 16384);
    const int gw = F.vcu * NWAVES + F.wave, NGW = F.G * NWAVES, gt = gw * 64 + F_lane, NGT = NGW * 64;
    bf16* WIN = (bf16*)(F.ws + WS_WIN); bf16* WOUT = (bf16*)(F.ws + WS_WOUT); bf16* HN = (bf16*)(F.ws + WS_HN);
    constexpr int I_IN = (D_ / 64) * (INW / 32), I_OUT = (D_ / 64) * (D_ / 32);
    for (int it = gw; it < I_IN + I_OUT; it += NGW) {
        if (it < I_IN) { const int nblk = INW / 32, kb = it / nblk, nb = it % nblk; transpose_item(A.in[IN_W_IN], D_, INW, WIN, 32 * nb, scr, 64 * kb, 32 * nb, F_lane); }
        else { const int r = it - I_IN, nblk = D_ / 32, kb = r / nblk, nb = r % nblk; transpose_item(A.in[IN_W_OUT], D_, D_, WOUT, 32 * nb, scr, 64 * kb, 32 * nb, F_lane); }
    }
    { GAS v4u* p = (GAS v4u*)(WIN + (size_t)INW * D_); const int n16 = (NIN - INW) * D_ * 2 / 16; for (int i = gt; i < n16; i += NGT) p[i] = (v4u){0u, 0u, 0u, 0u}; }
    { float* b = (float*)(F.ws + WS_MISC + MISC_BIAS); for (int i = gt; i < NIN; i += NGT) b[i] = (i >= RIN && i < INW) ? A.in[IN_B_ATTN][i - RIN] : 0.f; }
    { float* rt = (float*)(F.ws + WS_MISC + MISC_ROPE);
      for (int i = gt; i < T_ * 8; i += NGT) { const int t = i >> 3, k = i & 7;
          const float invf = k == 0 ? 1.0f : k == 1 ? 0x1.8d275ep-3f : k == 2 ? 0x1.341190p-5f : k == 3 ? 0x1.ddee9cp-8f : k == 4 ? 0x1.72ba44p-10f : k == 5 ? 0x1.1f91f0p-12f : k == 6 ? 0x1.be2188p-15f : 0x1.5a0f4ep-17f;
          const float ang = (float)t * invf;
          const double a = (double)ang, kq = rint(a * 0.15915494309189535), rr = fma(-kq, 6.283185307179586, a); const float rf = (float)rr;
          rt[t * 16 + k] = cosf(rf); rt[t * 16 + 8 + k] = sinf(rf); } }
    for (int m = gw; m < T_; m += NGW) rms_row_to_bf16(A.in[IN_X] + (size_t)m * D_, A.in[IN_LN_MIX_G], HN + (size_t)m * D_, F_lane);
}
__device__ __forceinline__ void ph_ffn_weights(Ctx& F, const Args& A, int gw, int NGW, int part) {
    const int F_lane = lane_v(), F_tid = F.wave * 64 + F_lane; (void)F_tid;
    LAS float* scr = (LAS float*)(F.lds + F.wave * 16384);
    bf16* WUG = (bf16*)(F.ws + WS_WUG); bf16* WDN = (bf16*)(F.ws + WS_WDN);
    constexpr int I_UP = (D_ / 64) * (DFF / 32), I_DN = (DFF / 64) * (D_ / 32);
    const int it_lo = (part == 1) ? 2 * I_UP : 0, it_hi = (part == 0) ? 2 * I_UP : 2 * I_UP + I_DN;
    for (int it = it_lo + gw; it < it_hi; it += NGW) {
        if (it < 2 * I_UP) { const int gate = it >= I_UP, r = gate ? it - I_UP : it, nblk = DFF / 32, kb = r / nblk, nb = r % nblk, n0 = 32 * nb;
            transpose_item(A.in[gate ? IN_W_GATE : IN_W_UP], D_, DFF, WUG, 256 * (n0 >> 7) + (n0 & 127) + (gate ? 128 : 0), scr, 64 * kb, n0, F_lane); }
        else { const int r = it - 2 * I_UP, nblk = D_ / 32, kb = r / nblk, nb = r % nblk; transpose_item(A.in[IN_W_DOWN], DFF, D_, WDN, 32 * nb, scr, 64 * kb, 32 * nb, F_lane); }
    }
}
__device__ __forceinline__ void ph_final(Ctx& F, const Args& A) {
    const int F_lane = lane_v(), F_tid = F.wave * 64 + F_lane; (void)F_tid;
    const float* ssq3 = (const float*)(F.ws + WS_CTL) + CW_SSQ3; const int gw = F.vcu * NWAVES + F.wave, NGW = F.G * NWAVES;
    for (int t = gw; t < T_; t += NGW) {
        const float sc = 1.0f / sqrtf(ssq3[t] * (1.f / D_) + NORM_EPS);
        GAS f32x4* xr = (GAS f32x4*)(F.out + (size_t)t * D_) + F_lane; const GAS f32x4* gr = (const GAS f32x4*)A.in[IN_LN_FINAL_G] + F_lane;
#pragma unroll
        for (int j = 0; j < 8; ++j) { const f32x4 v = xr[64 * j], g = gr[64 * j]; xr[64 * j] = v * sc * g; }
    }
}
constexpr size_t MISC_WLT = 2 * MiB;
constexpr int PR_AS = 592;
__device__ __forceinline__ void ph_prologue_lora(Ctx& F, const Args& A) {
    const int F_lane = lane_v(), F_tid = F.wave * 64 + F_lane; (void)F_tid;
    bf16* WLT = (bf16*)(F.ws + WS_MISC + MISC_WLT);
    const int gt = (F.vcu * NWAVES + F.wave) * 64 + F_lane, NGT = F.G * NWAVES * 64;
    for (int i = gt; i < 288 * RW; i += NGT) { const int j = i / RW, c = i % RW;
        const float v = j < 64 ? A.in[IN_W2][j * RW + c] : j < 128 ? A.in[IN_A2][(j - 64) * RW + c] : A.in[IN_G2][(j - 128) * RW + c];
        WLT[(size_t)c * 288 + j] = (bf16)f2bf(v); }
}
__device__ __forceinline__ f32x4 zshift4(const bf16* Z, const float* mu, int t, int col) {
    const f32x4 zc = unpack4(*(const GAS u32x2v*)(Z + (size_t)t * NIN + col)); f32x4 zp = (f32x4){0.f, 0.f, 0.f, 0.f};
    if (t > 0) zp = unpack4(*(const GAS u32x2v*)(Z + (size_t)(t - 1) * NIN + col));
    const f32x4 m = *(const GAS f32x4*)(mu + col); return zc + m * (zp - zc);
}
constexpr int RS_ = 144;
constexpr int MATB = 64 * RS_;
constexpr int L_RMA = 0, L_RMR = MATB, L_RMB = 2 * MATB, L_RMK = 3 * MATB;
constexpr int L_XTA = L_RMB, L_XTV = L_RMK;
constexpr int L_CMA = 4 * MATB, L_CMBH = 5 * MATB, L_CMKH = 6 * MATB, L_CMV = 7 * MATB;
constexpr int L_LAB = 8 * MATB, L_LAK = 9 * MATB, L_LRB = 10 * MATB, L_LRK = 11 * MATB;
constexpr int L_LD = 12 * MATB, L_TI = L_LD + 4096, L_TOT = L_TI + 2048, L_R1END = L_TOT + 2048;
constexpr int L_PAR = L_R1END;
static_assert(L_PAR + (8 * 64 + 288) * 4 <= RING_BYTES, "R1 params");
constexpr int L_RKV = 0, RKV_S = 784;
static_assert(64 * RKV_S <= L_LAB, "rkv overlay");
constexpr int L_ACT = L_LAB;
static_assert(64 * 592 <= L_TOT - L_LAB, "act overlay");
static_assert(L_R1END <= RING_BYTES, "R1 LDS");
constexpr size_t WS_SC = 1 * MiB, WS_WC = 17 * MiB, WS_H = 137 * MiB;
constexpr size_t OUT_GP = 32 * MiB, OUT_RB = 48 * MiB, OUT_YB = 0, OUT_VS = 16 * MiB;


__device__ __forceinline__ void ph_rwkv_chunk(Ctx& F, const Args& A) {
    const int F_lane = lane_v(), F_tid = F.wave * 64 + F_lane; (void)F_tid;
    const bf16* Z = (const bf16*)(F.ws + WS_Z); const float* mu = A.in[IN_MU]; const bf16* WLT = (const bf16*)(F.ws + WS_MISC + MISC_WLT);
    bf16* VSo = (bf16*)((unsigned char*)F.out + OUT_VS); bf16* GGo = (bf16*)(F.ws + WS_GG); float* BON = (float*)(F.ws + WS_MISC + MISC_BON);
    unsigned char* GPg = (unsigned char*)F.out + OUT_GP; unsigned char* RBg = (unsigned char*)F.out + OUT_RB;
    float* WCg = (float*)(F.ws + WS_WC); float* Hg = (float*)(F.ws + WS_H); unsigned char* YBg = (unsigned char*)F.out + OUT_YB;
    LAS unsigned char* lds = F.lds;
    const int w = F.wave;
    volatile LAS unsigned long long* TSL = (volatile LAS unsigned long long*)(F.lds + MISC_OFF + 256); unsigned long long tprev = 0;
#define R1STAMP(k) do { if (MK_TS >= 30 && blockIdx.x == 0 && F_tid == 0) { const unsigned long long tn = __builtin_amdgcn_s_memrealtime(); TSL[30 + (k)] += tn - tprev; tprev = tn; } } while (0)
    if (MK_TS >= 30 && blockIdx.x == 0 && F_tid == 0) { for (int i = 30; i < 40; ++i) TSL[i] = 0; }
    const u32x2v zero2 = (u32x2v){0u, 0u};
    u32x2v pa_c[15], pa_p[15];
#define R1_UOFF(ui, tid_) ((ui) < 2 ? (unsigned)((((tid_) + 512 * (ui)) >> 4) * NIN + COL_XW + 4 * (((tid_) + 512 * (ui)) & 15)) \
                      : (ui) < 4 ? (unsigned)((((tid_) + 512 * ((ui) - 2)) >> 4) * NIN + COL_XW + 64 + 4 * (((tid_) + 512 * ((ui) - 2)) & 15)) \
                      : (ui) < 9 ? (unsigned)((((tid_) + 512 * ((ui) - 4)) / 40) * NIN + COL_XW + 128 + 4 * (((tid_) + 512 * ((ui) - 4)) % 40)) \
                      : (unsigned)((((tid_) + 512 * ((ui) - 9)) / 48) * NIN + ((((tid_) + 512 * ((ui) - 9)) % 48) >> 4) * 1024 + 4 * (((tid_) + 512 * ((ui) - 9)) & 15)))
#define R1_PREFETCH(cn, hn, tid_) do { const bf16* zb_ = Z + (size_t)(64 * (cn)) * NIN; \
        _Pragma("unroll") for (int ui = 0; ui < 15; ++ui) { const unsigned zo_ = R1_UOFF(ui, tid_); const bf16* zc_ = zb_ + zo_ + (ui < 9 ? 0 : 64 * (hn)); const bool hp_ = (cn) > 0 || zo_ >= (unsigned)NIN; \
            pa_c[ui] = *(const GAS u32x2v*)zc_; const u32x2v zp_ = *(const GAS u32x2v*)(hp_ ? zc_ - NIN : zc_); pa_p[ui] = hp_ ? zp_ : (u32x2v){0u, 0u}; } } while (0)
#define R1_SHIFT(pc, pp, muv) (unpack4(pc) + (muv) * (unpack4(pp) - unpack4(pc)))
    int h_par = -1;
    if (F.vcu < 128 * NH) R1_PREFETCH(F.vcu >> 4, F.vcu & 15, F_tid);
    for (int it = F.vcu; it < 128 * NH; it += F.G) {
        const int c = it >> 4, h = it & 15;
        int l = F_lane; asm volatile("" : "+v"(l));
        const int r = l & 15, q = l >> 4;
        __syncthreads();
        if (h != h_par) {
            LAS float* par = (LAS float*)(lds + L_PAR);
            for (int i = F_tid; i < 8 * 64 + 288; i += 512) { float v;
                if (i < 512) { const int k = i >> 6, ch = 64 * h + (i & 63); v = k == 0 ? A.in[IN_W0][ch] : k == 1 ? A.in[IN_A0][ch] : k == 2 ? A.in[IN_K_K][ch] : k == 3 ? A.in[IN_K_A][ch] : k == 4 ? A.in[IN_R_K][ch] : k == 5 ? mu[COL_K + ch] : k == 6 ? mu[COL_R + ch] : mu[COL_V + ch]; }
                else v = mu[COL_XW + i - 512];
                par[i] = v; }
            h_par = h; __syncthreads(); }
        bf16x8 Wf[2][9];
        {
#pragma unroll
            for (int ui = 0; ui < 2; ++ui) { const int u = (w * 64 + l) + 512 * ui, tok = u >> 4, j = 4 * (u & 15); const f32x4 v = R1_SHIFT(pa_c[ui], pa_p[ui], *(const LAS f32x4*)(lds + L_PAR + (512 + j) * 4)); f32x4 a;
#pragma unroll
                for (int e = 0; e < 4; ++e) a[e] = 1.0f - 2.0f * __builtin_amdgcn_rcpf(1.0f + __expf(2.0f * v[e]));
                *(LAS u32x2v*)(lds + L_ACT + tok * PR_AS + j * 2) = pack4(a); }
#pragma unroll
            for (int ui = 0; ui < 2; ++ui) { const int u = (w * 64 + l) + 512 * ui, tok = u >> 4, j = 64 + 4 * (u & 15); const f32x4 v = R1_SHIFT(pa_c[2 + ui], pa_p[2 + ui], *(const LAS f32x4*)(lds + L_PAR + (512 + j) * 4));
                *(LAS u32x2v*)(lds + L_ACT + tok * PR_AS + j * 2) = pack4(v); }
#pragma unroll
            for (int ui = 0; ui < 5; ++ui) { const int u = (w * 64 + l) + 512 * ui, tok = u / 40, j = 128 + 4 * (u % 40); const f32x4 v = R1_SHIFT(pa_c[4 + ui], pa_p[4 + ui], *(const LAS f32x4*)(lds + L_PAR + (512 + j) * 4)); f32x4 a;
#pragma unroll
                for (int e = 0; e < 4; ++e) a[e] = __builtin_amdgcn_rcpf(1.0f + __expf(-v[e]));
                *(LAS u32x2v*)(lds + L_ACT + tok * PR_AS + j * 2) = pack4(a); }
        }
#pragma unroll
        for (int ui = 0; ui < 6; ++ui) { const int u = (w * 64 + l) + 512 * ui, tok = u / 48, a3 = (u % 48) >> 4, j4 = u & 15;
            const f32x4 v = R1_SHIFT(pa_c[9 + ui], pa_p[9 + ui], *(const LAS f32x4*)(lds + L_PAR + ((a3 == 0 ? 6 : a3 == 1 ? 5 : 7) * 64 + 4 * j4) * 4));
            *(LAS f32x4*)(lds + L_RKV + tok * RKV_S + (a3 * 64 + 4 * j4) * 4) = v;
            if (a3 == 2) *(GAS u32x2v*)(VSo + (size_t)(64 * c + tok) * RW + 64 * h + 4 * j4) = pack4(v); }
#pragma unroll
        for (int ci = 0; ci < 2; ++ci)
#pragma unroll
            for (int ks = 0; ks < 9; ++ks) Wf[ci][ks] = *(const GAS bf16x8*)(WLT + (size_t)(64 * h + 16 * (2 * (w >> 2) + ci) + r) * 288 + 8 * q + 32 * ks);
        if (MK_TS >= 30 && blockIdx.x == 0 && F_tid == 0) tprev = __builtin_amdgcn_s_memrealtime();
        __syncthreads(); R1STAMP(0);
        {
            const int tl = r, tt = w & 3, half = w >> 2, tloc = 16 * tt + tl, t = 64 * c + tloc;
            f32x4 lwv[2], kkv[2], alr[2], kmd[2], rsh[2], vsh[2];
            float n2 = 0.f, bon = 0.f;
#pragma unroll
            for (int ci = 0; ci < 2; ++ci) {
                const int ct = 2 * half + ci, c4 = 64 * h + 16 * ct + 4 * q;
                const LAS unsigned char* ap = lds + L_ACT + tloc * PR_AS + (8 * q) * 2; const int cl4 = 16 * ct + 4 * q;
                f32x4 wl = (f32x4){0.f, 0.f, 0.f, 0.f}, al = wl, gl = wl;
                wl = mfma16(Wf[ci][0], ld128(ap), wl); wl = mfma16(Wf[ci][1], ld128(ap + 64), wl);
                al = mfma16(Wf[ci][2], ld128(ap + 128), al); al = mfma16(Wf[ci][3], ld128(ap + 192), al);
#pragma unroll
                for (int ks = 4; ks < 9; ++ks) gl = mfma16(Wf[ci][ks], ld128(ap + 64 * ks), gl);
#define R1_PAR(k) (*(const LAS f32x4*)(lds + L_PAR + ((k) * 64 + cl4) * 4))
                const f32x4 w0 = R1_PAR(0), a0 = R1_PAR(1), kkc = R1_PAR(2), kac = R1_PAR(3), rkc = R1_PAR(4);
                const LAS unsigned char* rp = lds + L_RKV + tloc * RKV_S + cl4 * 4; const f32x4 kraw = *(const LAS f32x4*)(rp + 256); rsh[ci] = *(const LAS f32x4*)(rp); vsh[ci] = *(const LAS f32x4*)(rp + 512);
#undef R1_PAR
#pragma unroll
                for (int e = 0; e < 4; ++e) {
                    const float x = w0[e] + wl[e]; const float sp = (x < -20.f) ? -x : __logf(1.0f + __expf(-x));
                    lwv[ci][e] = -__expf(-sp - 0.5f);
                    const float a = __builtin_amdgcn_rcpf(1.0f + __expf(-(a0[e] + al[e]))); alr[ci][e] = a;
                    kkv[ci][e] = kraw[e] * kkc[e]; n2 += kkv[ci][e] * kkv[ci][e]; kmd[ci][e] = kraw[e] * (1.0f + (a - 1.0f) * kac[e]);
                    bon += rsh[ci][e] * kmd[ci][e] * rkc[e]; }
                const size_t o = (size_t)t * RW + c4;
                *(GAS u32x2v*)(GGo + o) = pack4(gl);
            }
            R1STAMP(7);
            if (it + F.G < 128 * NH) R1_PREFETCH((it + F.G) >> 4, (it + F.G) & 15, (w * 64 + l));
            R1STAMP(8);
            n2 += __shfl_xor(n2, 16); n2 += __shfl_xor(n2, 32); bon += __shfl_xor(bon, 16); bon += __shfl_xor(bon, 32);
            LAS float* tot = (LAS float*)(lds + L_TOT); LAS float* nrp = tot + 256; LAS float* bnp = tot + 384;
            if (q == 0) { nrp[half * 64 + tloc] = n2; bnp[half * 64 + tloc] = bon; }
            f32x4 cs[2];
#pragma unroll
            for (int ci = 0; ci < 2; ++ci)
#pragma unroll
                for (int e = 0; e < 4; ++e) { float v = lwv[ci][e];
#pragma unroll
                    for (int d = 1; d < 16; d <<= 1) { const float u = __shfl_up(v, d, 16); if (tl >= d) v += u; }
                    cs[ci][e] = v; }
            if (tl == 15) {
#pragma unroll
                for (int ci = 0; ci < 2; ++ci) *(LAS f32x4*)(tot + tt * 64 + 16 * (2 * half + ci) + 4 * q) = cs[ci]; }
            R1STAMP(9);
            __syncthreads(); R1STAMP(1);
            const float rn = 1.0f / fmaxf(sqrtf(nrp[tloc] + nrp[64 + tloc]), 1e-12f);
            if (half == 0 && q == 0) BON[t * 16 + h] = bnp[tloc] + bnp[64 + tloc];
#pragma unroll
            for (int ci = 0; ci < 2; ++ci) {
                const int ch0 = 16 * (2 * half + ci) + 4 * q;
                f32x4 pre = (f32x4){0.f, 0.f, 0.f, 0.f}, total = pre;
#pragma unroll
                for (int t2 = 0; t2 < 4; ++t2) { const f32x4 tv = *(const LAS f32x4*)(tot + t2 * 64 + ch0); total += tv; if (t2 < tt) pre += tv; }
                if (tt == 0 && tl == 0) { f32x4 wc;
#pragma unroll
                    for (int e = 0; e < 4; ++e) wc[e] = __expf(total[e]);
                    *(GAS f32x4*)(WCg + (h * 128 + c) * 64 + ch0) = wc; }
                f32x4 vA, vR, vB, vK, vBh, vKh;
#pragma unroll
                for (int e = 0; e < 4; ++e) { const float LWt = pre[e] + cs[ci][e], LWm = LWt - lwv[ci][e];
                    const float eA = __expf(LWm), eR = __expf(LWt), eN = __expf(-LWt), eH = __expf(total[e] - LWt);
                    const float kn = kkv[ci][e] * rn, bbv = kn * alr[ci][e];
                    vA[e] = -kn * eA; vR[e] = rsh[ci][e] * eR; vB[e] = bbv * eN; vK[e] = kmd[ci][e] * eN; vBh[e] = bbv * eH; vKh[e] = kmd[ci][e] * eH; }
                const u32x2v pA = pack4(vA), pR = pack4(vR), pB = pack4(vB), pK = pack4(vK), pBh = pack4(vBh), pKh = pack4(vKh), pV = pack4(vsh[ci]);
                *(LAS u32x2v*)(lds + L_RMA + tloc * RS_ + ch0 * 2) = pA; *(LAS u32x2v*)(lds + L_RMR + tloc * RS_ + ch0 * 2) = pR;
                *(LAS u32x2v*)(lds + L_RMB + tloc * RS_ + ch0 * 2) = pB; *(LAS u32x2v*)(lds + L_RMK + tloc * RS_ + ch0 * 2) = pK;
                const unsigned a4[4] = {pA.x & 0xffffu, pA.x >> 16, pA.y & 0xffffu, pA.y >> 16}, b4[4] = {pBh.x & 0xffffu, pBh.x >> 16, pBh.y & 0xffffu, pBh.y >> 16};
                const unsigned k4[4] = {pKh.x & 0xffffu, pKh.x >> 16, pKh.y & 0xffffu, pKh.y >> 16}, v4[4] = {pV.x & 0xffffu, pV.x >> 16, pV.y & 0xffffu, pV.y >> 16};
#pragma unroll
                for (int e = 0; e < 4; ++e) { const int ro = (ch0 + e) * RS_ + tloc * 2;
                    *(LAS unsigned short*)(lds + L_CMA + ro) = (unsigned short)a4[e]; *(LAS unsigned short*)(lds + L_CMBH + ro) = (unsigned short)b4[e];
                    *(LAS unsigned short*)(lds + L_CMKH + ro) = (unsigned short)k4[e]; *(LAS unsigned short*)(lds + L_CMV + ro) = (unsigned short)v4[e]; }
            }
        }
        __syncthreads(); R1STAMP(2);
        {
            const int p = w >> 1, half = w & 1; const int Arm = (p & 1) ? L_RMK : L_RMB, Brm = (p >> 1) ? L_RMR : L_RMA, Lout = L_LAB + p * MATB; const bool strict = p < 2;
            bf16x8 Bf[2][2];
#pragma unroll
            for (int tbi = 0; tbi < 2; ++tbi)
#pragma unroll
                for (int ks = 0; ks < 2; ++ks) Bf[tbi][ks] = ld128(lds + Brm + (16 * (2 * half + tbi) + r) * RS_ + (32 * ks + 8 * q) * 2);
#pragma unroll
            for (int sb = 0; sb < 4; ++sb) {
                const bf16x8 A0 = ld128(lds + Arm + (16 * sb + r) * RS_ + (8 * q) * 2), A1 = ld128(lds + Arm + (16 * sb + r) * RS_ + (32 + 8 * q) * 2);
#pragma unroll
                for (int tbi = 0; tbi < 2; ++tbi) { const int tb = 2 * half + tbi;
                    f32x4 acc = (f32x4){0.f, 0.f, 0.f, 0.f}; acc = mfma16(A0, Bf[tbi][0], acc); acc = mfma16(A1, Bf[tbi][1], acc);
                    const int t = 16 * tb + r, s0 = 16 * sb + 4 * q;
#pragma unroll
                    for (int e = 0; e < 4; ++e) { const bool keep = strict ? (s0 + e < t) : (s0 + e <= t); acc[e] = keep ? acc[e] : 0.f; }
                    *(LAS u32x2v*)(lds + Lout + t * RS_ + s0 * 2) = pack4(acc);
                    if (p == 0 && sb == tb) *(LAS f32x4*)(lds + L_LD + ((sb * 16 + r) * 16 + 4 * q) * 4) = acc; }
            }
        }
        __syncthreads(); R1STAMP(3);
        f32x4 acc[4];
        if (w >= 4) {
            const int nbv = w - 4;
            const bf16x8 V0 = ld128(lds + L_CMV + (16 * nbv + r) * RS_ + (8 * q) * 2), V1 = ld128(lds + L_CMV + (16 * nbv + r) * RS_ + (32 + 8 * q) * 2);
#pragma unroll
            for (int I = 0; I < 4; ++I) { acc[I] = (f32x4){0.f, 0.f, 0.f, 0.f};
                acc[I] = mfma16(ld128(lds + L_LAK + (16 * I + r) * RS_ + (8 * q) * 2), V0, acc[I]); acc[I] = mfma16(ld128(lds + L_LAK + (16 * I + r) * RS_ + (32 + 8 * q) * 2), V1, acc[I]); }
        } else {
#pragma unroll
            for (int I = 0; I < 4; ++I) acc[I] = unpack4(ld64(lds + L_CMA + (16 * w + r) * RS_ + (16 * I + 4 * q) * 2));
            if (w == 3) {
                const int b = q, cc = r; float x[16];
#pragma unroll
                for (int t = 0; t < 16; ++t) { float a = (t == cc) ? 1.f : 0.f;
#pragma unroll
                    for (int s4 = 0; s4 * 4 < t; ++s4) { const f32x4 lv = *(const LAS f32x4*)(lds + L_LD + ((b * 16 + t) * 16 + 4 * s4) * 4);
#pragma unroll
                        for (int e = 0; e < 4; ++e) if (4 * s4 + e < t) a += lv[e] * x[4 * s4 + e]; }
                    x[t] = a; *(LAS unsigned short*)(lds + L_TI + ((b * 16 + t) * 16 + cc) * 2) = (unsigned short)f2bf(a); }
            }
        }
        __syncthreads(); R1STAMP(4);
        {
            const f32x4 z4 = (f32x4){0.f, 0.f, 0.f, 0.f};
#define TIF(I) cat8(ld64(lds + L_TI + (((I) * 16 + r) * 16 + 4 * q) * 2), zero2)
#define LF1(I, K1) cat8(ld64(lds + L_LAB + (16 * (I) + r) * RS_ + (16 * (K1) + 4 * q) * 2), zero2)
#define LF2(I, K1, K2) cat8(ld64(lds + L_LAB + (16 * (I) + r) * RS_ + (16 * (K1) + 4 * q) * 2), ld64(lds + L_LAB + (16 * (I) + r) * RS_ + (16 * (K2) + 4 * q) * 2))
            const f32x4 X0 = mfma16(TIF(0), cat8(pack4(acc[0]), zero2), z4);
            const f32x4 Q1 = mfma16(LF1(1, 0), cat8(pack4(X0), zero2), acc[1]);
            const f32x4 X1 = mfma16(TIF(1), cat8(pack4(Q1), zero2), z4);
            const bf16x8 B01 = cat8(pack4(X0), pack4(X1));
            const f32x4 Q2 = mfma16(LF2(2, 0, 1), B01, acc[2]);
            const f32x4 X2 = mfma16(TIF(2), cat8(pack4(Q2), zero2), z4);
            f32x4 Q3 = mfma16(LF2(3, 0, 1), B01, acc[3]); Q3 = mfma16(LF1(3, 2), cat8(pack4(X2), zero2), Q3);
            const f32x4 X3 = mfma16(TIF(3), cat8(pack4(Q3), zero2), z4);
#undef TIF
#undef LF1
#undef LF2
            const int xo = (w < 4 ? L_XTA : L_XTV) + (16 * (w & 3) + r) * RS_ + (4 * q) * 2;
            *(LAS u32x2v*)(lds + xo) = pack4(X0); *(LAS u32x2v*)(lds + xo + 32) = pack4(X1); *(LAS u32x2v*)(lds + xo + 64) = pack4(X2); *(LAS u32x2v*)(lds + xo + 96) = pack4(X3);
        }
        __syncthreads(); R1STAMP(5);
        {
            const int lo4 = w & 3, hi2 = w >> 2; const f32x4 z4 = (f32x4){0.f, 0.f, 0.f, 0.f};
#define FR(base, row0, ks) ld128(lds + (base) + ((row0) + r) * RS_ + (32 * (ks) + 8 * q) * 2)
            {
                const bf16x8 B0 = FR(L_CMBH, 16 * lo4, 0), B1 = FR(L_CMBH, 16 * lo4, 1); u32x2v o[2];
#pragma unroll
                for (int hf = 0; hf < 2; ++hf) { const int jb = 2 * hi2 + hf; f32x4 a = mfma16(FR(L_XTA, 16 * jb, 0), B0, z4); a = mfma16(FR(L_XTA, 16 * jb, 1), B1, a); o[hf] = pack4(a); }
                *(GAS v4u*)(GPg + (size_t)(h * 128 + c) * 8192 + ((lo4 * 2 + hi2) * 64 + l) * 16) = (v4u){o[0].x, o[0].y, o[1].x, o[1].y};
            }
            {
                const bf16x8 B0 = FR(L_LRB, 16 * lo4, 0), B1 = FR(L_LRB, 16 * lo4, 1); const int t = 16 * lo4 + r;
#pragma unroll
                for (int hf = 0; hf < 2; ++hf) { const int jb = 2 * hi2 + hf; f32x4 a = unpack4(ld64(lds + L_RMR + t * RS_ + (16 * jb + 4 * q) * 2));
                    a = mfma16(FR(L_XTA, 16 * jb, 0), B0, a); a = mfma16(FR(L_XTA, 16 * jb, 1), B1, a);
                    *(GAS u32x2v*)(RBg + (size_t)it * 8192 + t * 128 + (16 * jb + 4 * q) * 2) = pack4(a); }
            }
            {
                const bf16x8 XV0 = FR(L_XTV, 16 * lo4, 0), XV1 = FR(L_XTV, 16 * lo4, 1), V0 = FR(L_CMV, 16 * lo4, 0), V1 = FR(L_CMV, 16 * lo4, 1);
#pragma unroll
                for (int hf = 0; hf < 2; ++hf) { const int ib = 2 * hi2 + hf;
                    f32x4 a = mfma16(FR(L_CMBH, 16 * ib, 0), XV0, z4); a = mfma16(FR(L_CMBH, 16 * ib, 1), XV1, a); a = mfma16(FR(L_CMKH, 16 * ib, 0), V0, a); a = mfma16(FR(L_CMKH, 16 * ib, 1), V1, a);
                    *(GAS f32x4*)(Hg + ((size_t)((h * 4 + lo4) * 128 + c) * 4 + ib) * 256 + l * 4) = a;
                    f32x4 y = mfma16(FR(L_LRB, 16 * ib, 0), XV0, z4); y = mfma16(FR(L_LRB, 16 * ib, 1), XV1, y); y = mfma16(FR(L_LRK, 16 * ib, 0), V0, y); y = mfma16(FR(L_LRK, 16 * ib, 1), V1, y);
                    *(GAS u32x2v*)(YBg + (size_t)it * 8192 + ((lo4 * 4 + ib) * 64 + l) * 8) = pack4(y); }
            }
#undef FR
        }
        R1STAMP(6);
    }
}
constexpr int CH_SS = 4;
constexpr int CH_STEP_BYTES = 8192 + 4096 + 256;
constexpr int CH_BUF_BYTES = CH_SS * CH_STEP_BYTES;
static_assert(2 * CH_BUF_BYTES <= RING_BYTES, "chain LDS");
__device__ __forceinline__ void chain_stage(Ctx& F, const Args& A, int h, int cb, int ss, int bufoff) {
    const int F_lane = lane_v(), F_tid = F.wave * 64 + F_lane; (void)F_tid;
    const unsigned char* GPg = (const unsigned char*)F.out + OUT_GP; const unsigned char* Hg = (const unsigned char*)(F.ws + WS_H); const unsigned char* WCg = (const unsigned char*)(F.ws + WS_WC);
#pragma unroll
    for (int st = 0; st < CH_SS; ++st) { const int c = ss * CH_SS + st; const size_t ih = (size_t)h * 128 + c; const int sb = bufoff + st * CH_STEP_BYTES;
#pragma unroll
        for (int p = 0; p < 13; ++p) { if (((st * 13 + p) & 7) != F.wave) continue;
            if (p < 8) __builtin_amdgcn_global_load_lds((const unsigned*)(GPg + ih * 8192 + p * 1024 + F_lane * 16), (LAS unsigned*)(F.lds + sb + p * 1024), 16, 0, 0);
            else if (p < 12) __builtin_amdgcn_global_load_lds((const unsigned*)(Hg + (((size_t)(h * 4 + cb) * 128 + c) * 4 + (p - 8)) * 1024 + F_lane * 16), (LAS unsigned*)(F.lds + sb + 8192 + (p - 8) * 1024), 16, 0, 0);
            else __builtin_amdgcn_global_load_lds((const unsigned*)(WCg + ih * 256 + F_lane * 4), (LAS unsigned*)(F.lds + sb + 12288), 4, 0, 0); } }
}
__device__ __forceinline__ void ph_rwkv_chain(Ctx& F, const Args& A, int cid) {
    const int F_lane = lane_v(), F_tid = F.wave * 64 + F_lane; (void)F_tid;
    const int h = cid >> 2, cb = cid & 3, l = F_lane, cc = l & 15, q = l >> 4;
    volatile LAS unsigned long long* TSL = (volatile LAS unsigned long long*)(F.lds + MISC_OFF + 256); if (MK_TS >= 20 && cid == 0 && F_tid == 0) { TSL[20] = 0; TSL[21] = 0; TSL[22] = 0; }
    unsigned char* SCg = F.ws + WS_SC;
    f32x4 S[4];
#pragma unroll
    for (int m = 0; m < 4; ++m) S[m] = (f32x4){0.f, 0.f, 0.f, 0.f};
    chain_stage(F, A, h, cb, 0, 0);
    for (int ss = 0; ss < 128 / CH_SS; ++ss) {
        const int bo = (ss & 1) * CH_BUF_BYTES;
        unsigned long long tw0 = 0; if (MK_TS >= 20 && cid == 0 && F_tid == 0) tw0 = __builtin_amdgcn_s_memrealtime();
        asm volatile("s_waitcnt vmcnt(0)" ::: "memory");
        if (MK_TS >= 20 && cid == 0 && F_tid == 0) { const unsigned long long t1 = __builtin_amdgcn_s_memrealtime(); TSL[20] += t1 - tw0; tw0 = t1; }
        __syncthreads();
        if (MK_TS >= 20 && cid == 0 && F_tid == 0) { const unsigned long long t1 = __builtin_amdgcn_s_memrealtime(); TSL[21] += t1 - tw0; tw0 = t1; }
        if (ss + 1 < 128 / CH_SS) chain_stage(F, A, h, cb, ss + 1, ((ss + 1) & 1) * CH_BUF_BYTES);
        if (F.wave == 0) {
#pragma unroll
            for (int st = 0; st < CH_SS; ++st) { const int c = ss * CH_SS + st; const size_t it = (size_t)c * 16 + h; const LAS unsigned char* sb = F.lds + bo + st * CH_STEP_BYTES;
                u32x2v ps[4];
#pragma unroll
                for (int m = 0; m < 4; ++m) { ps[m] = pack4(S[m]); *(GAS u32x2v*)(SCg + it * 8192 + (16 * cb + cc) * 128 + (16 * m + 4 * q) * 2) = ps[m]; }
                const bf16x8 b0 = cat8(ps[0], ps[1]), b1 = cat8(ps[2], ps[3]);
#pragma unroll
                for (int m = 0; m < 4; ++m) { const f32x4 wc = *(const LAS f32x4*)(sb + 12288 + (16 * m + 4 * q) * 4), hh = *(const LAS f32x4*)(sb + 8192 + (m * 64 + l) * 16);
                    f32x4 a = wc * S[m] + hh;
                    a = mfma16(ld128(sb + ((m * 2 + 0) * 64 + l) * 16), b0, a); a = mfma16(ld128(sb + ((m * 2 + 1) * 64 + l) * 16), b1, a);
                    S[m] = a; }
            }
        }
        if (MK_TS >= 20 && cid == 0 && F_tid == 0) { const unsigned long long t1 = __builtin_amdgcn_s_memrealtime(); TSL[22] += t1 - tw0; }
    }
    asm volatile("s_waitcnt vmcnt(0)" ::: "memory"); __syncthreads();
}
__device__ __forceinline__ void ph_post_b(Ctx& F, const Args& A) {
    const int F_lane = lane_v(), F_tid = F.wave * 64 + F_lane; (void)F_tid;
    const bf16* VSg = (const bf16*)((const unsigned char*)F.out + OUT_VS); const bf16* GGg = (const bf16*)(F.ws + WS_GG);
    const unsigned char* SCg = F.ws + WS_SC; const unsigned char* RBg = (const unsigned char*)F.out + OUT_RB; const unsigned char* YBg = (const unsigned char*)F.out + OUT_YB;
    const float* BON = (const float*)(F.ws + WS_MISC + MISC_BON);
    bf16* YC = (bf16*)(F.ws + WS_HN); const float* ssqA = (const float*)(F.ws + WS_CTL) + CW_SSQA;
    const int l = F_lane, cc = l & 15, q = l >> 4, tb = F.wave & 3;
    for (int it = F.vcu * 2 + (F.wave >> 2); it < 128 * NH; it += 2 * F.G) {
        const int c = it >> 4, h = it & 15;
        const bf16x8 A0 = *(const GAS bf16x8*)(RBg + (size_t)it * 8192 + (16 * tb + cc) * 128 + (8 * q) * 2), A1 = *(const GAS bf16x8*)(RBg + (size_t)it * 8192 + (16 * tb + cc) * 128 + (32 + 8 * q) * 2);
        f32x4 y[4];
#pragma unroll
        for (int nb = 0; nb < 4; ++nb) {
            const bf16x8 B0 = *(const GAS bf16x8*)(SCg + (size_t)it * 8192 + (16 * nb + cc) * 128 + (8 * q) * 2), B1 = *(const GAS bf16x8*)(SCg + (size_t)it * 8192 + (16 * nb + cc) * 128 + (32 + 8 * q) * 2);
            y[nb] = unpack4(*(const GAS u32x2v*)(YBg + (size_t)it * 8192 + ((nb * 4 + tb) * 64 + l) * 8));
            y[nb] = mfma16(A0, B0, y[nb]); y[nb] = mfma16(A1, B1, y[nb]); }
        float lg[4], lb[4];
#pragma unroll
        for (int nb = 0; nb < 4; ++nb) { lg[nb] = A.in[IN_LNX_G][h * 64 + 16 * nb + cc]; lb[nb] = A.in[IN_LNX_B][h * 64 + 16 * nb + cc]; }
#pragma unroll
        for (int e = 0; e < 4; ++e) {
            const int t = 64 * c + 16 * tb + 4 * q + e;
            float s = (y[0][e] + y[1][e]) + (y[2][e] + y[3][e]);
            s += __shfl_xor(s, 1); s += __shfl_xor(s, 2); s += __shfl_xor(s, 4); s += __shfl_xor(s, 8);
            const float mu = s * (1.f / 64.f);
            float d[4], v2 = 0.f;
#pragma unroll
            for (int nb = 0; nb < 4; ++nb) { d[nb] = y[nb][e] - mu; v2 += d[nb] * d[nb]; }
            v2 += __shfl_xor(v2, 1); v2 += __shfl_xor(v2, 2); v2 += __shfl_xor(v2, 4); v2 += __shfl_xor(v2, 8);
            const float rstd = 1.0f / sqrtf(v2 * (1.f / 64.f) + LNX_EPS), bon = BON[t * 16 + h];
#pragma unroll
            for (int nb = 0; nb < 4; ++nb) { const size_t o = (size_t)t * RW + h * 64 + 16 * nb + cc;
                const float val = (d[nb] * rstd * lg[nb] + lb[nb] + bon * bf2f(VSg[o])) * bf2f(GGg[o]);
                YC[(size_t)t * D_ + h * 64 + 16 * nb + cc] = (bf16)f2bf(val); }
        }
    }
    const int gw = F.vcu * NWAVES + F.wave, NGW = F.G * NWAVES;
    for (int t = gw; t < T_; t += NGW) {
        const float sc = 1.0f / sqrtf(ssqA[t] * (1.f / RW) + NORM_EPS);
        bf16* p = YC + (size_t)t * D_ + RW;
#pragma unroll
        for (int j = 0; j < 16; ++j) { const int c2 = j * 64 + l; p[c2] = (bf16)f2bf(bf2f(p[c2]) * sc * A.in[IN_ATTN_G][c2]); }
    }
}
constexpr int AT_KS = 144, AT_VS = 528;
constexpr int AT_K = 0, AT_V = 256 * AT_KS, AT_END = AT_V + 64 * AT_VS;
static_assert(AT_END <= RING_BYTES, "attention LDS");
__device__ __forceinline__ void ph_attention(Ctx& F, const Args& A, int bid, int nblk) {
    const int F_lane = lane_v(), F_tid = F.wave * 64 + F_lane; (void)F_tid;
    const bf16* Z = (const bf16*)(F.ws + WS_Z); bf16* YC = (bf16*)(F.ws + WS_HN); const float* rope = (const float*)(F.ws + WS_MISC + MISC_ROPE);
    float* ssqA = (float*)(F.ws + WS_CTL) + CW_SSQA;
    LAS unsigned char* lds = F.lds; const int l = F_lane, cc = l & 15, q = l >> 4;
    for (int it = bid; it < 256; it += nblk) {
        const int nb = it >> 2, kvh = (it >> 1) & 1, qh = it & 1;
        const int kpos0 = 128 * (nb - 1);
        __syncthreads();
        for (int u = F_tid; u < 1024; u += 512) {
            const int key = u >> 2, part = u & 3, pos = kpos0 + key;
            v4u k0 = (v4u){0u, 0u, 0u, 0u}, k1 = k0, v0 = k0, v1 = k0;
            if (pos >= 0) { const bf16* kr = Z + (size_t)pos * NIN + COL_KA + kvh * 64 + part * 16; const bf16* vr = Z + (size_t)pos * NIN + COL_VA + kvh * 64 + part * 16;
                k0 = *(const GAS v4u*)kr; k1 = *(const GAS v4u*)(kr + 8); v0 = *(const GAS v4u*)vr; v1 = *(const GAS v4u*)(vr + 8);
                if (part == 0) { const f32x4 c0 = *(const GAS f32x4*)(rope + pos * 16), c1 = *(const GAS f32x4*)(rope + pos * 16 + 4), s0 = *(const GAS f32x4*)(rope + pos * 16 + 8), s1 = *(const GAS f32x4*)(rope + pos * 16 + 12);
                    const float cs[8] = {c0[0], c0[1], c0[2], c0[3], c1[0], c1[1], c1[2], c1[3]}, sn[8] = {s0[0], s0[1], s0[2], s0[3], s1[0], s1[1], s1[2], s1[3]};
                    const unsigned a[4] = {k0.x, k0.y, k0.z, k0.w}, b[4] = {k1.x, k1.y, k1.z, k1.w}; unsigned oa[4], ob[4];
#pragma unroll
                    for (int e = 0; e < 4; ++e) { const float x1l = bf2f(a[e] & 0xffffu), x1h = bf2f(a[e] >> 16), x2l = bf2f(b[e] & 0xffffu), x2h = bf2f(b[e] >> 16);
                        oa[e] = pk2(x1l * cs[2 * e] - x2l * sn[2 * e], x1h * cs[2 * e + 1] - x2h * sn[2 * e + 1]); ob[e] = pk2(x2l * cs[2 * e] + x1l * sn[2 * e], x2h * cs[2 * e + 1] + x1h * sn[2 * e + 1]); }
                    k0 = (v4u){oa[0], oa[1], oa[2], oa[3]}; k1 = (v4u){ob[0], ob[1], ob[2], ob[3]}; } }
            *(LAS v4u*)(lds + AT_K + key * AT_KS + part * 32) = k0; *(LAS v4u*)(lds + AT_K + key * AT_KS + part * 32 + 16) = k1;
            const unsigned vv[8] = {v0.x, v0.y, v0.z, v0.w, v1.x, v1.y, v1.z, v1.w};
#pragma unroll
            for (int e = 0; e < 8; ++e) { *(LAS unsigned short*)(lds + AT_V + (part * 16 + 2 * e) * AT_VS + key * 2) = (unsigned short)(vv[e] & 0xffffu); *(LAS unsigned short*)(lds + AT_V + (part * 16 + 2 * e + 1) * AT_VS + key * 2) = (unsigned short)(vv[e] >> 16); }
        }
        __syncthreads();
        const int h = kvh * 8 + F.wave; const float sink = A.in[IN_SINKS][h];
#pragma unroll 1
        for (int qb = 0; qb < 4; ++qb) {
            const int p0 = 128 * nb + 64 * qh + 16 * qb, t = p0 + cc, kb = 64 * qh + 16 * qb;
            bf16x8 Q0, Q1;
            { const bf16* qp = Z + (size_t)t * NIN + COL_Q + h * 64; const v4u w0 = *(const GAS v4u*)(qp + 8 * q), w1 = *(const GAS v4u*)(qp + 32 + 8 * q);
              float x[8]; const unsigned ww[4] = {w0.x, w0.y, w0.z, w0.w};
#pragma unroll
              for (int e = 0; e < 4; ++e) { x[2 * e] = bf2f(ww[e] & 0xffffu); x[2 * e + 1] = bf2f(ww[e] >> 16); }
              float y[8];
#pragma unroll
              for (int j = 0; j < 8; ++j) { const float o = __shfl_xor(x[j], 16); const float c = rope[t * 16 + j], s = rope[t * 16 + 8 + j];
                  y[j] = (q == 0) ? (x[j] * c - o * s) : (q == 1) ? (x[j] * c + o * s) : x[j]; y[j] *= 0.125f; }
              v4u r0; r0.x = pk2(y[0], y[1]); r0.y = pk2(y[2], y[3]); r0.z = pk2(y[4], y[5]); r0.w = pk2(y[6], y[7]); Q0 = __builtin_bit_cast(bf16x8, r0);
              const unsigned w1a[4] = {w1.x, w1.y, w1.z, w1.w}; v4u r1; unsigned r1a[4];
#pragma unroll
              for (int e = 0; e < 4; ++e) r1a[e] = pk2(bf2f(w1a[e] & 0xffffu) * 0.125f, bf2f(w1a[e] >> 16) * 0.125f);
              r1 = (v4u){r1a[0], r1a[1], r1a[2], r1a[3]}; Q1 = __builtin_bit_cast(bf16x8, r1); }
            f32x4 s[9]; float mx = sink;
#pragma unroll
            for (int kt = 0; kt < 9; ++kt) {
                const LAS unsigned char* kp = lds + AT_K + (kb + 16 * kt + cc) * AT_KS + (8 * q) * 2;
                f32x4 a = mfma16(ld128(kp), Q0, (f32x4){0.f, 0.f, 0.f, 0.f}); a = mfma16(ld128(kp + 64), Q1, a);
#pragma unroll
                for (int e = 0; e < 4; ++e) { const int i = 4 * q + e; bool ok = (p0 - 128 + 16 * kt + i) >= 0;
                    if (kt == 0) ok = ok && (i >= cc + 1); if (kt == 8) ok = ok && (i <= cc);
                    a[e] = ok ? a[e] : -INFINITY; mx = fmaxf(mx, a[e]); }
                s[kt] = a; }
            mx = fmaxf(mx, __shfl_xor(mx, 16)); mx = fmaxf(mx, __shfl_xor(mx, 32));
            float lsum = 0.f; u32x2v pp[10];
#pragma unroll
            for (int kt = 0; kt < 9; ++kt) { f32x4 p;
#pragma unroll
                for (int e = 0; e < 4; ++e) { p[e] = __expf(s[kt][e] - mx); lsum += p[e]; }
                pp[kt] = pack4(p); }
            pp[9] = (u32x2v){0u, 0u};
            lsum += __shfl_xor(lsum, 16); lsum += __shfl_xor(lsum, 32);
            const float inv = 1.0f / (lsum + __expf(sink - mx));
            f32x4 o[4];
#pragma unroll
            for (int dt = 0; dt < 4; ++dt) { o[dt] = (f32x4){0.f, 0.f, 0.f, 0.f};
                const LAS unsigned char* vp = lds + AT_V + (16 * dt + cc) * AT_VS + (kb + 4 * q) * 2;
#pragma unroll
                for (int ks = 0; ks < 5; ++ks) { const u32x2v lo = ld64(vp + (32 * ks) * 2), hi = ld64(vp + (32 * ks + (ks < 4 ? 16 : 0)) * 2);
                    o[dt] = mfma16(cat8(lo, hi), cat8(pp[2 * ks], pp[2 * ks + 1]), o[dt]); } }
            float sq = 0.f;
#pragma unroll
            for (int dt = 0; dt < 4; ++dt) { o[dt] = o[dt] * inv; sq += (o[dt][0] * o[dt][0] + o[dt][1] * o[dt][1]) + (o[dt][2] * o[dt][2] + o[dt][3] * o[dt][3]);
                *(GAS u32x2v*)(YC + (size_t)t * D_ + RW + h * 64 + 16 * dt + 4 * q) = pack4(o[dt]); }
            sq += __shfl_xor(sq, 16); sq += __shfl_xor(sq, 32);
            if (q == 0) atomicAdd(ssqA + t, sq);
        }
    }
}
constexpr int N_PHASES = 9;
#ifndef MK_TS
#define MK_TS 0
#endif
#ifndef MK_FILLER_IN_CHAIN
#define MK_FILLER_IN_CHAIN 1
#endif
#ifndef MK_REPEAT_MASK
#define MK_REPEAT_MASK 0
#endif
constexpr int N_LAUNCHES = MK_N_LAUNCHES;
__global__ void __launch_bounds__(NWAVES * 64, 2) mk_fwd(Args args) {
    extern __shared__ __attribute__((aligned(16))) unsigned char lds[];
    Ctx F;
    F.lds = (LAS unsigned char*)lds;
    F.wave = __builtin_amdgcn_readfirstlane((int)threadIdx.x >> 6);
#define LEADER (F.wave == 0 && lane_v() == 0)
    F.G = gridDim.x; { const int bx = blockIdx.x; F.vcu = (F.G % 8 == 0) ? (bx % 8) * (F.G / 8) + bx / 8 : bx; }
    F.out = args.out; F.ws = args.ws;
    volatile LAS unsigned* MISC = (volatile LAS unsigned*)(F.lds + MISC_OFF);
    for (int u = (int)threadIdx.x; u < (LDS_BYTES - LDSCTL_OFF) / 4; u += NWAVES * 64) ((LAS unsigned*)(F.lds + LDSCTL_OFF))[u] = 0u;
    __syncthreads();
    gu32* ctl = (gu32*)(F.ws + WS_CTL);
    XcdBarrier bar; bar.bar = (unsigned*)(ctl + CW_BAR); bar.x = 0; bar.st = nullptr;
    const int lo = args.ph_lo, hi = args.ph_hi;
    if (hi - lo > 1) bar = xcd_barrier_post((unsigned*)(ctl + CW_BAR), MISC + 8, LEADER);
#define IN(k) (lo <= (k) && (k) < hi)
#define REPS(k) (1 + ((MK_REPEAT_MASK >> (k)) & 1))
#define SEAM(k) do { if (IN(k) && IN((k) + 1)) xcd_barrier(bar, LEADER); } while (0)
    float* ssq = (float*)(F.ws + WS_CTL);
    volatile LAS unsigned long long* TSL = (volatile LAS unsigned long long*)(F.lds + MISC_OFF + 256);
#define STAMP(i) do { if (MK_TS && blockIdx.x == 0 && LEADER) TSL[(i)] = __builtin_amdgcn_s_memrealtime(); } while (0)
    STAMP(0);
    bf16* HN = (bf16*)(F.ws + WS_HN); bf16* Z = (bf16*)(F.ws + WS_Z); bf16* H2 = (bf16*)(F.ws + WS_H2); bf16* ACT = (bf16*)(F.ws + WS_ACT);

    if (IN(0)) { ph_prologue(F, args); ph_prologue_lora(F, args); } SEAM(0); STAMP(1);
#define PH1() do {   \
        pg8::Gemm g{HN, (const bf16*)(F.ws + WS_WIN), T_, NIN, D_, 0L, 256L * D_ * 2}; pg8::StaticOrder S; S.init(T_, NIN, F.G, (int)blockIdx.x); \
        pg8::EpiZ E{Z, NIN, (const float*)(F.ws + WS_MISC + MISC_BIAS)}; \
        pg8::gemm_phase<pg8::EpiZ, pg8::StaticOrder, true, true>(F.lds, g, S, E, F.wave); } while (0)
    if (IN(1)) { PH1();
        if ((int)blockIdx.x >= 608 - 2 * F.G && F.G == 256) { __syncthreads(); ph_ffn_weights(F, args, ((int)blockIdx.x - 96) * NWAVES + F.wave, (F.G - 96) * NWAVES, 2); }
        else if (F.G != 256) ph_ffn_weights(F, args, F.vcu * NWAVES + F.wave, F.G * NWAVES, 2); } SEAM(1); STAMP(2);
    if (IN(2)) { ph_rwkv_chunk(F, args); } SEAM(2); STAMP(3);
    if (IN(3)) {
        if ((int)blockIdx.x < 64) ph_rwkv_chain(F, args, (int)blockIdx.x);
        else ph_attention(F, args, (int)blockIdx.x - 64, F.G - 64);
    } SEAM(3); STAMP(4);
    if (IN(4)) { ph_post_b(F, args); } SEAM(4); STAMP(5);
    if (IN(5)) {
        pg8::Gemm g{HN, (const bf16*)(F.ws + WS_WOUT), T_, D_, D_, 0L, 256L * D_ * 2}; pg8::StaticOrder S; S.init(T_, D_, F.G, (int)blockIdx.x);
        pg8::EpiRes E{args.in[IN_X], F.out, D_, H2, args.in[IN_LN_FFN_G], ssq + CW_SSQ2};
        pg8::gemm_phase<pg8::EpiRes, pg8::StaticOrder, true, true>(F.lds, g, S, E, F.wave);
    } SEAM(5); STAMP(6);
    if (IN(6)) {
        pg8::Gemm g{H2, (const bf16*)(F.ws + WS_WUG), T_, NUG, D_, -2L * D_ * 2, 254L * D_ * 2}; pg8::StaticOrder S; S.initT(33, NUG / 256, F.G, (int)blockIdx.x);
        pg8::EpiUpGate E{ACT, ssq + CW_SSQ2, args.in[IN_CONV_W], args.in[IN_CONV_B], (LAS float*)(F.lds + XCH_OFF), T_, DFF, 1.0f / D_, NORM_EPS};
        pg8::gemm_phase<pg8::EpiUpGate, pg8::StaticOrder, true, true>(F.lds, g, S, E, F.wave);
    } SEAM(6); STAMP(7);
    if (IN(7)) {
        pg8::Gemm g{ACT, (const bf16*)(F.ws + WS_WDN), T_, D_, DFF, 0L, 256L * DFF * 2}; pg8::StaticOrder S; S.init(T_, D_, F.G, (int)blockIdx.x);
        pg8::EpiRes E{F.out, F.out, D_, nullptr, nullptr, ssq + CW_SSQ3};
        pg8::gemm_phase<pg8::EpiRes, pg8::StaticOrder, true, true>(F.lds, g, S, E, F.wave);
    } SEAM(7); STAMP(8);
    if (IN(8)) { ph_final(F, args); }
    STAMP(9);
    if (MK_TS && blockIdx.x == 0 && LEADER) {
        unsigned long long dt;
        if (MK_TS <= 9) dt = TSL[MK_TS] - TSL[MK_TS - 1]; else dt = TSL[MK_TS];
        asm volatile("s_waitcnt vmcnt(0)" ::: "memory");
        F.out[0] += (float)dt * 1e-4f;
    }
#undef IN
#undef SEAM
}

extern "C" void kernel_launch(void* const* d_in, const int* in_sizes, int n_in, void* d_out, int out_size, void* d_ws, size_t ws_size, hipStream_t stream) {
    static int grid = 0;
    if (grid == 0) {
        if (n_in != 25 || in_sizes[0] != T_ * D_ || out_size != T_ * D_ || ws_size < WS_END) { fprintf(stderr, "kernel_launch: unexpected shapes (n_in %d, in0 %d, out %d, ws %zu)\n", n_in, n_in > 0 ? in_sizes[0] : -1, out_size, ws_size); grid = -1; return; }
        int dev = 0, cus = 0;
        if (hipGetDevice(&dev) != hipSuccess || hipDeviceGetAttribute(&cus, hipDeviceAttributeMultiprocessorCount, dev) != hipSuccess) { grid = -1; return; }
        if (hipFuncSetAttribute((const void*)mk_fwd, hipFuncAttributeMaxDynamicSharedMemorySize, LDS_BYTES) != hipSuccess) { fprintf(stderr, "kernel_launch: hipFuncSetAttribute failed\n"); grid = -1; return; }
        (void)hipGetLastError();
        grid = cus;
    }
    if (grid < 0) return;
    if (hipMemsetAsync((char*)d_ws + WS_CTL, 0, CTL_ZERO_BYTES, stream) != hipSuccess) return;
    Args a{};
    for (int i = 0; i < 25; ++i) a.in[i] = (const float*)d_in[i];
    a.out = (float*)d_out; a.ws = (unsigned char*)d_ws;
    if (N_LAUNCHES == 1) { a.ph_lo = 0; a.ph_hi = N_PHASES; a.li = 0; hipLaunchKernelGGL(mk_fwd, dim3(grid), dim3(NWAVES * 64), LDS_BYTES, stream, a); }
    else for (int ph = 0; ph < N_PHASES; ++ph) { a.ph_lo = ph; a.ph_hi = ph + 1; a.li = 0; hipLaunchKernelGGL(mk_fwd, dim3(grid), dim3(NWAVES * 64), LDS_BYTES, stream, a); }
}
```
